# Optimizing an MI355X kernel written in HIP

```python
import jax, jax.numpy as jnp
from jax import lax
import numpy as np

D_MODEL = 1024
BATCH = 2
SEQ = 8192
DEPTH = 4
DEC_BATCH = 32
DEC_SEQ = 1
PAST_LEN = 8192
PAGE_SIZE = 128

N_A_LAYERS = DEPTH // 2
N_B_LAYERS = DEPTH - N_A_LAYERS
POOL_WINDOWS = (2, 4, 8, 16)
N_POOL_GROUPS = len(POOL_WINDOWS)
POOL_GROUP = D_MODEL // N_POOL_GROUPS
POOL_BUF = max(POOL_WINDOWS) - 1
HEAD_DIM = 64
N_HEADS = D_MODEL // HEAD_DIM
N_KV_HEADS = 4
GQ = N_HEADS // N_KV_HEADS
ROT_DIM = HEAD_DIM // 4
ROPE_THETA = 500000.0
SEL_BLOCK = 64
N_SEL = 16
WINDOW = 512
CMP_HIDDEN = 128
N_KV_SLOTS = 4
Q_BLOCK = 64
FORCE_SCORE = 1.0e4
D_FF = -(-(8 * D_MODEL) // (3 * 256)) * 256
EPS = 1e-6

kernel_name = 'yoco_pool_nsa_decoder_step'


def rmsnorm(x, g):
    xf = x.astype(jnp.float32)
    y = xf * lax.rsqrt(jnp.mean(xf * xf, axis=-1, keepdims=True) + EPS)
    return (y * g.astype(jnp.float32)).astype(x.dtype)


def rope_partial(x, pos):
    half = ROT_DIM // 2
    inv = jnp.power(jnp.float32(ROPE_THETA), -jnp.arange(half, dtype=jnp.float32) * 2.0 / ROT_DIM)
    ang = pos.astype(jnp.float32)[:, None] * inv[None, :]
    cos = jnp.cos(ang)[:, None, :].astype(x.dtype)
    sin = jnp.sin(ang)[:, None, :].astype(x.dtype)
    x1 = x[..., :half]
    x2 = x[..., half:ROT_DIM]
    return jnp.concatenate([x1 * cos - x2 * sin, x2 * cos + x1 * sin, x[..., ROT_DIM:]], axis=-1)


def adaln(x, c, w, b, g):
    mod = (c @ w + b)[:, None, :]
    shift, scale, gate = jnp.split(mod, 3, axis=-1)
    return rmsnorm(x, g) * (1 + scale) + shift, gate


def swiglu(h, w_gu, w_down):
    g, u = jnp.split(h @ w_gu, 2, axis=-1)
    return (jax.nn.silu(g) * u) @ w_down


def masked_softmax(s, mask):
    s = jnp.where(mask, s.astype(jnp.float32), -1e30)
    m = jnp.max(s, axis=-1, keepdims=True)
    p = jnp.where(mask, jnp.exp(s - m), 0.0)
    return p / jnp.maximum(jnp.sum(p, axis=-1, keepdims=True), 1e-30)


def pool_mix(h, prefix, pos0, w_grp, scale):
    B, T, D = h.shape
    full = jnp.concatenate([prefix, h], axis=1).astype(jnp.float32)
    cs = jnp.concatenate([jnp.zeros((B, 1, D), jnp.float32), jnp.cumsum(full, axis=1)], axis=1)
    pos = pos0 + jnp.arange(T)
    hi = cs[:, POOL_BUF + 1:POOL_BUF + 1 + T]
    means = []
    for g, w in enumerate(POOL_WINDOWS):
        ch = slice(g * POOL_GROUP, (g + 1) * POOL_GROUP)
        lo = cs[:, POOL_BUF + 1 - w:POOL_BUF + 1 - w + T, ch]
        cnt = jnp.minimum(w, pos + 1).astype(jnp.float32)[None, :, None]
        means.append((hi[:, :, ch] - lo) / cnt)
    pooled = (jnp.concatenate(means, axis=-1) - h.astype(jnp.float32)).reshape(B, T, N_POOL_GROUPS, POOL_GROUP)
    y = jnp.einsum('btgc,gcd->btgd', pooled, w_grp.astype(jnp.float32)).reshape(B, T, D)
    return (y * scale.astype(jnp.float32)).astype(h.dtype)


def compress_blocks(rows, pe, w1, w2):
    B, nb = rows.shape[:2]
    z = (rows + pe[:, None, :]).transpose(0, 1, 3, 2, 4).reshape(B, nb, N_KV_HEADS, SEL_BLOCK * HEAD_DIM)
    return jax.nn.gelu(z @ w1) @ w2


def shared_kv(x, c, pos, kv_prefix, win_prefix, win_keep, p):
    B, T, _ = x.shape
    mod = (c @ p['ada_kv_w'] + p['ada_kv_b'])[:, None, :]
    shift, scale = jnp.split(mod, 2, axis=-1)
    h = rmsnorm(x, p['norm_kv']) * (1 + scale) + shift
    proj = (h @ p['w_kv']).reshape(B, T, 6, N_KV_HEADS, HEAD_DIM)
    k_sel = rope_partial(rmsnorm(proj[:, :, 2], p['k_norm'][1]), pos)
    k_win = rope_partial(rmsnorm(proj[:, :, 4], p['k_norm'][2]), pos)
    rows_new = jnp.stack([proj[:, :, 0], proj[:, :, 1], k_sel, proj[:, :, 3]], axis=2)
    win_full = jnp.concatenate([win_prefix, jnp.stack([k_win, proj[:, :, 5]], axis=2)], axis=1)
    rows = jnp.concatenate([kv_prefix, rows_new], axis=1)
    L = rows.shape[1]
    nb = -(-L // SEL_BLOCK)
    rows = jnp.pad(rows, ((0, 0), (0, nb * SEL_BLOCK - L), (0, 0), (0, 0), (0, 0)))
    blocks = rows.reshape(B, nb, SEL_BLOCK, N_KV_SLOTS, N_KV_HEADS, HEAD_DIM)
    kc = compress_blocks(blocks[:, :, :, 0], p['cmp_pe'][0], p['cmp_w1'][0], p['cmp_w2'][0])
    kc = rope_partial(rmsnorm(kc, p['k_norm'][0]), (jnp.arange(nb) + 1) * SEL_BLOCK - 1)
    vc = compress_blocks(blocks[:, :, :, 1], p['cmp_pe'][1], p['cmp_w1'][1], p['cmp_w2'][1])
    ksb = blocks[:, :, :, 2].transpose(0, 3, 1, 2, 4)
    vsb = blocks[:, :, :, 3].transpose(0, 3, 1, 2, 4)
    return rows_new, win_full[:, -win_keep:], kc, vc, ksb, vsb, win_full[:, :, 0], win_full[:, :, 1]


def nsa_attention(q, gates, kc, vc, ksb, vsb, kw, vw, q_start):
    B, T = q.shape[:2]
    nb = kc.shape[1]
    n_sel = min(N_SEL, nb)
    qb = Q_BLOCK if T % Q_BLOCK == 0 else T
    sm = HEAD_DIM ** -0.5
    blk = jnp.arange(nb)
    blk_end = (blk + 1) * SEL_BLOCK - 1
    b_idx = jnp.arange(B)[:, None, None, None]
    h_idx = jnp.arange(N_KV_HEADS)[None, :, None, None]

    def one_block(i):
        t0 = i * qb
        qq = lax.dynamic_slice_in_dim(q, t0, qb, axis=1).reshape(B, qb, N_KV_HEADS, GQ, HEAD_DIM)
        gg = lax.dynamic_slice_in_dim(gates, t0, qb, axis=1).reshape(B, qb, N_KV_HEADS, GQ, 3)
        pos = q_start + t0 + jnp.arange(qb)
        s_c = jnp.einsum('bqkgd,bnkd->bkgqn', qq, kc) * sm
        p_c = masked_softmax(s_c, blk_end[None, :] <= pos[:, None])
        o_c = jnp.einsum('bkgqn,bnkd->bqkgd', p_c.astype(vc.dtype), vc)
        cur = pos // SEL_BLOCK
        forced = (blk[None, :] == 0) | (blk[None, :] == cur[:, None]) | (blk[None, :] == cur[:, None] - 1)
        imp = jnp.sum(p_c, axis=2)
        imp = jnp.where(forced, FORCE_SCORE, jnp.where(blk[None, :] > cur[:, None], -1.0, imp))
        _, idx = lax.top_k(imp, n_sel)
        k_g = ksb[b_idx, h_idx, idx]
        v_g = vsb[b_idx, h_idx, idx]
        s_s = jnp.einsum('bqkgd,bkqnsd->bkgqns', qq, k_g) * sm
        key_pos = idx[..., None] * SEL_BLOCK + jnp.arange(SEL_BLOCK)
        mask_s = (key_pos <= pos[:, None, None]).reshape(B, N_KV_HEADS, 1, qb, n_sel * SEL_BLOCK)
        p_s = masked_softmax(s_s.reshape(B, N_KV_HEADS, GQ, qb, n_sel * SEL_BLOCK), mask_s)
        o_s = jnp.einsum('bkgqm,bkqmd->bqkgd', p_s.astype(v_g.dtype),
                         v_g.reshape(B, N_KV_HEADS, qb, n_sel * SEL_BLOCK, HEAD_DIM))
        kk = lax.dynamic_slice_in_dim(kw, t0, WINDOW + qb, axis=1)
        vv = lax.dynamic_slice_in_dim(vw, t0, WINDOW + qb, axis=1)
        wpos = q_start - WINDOW + t0 + jnp.arange(WINDOW + qb)
        dist = pos[:, None] - wpos[None, :]
        mask_w = (wpos[None, :] >= 0) & (dist >= 0) & (dist < WINDOW)
        s_w = jnp.einsum('bqkgd,bmkd->bkgqm', qq, kk) * sm
        p_w = masked_softmax(s_w, mask_w)
        o_w = jnp.einsum('bkgqm,bmkd->bqkgd', p_w.astype(vv.dtype), vv)
        o = gg[..., 0:1] * o_c + gg[..., 1:2] * o_s + gg[..., 2:3] * o_w
        return o.astype(q.dtype).reshape(B, qb, N_HEADS * HEAD_DIM)

    out = lax.map(one_block, jnp.arange(T // qb))
    return out.transpose(1, 0, 2, 3).reshape(B, T, N_HEADS * HEAD_DIM)


def forward_group(x, c, q_start, pool_prefix, kv_prefix, win_prefix, win_keep, p):
    B, T, _ = x.shape
    pos = q_start + jnp.arange(T)
    hq = N_HEADS * HEAD_DIM
    new_pool = []
    for l in range(DEPTH):
        if l < N_A_LAYERS:
            h, gate = adaln(x, c, p['ada_w'][l, 0], p['ada_b'][l, 0], p['norm_mix'][l])
            x = x + gate * pool_mix(h, pool_prefix[l], q_start, p['pool_w'][l], p['pool_scale'][l])
            new_pool.append(jnp.concatenate([pool_prefix[l], h], axis=1)[:, -POOL_BUF:])
        else:
            if l == N_A_LAYERS:
                rows_new, win_state, kc, vc, ksb, vsb, kw, vw = shared_kv(x, c, pos, kv_prefix, win_prefix, win_keep, p)
            j = l - N_A_LAYERS
            h, gate = adaln(x, c, p['ada_w'][l, 0], p['ada_b'][l, 0], p['norm_mix'][l])
            qg = h @ p['w_qg'][j]
            q = rope_partial(rmsnorm(qg[..., :hq].reshape(B, T, N_HEADS, HEAD_DIM), p['q_norm'][j]), pos)
            gates = jax.nn.sigmoid(qg[..., hq:]).reshape(B, T, N_HEADS, 3)
            o = nsa_attention(q, gates, kc, vc, ksb, vsb, kw, vw, q_start)
            x = x + gate * (o @ p['w_o'][j])
        h, gate = adaln(x, c, p['ada_w'][l, 1], p['ada_b'][l, 1], p['norm_ffn'][l])
        x = x + gate * swiglu(h, p['w_gate_up'][l], p['w_down'][l])
    return x, rows_new, win_state, jnp.stack(new_pool)


def setup_inputs(seed: int = 0) -> dict:
    key = jax.random.key(seed)
    ks = jax.random.split(key, 32)
    f32 = jnp.float32
    D = D_MODEL
    n_pages = PAST_LEN // PAGE_SIZE
    n_used = DEC_BATCH * n_pages
    n_phys = n_used + max(1, n_used // 4)
    w_buf = min(WINDOW, PAST_LEN)
    hq = N_HEADS * HEAD_DIM

    def nrm(k, shape, s=1.0):
        return jax.random.normal(k, shape, f32) * s

    def gain(k, shape):
        return 1.0 + 0.05 * jax.random.normal(k, shape, f32)

    page_table = jax.random.permutation(ks[5], n_phys)[:n_used].reshape(DEC_BATCH, n_pages).astype(jnp.int32)
    return {
        'x_prompt': nrm(ks[0], (BATCH, SEQ, D)),
        'x_sample': nrm(ks[1], (DEC_BATCH, DEC_SEQ, D)),
        'cache_kv': nrm(ks[2], (n_phys, PAGE_SIZE, N_KV_SLOTS, N_KV_HEADS, HEAD_DIM)),
        'state_kv_win': nrm(ks[3], (DEC_BATCH, w_buf, 2, N_KV_HEADS, HEAD_DIM)),
        'state_pool': nrm(ks[4], (N_A_LAYERS, DEC_BATCH, POOL_BUF, D)),
        'page_table': page_table,
        'c_prompt': nrm(ks[6], (BATCH, D)),
        'c_sample': nrm(ks[7], (DEC_BATCH, D)),
        'ada_w': nrm(ks[8], (DEPTH, 2, D, 3 * D), 0.3 * D ** -0.5),
        'ada_b': nrm(ks[9], (DEPTH, 2, 3 * D), 0.02),
        'norm_mix': gain(ks[10], (DEPTH, D)),
        'norm_ffn': gain(ks[11], (DEPTH, D)),
        'pool_w': nrm(ks[12], (N_A_LAYERS, N_POOL_GROUPS, POOL_GROUP, POOL_GROUP), POOL_GROUP ** -0.5),
        'pool_scale': gain(ks[13], (N_A_LAYERS, D)),
        'ada_kv_w': nrm(ks[14], (D, 2 * D), 0.3 * D ** -0.5),
        'ada_kv_b': nrm(ks[15], (2 * D,), 0.02),
        'norm_kv': gain(ks[16], (D,)),
        'w_kv': nrm(ks[17], (D, 6 * N_KV_HEADS * HEAD_DIM), D ** -0.5),
        'k_norm': gain(ks[18], (3, HEAD_DIM)),
        'cmp_pe': nrm(ks[19], (2, SEL_BLOCK, HEAD_DIM), 0.1),
        'cmp_w1': nrm(ks[20], (2, SEL_BLOCK * HEAD_DIM, CMP_HIDDEN), (SEL_BLOCK * HEAD_DIM) ** -0.5),
        'cmp_w2': nrm(ks[21], (2, CMP_HIDDEN, HEAD_DIM), CMP_HIDDEN ** -0.5),
        'w_qg': nrm(ks[22], (N_B_LAYERS, D, hq + 3 * N_HEADS), D ** -0.5),
        'q_norm': gain(ks[23], (N_B_LAYERS, HEAD_DIM)),
        'w_o': nrm(ks[24], (N_B_LAYERS, hq, D), hq ** -0.5),
        'w_gate_up': nrm(ks[25], (DEPTH, D, 2 * D_FF), D ** -0.5),
        'w_down': nrm(ks[26], (DEPTH, D_FF, D), D_FF ** -0.5),
    }


def reference(x_prompt, x_sample, cache_kv, state_kv_win, state_pool, page_table, c_prompt, c_sample,
              ada_w, ada_b, norm_mix, norm_ffn, pool_w, pool_scale, ada_kv_w, ada_kv_b, norm_kv, w_kv,
              k_norm, cmp_pe, cmp_w1, cmp_w2, w_qg, q_norm, w_o, w_gate_up, w_down):
    p = dict(ada_w=ada_w, ada_b=ada_b, norm_mix=norm_mix, norm_ffn=norm_ffn, pool_w=pool_w,
             pool_scale=pool_scale, ada_kv_w=ada_kv_w, ada_kv_b=ada_kv_b, norm_kv=norm_kv, w_kv=w_kv,
             k_norm=k_norm, cmp_pe=cmp_pe, cmp_w1=cmp_w1, cmp_w2=cmp_w2, w_qg=w_qg, q_norm=q_norm,
             w_o=w_o, w_gate_up=w_gate_up, w_down=w_down)
    b_p, seq = x_prompt.shape[:2]
    b_s = x_sample.shape[0]
    dt = x_prompt.dtype
    y_prompt, kv_rows_prompt, win_prompt, pool_prompt = forward_group(
        x_prompt, c_prompt, 0,
        jnp.zeros((N_A_LAYERS, b_p, POOL_BUF, D_MODEL), dt),
        jnp.zeros((b_p, 0, N_KV_SLOTS, N_KV_HEADS, HEAD_DIM), dt),
        jnp.zeros((b_p, WINDOW, 2, N_KV_HEADS, HEAD_DIM), dt),
        min(WINDOW, seq), p)
    past_len = page_table.shape[1] * PAGE_SIZE
    kv_past = cache_kv[page_table].reshape(b_s, past_len, N_KV_SLOTS, N_KV_HEADS, HEAD_DIM)
    w_buf = state_kv_win.shape[1]
    win_prefix = jnp.pad(state_kv_win, ((0, 0), (WINDOW - w_buf, 0), (0, 0), (0, 0), (0, 0)))
    y_sample, kv_rows_sample, win_sample, pool_sample = forward_group(
        x_sample, c_sample, past_len, state_pool, kv_past, win_prefix, w_buf, p)
    return (y_prompt, y_sample, kv_rows_prompt, kv_rows_sample, win_prompt, win_sample, pool_prompt, pool_sample)
```

```cpp
#include <hip/hip_runtime.h>
#include <cstdio>
#include <cstdint>

#ifndef MK_PER_PHASE
#define MK_PER_PHASE 1
#endif

constexpr int D = 1024, SEQ = 8192, NBP = 2, NBS = 32, MP = NBP * SEQ  , MR = MP + NBS  , MPAD = 16640  ;
constexpr int DFF = 2816, NGU = 2 * DFF, NKV = 1536, NQG = 1072, NQGP = 1280, NADA = 8 * 3072 + 2048  ;
constexpr int NBLK = 128, NBATCH = NBP + NBS  , NBLKT = NBATCH * NBLK  ;
constexpr float EPS = 1e-6f;
constexpr float C2 = 0.125f * 1.4426950408889634f;

constexpr size_t O_Y = 0, O_KV = (size_t)MR * 1024, O_WINP = O_KV + (size_t)MR * 1024, O_WINS = O_WINP + (size_t)2 * 512 * 512, O_POOLP = O_WINS + (size_t)32 * 512 * 512,
                 O_POOLS = O_POOLP + (size_t)2 * 2 * 15 * 1024, O_END = O_POOLS + (size_t)2 * 32 * 15 * 1024;
static_assert(O_END == 43577344, "output size");

constexpr size_t MiB = 1u << 20;
constexpr size_t WS_CTL = 0, CTL_ZERO_BYTES = 1 * MiB;
constexpr size_t WS_MODS = 1 * MiB, WS_CB = 8 * MiB, WS_ROPE = 9 * MiB, WS_BIASPE = 10 * MiB;
constexpr size_t WS_ADAT = 16 * MiB, WS_WGU = 68 * MiB, WS_WDN = 112 * MiB, WS_WKV = 134 * MiB, WS_WQG = 137 * MiB, WS_WO = 142 * MiB, WS_POOLW = 146 * MiB, WS_W1T = 147 * MiB;
constexpr size_t WS_XN = 160 * MiB, WS_XN2 = 193 * MiB, WS_H0 = 226 * MiB, WS_H = 291 * MiB, WS_RAWKV = 381 * MiB, WS_RAWQ = 479 * MiB, WS_KVB = 561 * MiB, WS_WINB = 594 * MiB,
                 WS_QB = 611 * MiB, WS_OB = 644 * MiB, WS_GATES = 677 * MiB, WS_KC = 681 * MiB, WS_VC = 686 * MiB, WS_END = 700 * MiB;
constexpr int CW_BAR = 4096;

#define GAS __attribute__((address_space(1)))
#define LAS __attribute__((address_space(3)))
typedef unsigned short bf16;
typedef float f32x4 __attribute__((ext_vector_type(4)));
typedef float f32x2 __attribute__((ext_vector_type(2)));
typedef unsigned v4u __attribute__((ext_vector_type(4)));
typedef unsigned v2u __attribute__((ext_vector_type(2)));
typedef short bf16x8 __attribute__((ext_vector_type(8)));
#define RLX_AGENT __ATOMIC_RELAXED, __HIP_MEMORY_SCOPE_AGENT
#define LDS_WAIT() asm volatile("s_waitcnt lgkmcnt(0)" ::: "memory")
#define VM_WAIT() asm volatile("s_waitcnt vmcnt(0)" ::: "memory")

__device__ __forceinline__ unsigned f2bf(float f) { unsigned u = __builtin_bit_cast(unsigned, f); return (u + 0x7fffu + ((u >> 16) & 1u)) >> 16; }
__device__ __forceinline__ unsigned pk2(float lo, float hi) { return f2bf(lo) | (f2bf(hi) << 16); }
__device__ __forceinline__ float bf2f(unsigned short u) { return __builtin_bit_cast(float, (unsigned)u << 16); }
__device__ __forceinline__ float wave_sum(float v) {
#pragma unroll
    for (int o = 1; o < 64; o <<= 1) v += __shfl_xor(v, o);
    return v;
}
__device__ __forceinline__ float wave_max(float v) {
#pragma unroll
    for (int o = 1; o < 64; o <<= 1) v = fmaxf(v, __shfl_xor(v, o));
    return v;
}
__device__ __forceinline__ int bidx_of(int row) { return row < MP ? (row >> 13) : ((row - MP + 2) < NBATCH ? (row - MP + 2) : NBATCH - 1); }

namespace pg8 {
#define PG8_LAS __attribute__((address_space(3)))
typedef unsigned short bf16_t;
typedef short bf16x8 __attribute__((ext_vector_type(8)));
typedef float f32x4 __attribute__((ext_vector_type(4)));
typedef unsigned u32x4 __attribute__((ext_vector_type(4)));
constexpr int BM = 256, BK = 64, HALF = 128, HTB = HALF * BK * 2, STAGE_BYTES = 8 * HTB, NXCD = 8, WGM = 8;
__host__ __device__ __forceinline__ int lds_byte(int r, int c) { const int st = (r >> 4) * 2 + (c >> 5), rr = r & 15, cc = c & 31, ob = rr * 64 + cc * 2; return st * 1024 + (ob ^ (((ob >> 9) & 1) << 5)); }
__host__ __device__ __forceinline__ void stage_rc(int b, int& R, int& C) { const int st = b / 1024, sb = b % 1024, swz = sb ^ (((sb >> 9) & 1) << 5); R = (st >> 1) * 16 + swz / 64; C = (st & 1) * 32 + (swz % 64) / 2; }
__host__ __device__ __forceinline__ int perm32(int rho) { const int n = rho >> 4, i = rho & 15; return 8 * (i >> 2) + 4 * n + (i & 3); }
struct Unit { int pm, pn; };
struct Gemm { const bf16_t* A; const bf16_t* Bt; int lda, ldb, K, a_pn_off; };
struct StaticOrder {
    int nM, nN, nwg, G, c;
    __host__ __device__ void init(int M, int N, int G_, int c_) { nM = M / BM; nN = N / BM; nwg = nM * nN; G = G_; c = c_; }
    __host__ __device__ bool next(int i, Unit& u) const {
        const long L = (long)i * G + c; if (L >= nwg) return false;
        int wgid = (int)L; { const int q = nwg / NXCD, r = nwg % NXCD, xcd = wgid % NXCD, off = wgid / NXCD; wgid = (xcd < r ? xcd * (q + 1) : r * (q + 1) + (xcd - r) * q) + off; }
        const int nig = WGM * nN, gid = wgid / nig, fm = gid * WGM, gsz = (nM - fm) < WGM ? (nM - fm) : WGM;
        u.pm = fm + ((wgid % nig) % gsz); u.pn = (wgid % nig) / gsz; return true;
    }
};
template <class Epi>
__device__ __forceinline__ void gemm_phase(PG8_LAS unsigned char* lds, const Gemm g, const StaticOrder& S, const Epi& E) {
    int tid = threadIdx.x; asm volatile("" : "+v"(tid));
    const int wid = __builtin_amdgcn_readfirstlane(tid >> 6), lane = tid & 63, wr = wid >> 2, wc = wid & 3, fr = lane & 15, fq = lane >> 4;
    const int K = g.K, nt = K / BK;
    unsigned voffA[2], voffB[2];
#pragma unroll
    for (int i = 0; i < 2; ++i) { int R, C; stage_rc(tid * 16 + i * 8192, R, C); const int Rb = Epi::PERM ? ((R & ~31) + perm32(R & 31)) : R;
        voffA[i] = (unsigned)(R * g.lda + C) * 2u; voffB[i] = (unsigned)(Rb * g.ldb + C) * 2u; }
    const size_t kstep = (size_t)(BK * 2);
    const size_t hstepA = (size_t)HALF * g.lda * 2, hstepB = (size_t)HALF * g.ldb * 2, tstepA = 2 * hstepA, tstepB = 2 * hstepB;
    const unsigned ldsw = (unsigned)wid * 1024u;
    const int aoff = lds_byte(wr * 64 + fr, fq * 8), boff = lds_byte(wc * 32 + fr, fq * 8);
#define PG8_SA(b, h) (((b) * 2 + (h)) * HTB)
#define PG8_SB(b, h) ((4 + (b) * 2 + (h)) * HTB)
#define PG8_STAGE(bufoff, gbase, voff) do { _Pragma("unroll") for (int _i = 0; _i < 2; ++_i) \
        __builtin_amdgcn_global_load_lds((const unsigned*)((const char*)(gbase) + (voff)[_i]), (PG8_LAS unsigned*)(lds + (bufoff) + ldsw + _i * 8192), 16, 0, 0); } while (0)
#define PG8_LDA(dst, b, h) do { _Pragma("unroll") for (int m = 0; m < 4; ++m) _Pragma("unroll") for (int k = 0; k < 2; ++k) dst[m][k] = *(const PG8_LAS bf16x8*)(lds + PG8_SA(b, h) + aoff + m * 2048 + k * 1024); } while (0)
#define PG8_LDB(dst, b, h) do { _Pragma("unroll") for (int n = 0; n < 2; ++n) _Pragma("unroll") for (int k = 0; k < 2; ++k) dst[n][k] = *(const PG8_LAS bf16x8*)(lds + PG8_SB(b, h) + boff + n * 2048 + k * 1024); } while (0)
#define PG8_MMA(ai, bj, At, Bt) do { __builtin_amdgcn_s_setprio(1); _Pragma("unroll") for (int m = 0; m < 4; ++m) _Pragma("unroll") for (int n = 0; n < 2; ++n) _Pragma("unroll") for (int k = 0; k < 2; ++k) \
        acc[ai][bj][m][n] = __builtin_amdgcn_mfma_f32_16x16x32_bf16(Bt[n][k], At[m][k], acc[ai][bj][m][n], 0, 0, 0); __builtin_amdgcn_s_setprio(0); } while (0)
#define PG8_WAIT_V(n) asm volatile("s_waitcnt vmcnt(" #n ")" ::: "memory")
#define PG8_WAIT_L(n) asm volatile("s_waitcnt lgkmcnt(" #n ")" ::: "memory")
#define PG8_BAR __builtin_amdgcn_s_barrier()
#define PG8_SCHED __builtin_amdgcn_sched_barrier(0)
    Unit cur, nxt; int ui = 0;
    if (!S.next(0, cur)) return;
    f32x4 acc[2][2][4][2];
#pragma unroll
    for (int a = 0; a < 2; ++a)
#pragma unroll
        for (int b = 0; b < 2; ++b)
#pragma unroll
            for (int m = 0; m < 4; ++m)
#pragma unroll
                for (int n = 0; n < 2; ++n) acc[a][b][m][n] = (f32x4){0.f, 0.f, 0.f, 0.f};
    bf16x8 At[4][2], B0[2][2], B1[2][2];
    const char* cA = (const char*)g.A + (size_t)cur.pm * tstepA + (size_t)cur.pn * g.a_pn_off * 2; const char* cB = (const char*)g.Bt + (size_t)cur.pn * tstepB;
    PG8_STAGE(PG8_SB(0, 0), cB, voffB); PG8_STAGE(PG8_SB(0, 1), cB + hstepB, voffB); PG8_STAGE(PG8_SA(0, 0), cA, voffA); PG8_STAGE(PG8_SA(0, 1), cA + hstepA, voffA);
    if (wr == 1) PG8_BAR;
    PG8_WAIT_V(2); PG8_BAR;
    PG8_STAGE(PG8_SB(1, 0), cB + kstep, voffB); PG8_STAGE(PG8_SA(1, 0), cA + kstep, voffA); PG8_STAGE(PG8_SB(1, 1), cB + hstepB + kstep, voffB);
    PG8_WAIT_V(6); PG8_BAR;
    for (;;) {
        const bool has_next = S.next(ui + 1, nxt);
        const char* nA = has_next ? (const char*)g.A + (size_t)nxt.pm * tstepA + (size_t)nxt.pn * g.a_pn_off * 2 : cA; const char* nB = has_next ? (const char*)g.Bt + (size_t)nxt.pn * tstepB : cB;
        for (int t = 0; t < nt; t += 2) {
            const bool last = (t == nt - 2);
            const char* a1 = cA + (size_t)(t + 1) * kstep;
            const char* a2 = last ? nA : cA + (size_t)(t + 2) * kstep; const char* b2 = last ? nB : cB + (size_t)(t + 2) * kstep;
            const char* a3 = a2 + kstep; const char* b3 = b2 + kstep;
            PG8_LDB(B0, 0, 0); PG8_LDB(B1, 0, 1); PG8_SCHED; PG8_LDA(At, 0, 0); PG8_STAGE(PG8_SA(1, 1), a1 + hstepA, voffA);
            PG8_WAIT_V(8); PG8_WAIT_L(0); PG8_BAR; PG8_MMA(0, 0, At, B0); PG8_MMA(0, 1, At, B1); PG8_BAR; PG8_SCHED;
            PG8_LDA(At, 0, 1); PG8_STAGE(PG8_SB(0, 0), b2, voffB); PG8_STAGE(PG8_SB(0, 1), b2 + hstepB, voffB); PG8_STAGE(PG8_SA(0, 0), a2, voffA);
            PG8_WAIT_V(8); PG8_WAIT_L(0); PG8_BAR; PG8_MMA(1, 0, At, B0); PG8_MMA(1, 1, At, B1); PG8_BAR; PG8_SCHED;
            PG8_LDB(B0, 1, 0); PG8_LDB(B1, 1, 1); PG8_SCHED; PG8_LDA(At, 1, 0); PG8_STAGE(PG8_SA(0, 1), a2 + hstepA, voffA);
            PG8_WAIT_V(8); PG8_WAIT_L(0); PG8_BAR; PG8_MMA(0, 0, At, B0); PG8_MMA(0, 1, At, B1); PG8_BAR; PG8_SCHED;
            PG8_LDA(At, 1, 1); PG8_STAGE(PG8_SB(1, 0), b3, voffB); PG8_STAGE(PG8_SB(1, 1), b3 + hstepB, voffB); PG8_STAGE(PG8_SA(1, 0), a3, voffA);
            PG8_WAIT_V(8); PG8_WAIT_L(0); PG8_BAR; PG8_MMA(1, 0, At, B0); PG8_MMA(1, 1, At, B1); PG8_BAR; PG8_SCHED;
        }
        if (wr == 0) PG8_BAR;
        E(acc, cur, wr, wc, fr, fq);
        if (!has_next) break;
#pragma unroll
        for (int a = 0; a < 2; ++a)
#pragma unroll
            for (int b = 0; b < 2; ++b)
#pragma unroll
                for (int m = 0; m < 4; ++m)
#pragma unroll
                    for (int n = 0; n < 2; ++n) acc[a][b][m][n] = (f32x4){0.f, 0.f, 0.f, 0.f};
        cur = nxt; cA = nA; cB = nB; ++ui;
        if (wr == 1) PG8_BAR;
    }
    PG8_WAIT_V(0);
    PG8_BAR;
#undef PG8_SA
#undef PG8_SB
#undef PG8_STAGE
#undef PG8_LDA
#undef PG8_LDB
#undef PG8_MMA
#undef PG8_WAIT_V
#undef PG8_WAIT_L
#undef PG8_BAR
#undef PG8_SCHED
}

__device__ __forceinline__ unsigned cvt_pk_bf16(float lo, float hi) { unsigned r; asm volatile("v_cvt_pk_bf16_f32 %0, %1, %2" : "=v"(r) : "v"(lo), "v"(hi)); return r; }
struct EpiF32 {
    static constexpr bool PERM = false;
    float* out; int ldc; int rows_valid; const float* bias_a; const float* bias_b; int bias_split;
    __device__ __forceinline__ void operator()(const f32x4 (&acc)[2][2][4][2], const Unit& u, int wr, int wc, int fr, int fq) const {
#pragma unroll
        for (int ai = 0; ai < 2; ++ai)
#pragma unroll
            for (int m = 0; m < 4; ++m) { const int row = u.pm * BM + ai * HALF + wr * 64 + m * 16 + fr;
                if (row < rows_valid) {
#pragma unroll
                    for (int bj = 0; bj < 2; ++bj)
#pragma unroll
                        for (int n = 0; n < 2; ++n) { const int col = u.pn * BM + bj * HALF + wc * 32 + n * 16 + 4 * fq; f32x4 v = acc[ai][bj][m][n];
                            if (bias_a) { const f32x4 b = (col < bias_split) ? *(const f32x4*)(bias_a + col) : *(const f32x4*)(bias_b + (col - bias_split)); v += b; }
                            *(f32x4*)(out + (size_t)row * ldc + col) = v; } } }
    }
};
struct EpiRes {
    static constexpr bool PERM = false;
    const float* in_lo; const float* in_hi; float* out; const float* mods; int gate_off; const float* cscale;
    __device__ __forceinline__ void operator()(const f32x4 (&acc)[2][2][4][2], const Unit& u, int wr, int wc, int fr, int fq) const {
#pragma unroll
        for (int ai = 0; ai < 2; ++ai)
#pragma unroll
            for (int m = 0; m < 4; ++m) { const int row = u.pm * BM + ai * HALF + wr * 64 + m * 16 + fr;
                if (row < MR) { const float* gp = mods + (size_t)bidx_of(row) * NADA + gate_off; const float* ip = row < MP ? in_lo + (size_t)row * D : in_hi + (size_t)(row - MP) * D; float* op = out + (size_t)row * D;
#pragma unroll
                    for (int bj = 0; bj < 2; ++bj)
#pragma unroll
                        for (int n = 0; n < 2; ++n) { const int col = u.pn * BM + bj * HALF + wc * 32 + n * 16 + 4 * fq; f32x4 gt = *(const f32x4*)(gp + col);
                            if (cscale) gt *= *(const f32x4*)(cscale + col);
                            const f32x4 x = *(const f32x4*)(ip + col); *(f32x4*)(op + col) = x + gt * acc[ai][bj][m][n]; } } }
    }
};
__device__ __forceinline__ float silu_f(float x) { return x * __builtin_amdgcn_rcpf(1.f + __builtin_amdgcn_exp2f(-1.4426950408889634f * x)); }
struct EpiSwiglu {
    static constexpr bool PERM = true;
    bf16_t* H; int ldh;
    __device__ __forceinline__ void operator()(const f32x4 (&acc)[2][2][4][2], const Unit& u, int wr, int wc, int fr, int fq) const {
        const int row0 = u.pm * BM + wr * 64 + fr, col0 = u.pn * HALF + wc * 32 + 8 * fq;
#pragma unroll
        for (int ai = 0; ai < 2; ++ai)
#pragma unroll
            for (int m = 0; m < 4; ++m) { bf16_t* rowp = H + (size_t)(row0 + ai * HALF + m * 16) * ldh + col0;
                const f32x4 g0 = acc[ai][0][m][0], g1 = acc[ai][0][m][1], u0 = acc[ai][1][m][0], u1 = acc[ai][1][m][1];
                u32x4 w; w.x = cvt_pk_bf16(silu_f(g0[0]) * u0[0], silu_f(g0[1]) * u0[1]); w.y = cvt_pk_bf16(silu_f(g0[2]) * u0[2], silu_f(g0[3]) * u0[3]);
                w.z = cvt_pk_bf16(silu_f(g1[0]) * u1[0], silu_f(g1[1]) * u1[1]); w.w = cvt_pk_bf16(silu_f(g1[2]) * u1[2], silu_f(g1[3]) * u1[3]);
                *(u32x4*)rowp = w; }
    }
};
}

#define XB_TMO      128
#define XB_XCNT(j)  (256  + 64 * (j))
#define XB_XSUB(j)  (1280 + 64 * (j))
#define XB_XGEN(j)  (2304 + 64 * (j))
#define XB_TOP      3328
#define XB_TOPGEN   3392
#define XCD_BAR_WORDS 3456
#define XB_SPIN_CAP (1u << 18)
__device__ __forceinline__ unsigned xb_ld(unsigned* p)              { return __hip_atomic_load(p, __ATOMIC_RELAXED, __HIP_MEMORY_SCOPE_AGENT); }
__device__ __forceinline__ unsigned xb_add(unsigned* p, unsigned v) { return __hip_atomic_fetch_add(p, v, __ATOMIC_RELAXED, __HIP_MEMORY_SCOPE_AGENT); }
__device__ __forceinline__ unsigned xb_xcc_id() { return (unsigned)__builtin_amdgcn_s_getreg((3 << 11) | 20) & 0xFu; }
#define XB_SPIN(cond, bar) do { unsigned _sp = 0; while (cond) { __builtin_amdgcn_s_sleep(1); \
    if ((++_sp & 255u) == 0u) { if (xb_ld(&(bar)[XB_TMO])) break; if (_sp > XB_SPIN_CAP) { atomicAdd(&(bar)[XB_TMO], 1u); break; } } } } while (0)
struct XcdBarrier { unsigned* bar; unsigned x; volatile LAS unsigned* st; };
__device__ __forceinline__ XcdBarrier xcd_barrier_post(unsigned* bar, volatile LAS unsigned* st) {
    XcdBarrier b; b.bar = bar; b.x = xb_xcc_id(); b.st = st;
    if (threadIdx.x == 0) (void)xb_add(&bar[XB_XCNT(b.x)], 1u);
    return b;
}
__device__ __forceinline__ void xcd_barrier_complete(unsigned* bar, unsigned x, unsigned& nloc, unsigned& nx) {
    const unsigned G = gridDim.x * gridDim.y * gridDim.z;
    unsigned sum, cnt, mine, sp = 0u;
    for (;;) {
        sum = 0u; cnt = 0u; mine = 0u;
#pragma unroll
        for (unsigned j = 0; j < 16; ++j) { const unsigned c = xb_ld(&bar[XB_XCNT(j)]); sum += c; cnt += (c > 0u) ? 1u : 0u; mine = (j == x) ? c : mine; }
        if (sum == G) break;
        __builtin_amdgcn_s_sleep(1);
        if ((++sp & 255u) == 0u) { if (xb_ld(&bar[XB_TMO])) break; if (sp > XB_SPIN_CAP) { atomicAdd(&bar[XB_TMO], 1u); break; } }
    }
    nloc = mine > 0u ? mine : 1u; nx = cnt > 0u ? cnt : 1u;
}
__device__ __forceinline__ void xcd_barrier(const XcdBarrier& b) {
    asm volatile("s_waitcnt vmcnt(0)" ::: "memory");
    __syncthreads();
    if (threadIdx.x == 0) {
        unsigned* bar = b.bar;
        __builtin_amdgcn_s_waitcnt(0);
        unsigned nloc = b.st[0], nx = b.st[1];
        if (nloc == 0u) { xcd_barrier_complete(bar, b.x, nloc, nx); b.st[0] = nloc; b.st[1] = nx; }
        const unsigned old = xb_add(&bar[XB_XSUB(b.x)], 1u);
        const unsigned gen = old / nloc;
        if (old + 1u == (gen + 1u) * nloc) {
            __builtin_amdgcn_fence(__ATOMIC_RELEASE, "agent");
            asm volatile("s_waitcnt vmcnt(0)" ::: "memory");
            const unsigned og = xb_add(&bar[XB_TOP], 1u);
            const unsigned tg = og / nx;
            if (og + 1u == (tg + 1u) * nx) xb_add(&bar[XB_TOPGEN], 1u);
            else XB_SPIN(xb_ld(&bar[XB_TOPGEN]) == tg, bar);
            __builtin_amdgcn_fence(__ATOMIC_ACQUIRE, "agent");
            xb_add(&bar[XB_XGEN(b.x)], 1u);
            asm volatile("s_waitcnt vmcnt(0)" ::: "memory");
        } else {
            XB_SPIN(xb_ld(&bar[XB_XGEN(b.x)]) == gen, bar);
            __builtin_amdgcn_fence(__ATOMIC_ACQUIRE, "agent");
            asm volatile("s_waitcnt vmcnt(0)" ::: "memory");
        }
    }
    __syncthreads();
}

constexpr int RING_BYTES = 131072, MISC_OFF = RING_BYTES + 320, LDS_BYTES = 147456;
struct Args { const void* in[27]; float* out; unsigned char* ws; int ph_lo, ph_hi; };
struct Ctx {
    LAS unsigned char* lds; int tid, lane, wave, vcu, G, gw, NGW;
    float* out; unsigned char* ws;
};

__device__ __forceinline__ Ctx fresh(const Ctx& F) { Ctx C = F; asm volatile("" : "+v"(C.tid), "+v"(C.lane), "+s"(C.wave), "+s"(C.vcu), "+s"(C.G), "+s"(C.gw), "+s"(C.NGW), "+s"(C.out), "+s"(C.ws)); return C; }
__device__ __forceinline__ const void* kin(int i) { const char __attribute__((address_space(4)))* kp = (const char __attribute__((address_space(4)))*)__builtin_amdgcn_kernarg_segment_ptr(); asm volatile("" : "+s"(kp));
    return *(const void* const __attribute__((address_space(4)))*)(kp + 8 * i); }
__device__ __forceinline__ void tr_item(const float* W, int N, int K, bf16* WT, int kb, int n0, int drow0, LAS float* scr, int lane) {
    const int k0 = 64 * kb, nn = n0 + (lane & 31); const bool ok = nn < N;
#pragma unroll 8
    for (int i = 0; i < 32; ++i) { const int kk = 2 * i + (lane >> 5); scr[kk * 33 + (lane & 31)] = ok ? W[(size_t)(k0 + kk) * N + nn] : 0.f; }
    LDS_WAIT(); asm volatile("" ::: "memory");
    const int c = lane & 7;
#pragma unroll
    for (int j = 0; j < 4; ++j) { const int n = (lane >> 3) + 8 * j; const LAS float* s = scr + (8 * c) * 33 + n;
        v4u o; o.x = pk2(s[0 * 33], s[1 * 33]); o.y = pk2(s[2 * 33], s[3 * 33]); o.z = pk2(s[4 * 33], s[5 * 33]); o.w = pk2(s[6 * 33], s[7 * 33]);
        *(GAS v4u*)(WT + (size_t)(drow0 + n) * K + k0 + 8 * c) = o; }
    LDS_WAIT(); asm volatile("" ::: "memory");
}
__device__ __forceinline__ void tr_job(const float* W, int N, int K, bf16* WT, int it, int mode, LAS float* scr, int lane) {
    const int nblk = (N + 31) / 32, kb = it / nblk, n0 = 32 * (it % nblk);
    int drow0 = n0;
    if (mode == 1) drow0 = (n0 < DFF) ? 256 * (n0 / 128) + (n0 % 128) : 256 * ((n0 - DFF) / 128) + 128 + ((n0 - DFF) % 128);
    tr_item(W, N, K, WT, kb, n0, drow0, scr, lane);
}
__device__ __forceinline__ void p0_prologue(Ctx& F) {
    LAS float* scr = (LAS float*)(F.lds + F.wave * 16384);
    constexpr int I_ADA = 16 * 96, I_ADAKV = 16 * 64, I_GU = 16 * 176, I_DN = 44 * 32, I_KV = 16 * 48, I_QG = 16 * 34, I_WO = 16 * 32, I_PW = 4 * 8, I_W1 = 64 * 4;
    constexpr int NIT = 8 * I_ADA + I_ADAKV + 4 * I_GU + 4 * I_DN + I_KV + 2 * I_QG + 2 * I_WO + 8 * I_PW + 2 * I_W1;
    for (int it = F.gw; it < NIT; it += F.NGW) {
        int r = it;
        if (r < 8 * I_ADA) { const int s = r / I_ADA; tr_job(((const float*)kin(8)) + (size_t)s * 1024 * 3072, 3072, 1024, ((bf16*)(F.ws + WS_ADAT)) + (size_t)s * 3072 * 1024, r % I_ADA, 0, scr, F.lane); continue; } r -= 8 * I_ADA;
        if (r < I_ADAKV) { tr_job(((const float*)kin(14)), 2048, 1024, ((bf16*)(F.ws + WS_ADAT)) + (size_t)24576 * 1024, r, 0, scr, F.lane); continue; } r -= I_ADAKV;
        if (r < 4 * I_GU) { const int s = r / I_GU; tr_job(((const float*)kin(25)) + (size_t)s * 1024 * NGU, NGU, 1024, ((bf16*)(F.ws + WS_WGU)) + (size_t)s * NGU * 1024, r % I_GU, 1, scr, F.lane); continue; } r -= 4 * I_GU;
        if (r < 4 * I_DN) { const int s = r / I_DN; tr_job(((const float*)kin(26)) + (size_t)s * DFF * 1024, 1024, DFF, ((bf16*)(F.ws + WS_WDN)) + (size_t)s * 1024 * DFF, r % I_DN, 0, scr, F.lane); continue; } r -= 4 * I_DN;
        if (r < I_KV) { tr_job(((const float*)kin(17)), NKV, 1024, ((bf16*)(F.ws + WS_WKV)), r, 0, scr, F.lane); continue; } r -= I_KV;
        if (r < 2 * I_QG) { const int s = r / I_QG; tr_job(((const float*)kin(22)) + (size_t)s * 1024 * NQG, NQG, 1024, ((bf16*)(F.ws + WS_WQG)) + (size_t)s * NQGP * 1024, r % I_QG, 0, scr, F.lane); continue; } r -= 2 * I_QG;
        if (r < 2 * I_WO) { const int s = r / I_WO; tr_job(((const float*)kin(24)) + (size_t)s * 1024 * 1024, 1024, 1024, ((bf16*)(F.ws + WS_WO)) + (size_t)s * 1024 * 1024, r % I_WO, 0, scr, F.lane); continue; } r -= 2 * I_WO;
        if (r < 8 * I_PW) { const int s = r / I_PW; tr_job(((const float*)kin(12)) + (size_t)s * 256 * 256, 256, 256, ((bf16*)(F.ws + WS_POOLW)) + (size_t)s * 256 * 256, r % I_PW, 0, scr, F.lane); continue; } r -= 8 * I_PW;
        { const int s = r / I_W1; tr_job(((const float*)kin(20)) + (size_t)s * 4096 * 128, 128, 4096, ((bf16*)(F.ws + WS_W1T)) + (size_t)s * 128 * 4096, r % I_W1, 0, scr, F.lane); }
    }
    for (int r = F.gw; r < 256; r += F.NGW) {
        const float* src = r < 2 ? ((const float*)kin(6)) + (size_t)r * D : (r < NBATCH ? ((const float*)kin(7)) + (size_t)(r - 2) * D : nullptr);
        unsigned long long* o8 = (unsigned long long*)(((bf16*)(F.ws + WS_CB)) + (size_t)r * D) + F.lane;
#pragma unroll
        for (int j = 0; j < 4; ++j) { f32x4 v = src ? ((const f32x4*)src)[F.lane + 64 * j] : (f32x4){0.f, 0.f, 0.f, 0.f}; o8[64 * j] = (unsigned long long)pk2(v.x, v.y) | ((unsigned long long)pk2(v.z, v.w) << 32); }
    }
    for (int r = F.gw; r < 2 * (NQGP - 1088); r += F.NGW) { const int s = r / (NQGP - 1088), rr = 1088 + r % (NQGP - 1088);
        unsigned long long* o8 = (unsigned long long*)(((bf16*)(F.ws + WS_WQG)) + ((size_t)s * NQGP + rr) * D) + F.lane;
#pragma unroll
        for (int j = 0; j < 4; ++j) o8[64 * j] = 0ull; }
    const int gt = F.gw * 64 + F.lane, NGT = F.NGW * 64;
    for (int e = gt; e < 8193 * 8; e += NGT) { const int pos = e >> 3, i = e & 7;
        const float invs[8] = {1.0f, 0.1939227432012558f, 0.03760603070259094f, 0.007292664609849453f, 0.0014142135623842478f, 0.00027424818836152554f, 5.318296098266728e-05f, 1.0313386155758053e-05f};
        float inv = invs[0];
#pragma unroll
        for (int q = 1; q < 8; ++q) inv = (i == q) ? invs[q] : inv;
        const float ang = (float)pos * inv; const double rev = (double)ang * 0.15915494309189535; const float fr = (float)(rev - floor(rev));
        ((f32x2*)((float*)(F.ws + WS_ROPE)))[e] = (f32x2){__builtin_amdgcn_cosf(fr), __builtin_amdgcn_sinf(fr)}; }
    for (int o = F.gw; o < 256; o += F.NGW) { const int slot = o >> 7, hid = o & 127; float s = 0.f;
        for (int k = F.lane; k < 4096; k += 64) s += ((const float*)kin(19))[slot * 4096 + k] * ((const float*)kin(20))[((size_t)slot * 4096 + k) * 128 + hid];
        s = wave_sum(s); if (F.lane == 0) ((float*)(F.ws + WS_BIASPE))[o] = s; }
    for (int e = gt; e < 32 * 511 * 128; e += NGT) { const int s = e / (511 * 128), r = e % (511 * 128), i = r >> 7, c = r & 127;
        ((f32x4*)(F.out + O_WINS))[((size_t)s * 512 + i) * 128 + c] = ((const f32x4*)((const float*)kin(3)))[((size_t)s * 512 + i + 1) * 128 + c]; }
}

__device__ __forceinline__ const float* xrow(const float* lo, const float* hi, int row) { return row < MP ? lo + (size_t)row * D : hi + (size_t)(row - MP) * D; }
__device__ __forceinline__ void load_row(const float* p, int lane, f32x4 (&v)[4]) {
#pragma unroll
    for (int j = 0; j < 4; ++j) v[j] = ((const f32x4*)p)[lane + 64 * j];
}
__device__ __forceinline__ float row_rstd(const f32x4 (&v)[4]) { float s = 0.f;
#pragma unroll
    for (int j = 0; j < 4; ++j) s += (v[j].x * v[j].x + v[j].y * v[j].y) + (v[j].z * v[j].z + v[j].w * v[j].w);
    return rsqrtf(wave_sum(s) * (1.f / D) + EPS); }
__device__ __forceinline__ void load_mod(const float* mods, int bi, int off, const float* gain, int lane, f32x4 (&A)[4], f32x4 (&S)[4]) {
    const float* mp = mods + (size_t)bi * NADA + off;
#pragma unroll
    for (int j = 0; j < 4; ++j) { const f32x4 g = ((const f32x4*)gain)[lane + 64 * j], sc = ((const f32x4*)(mp + 1024))[lane + 64 * j]; A[j] = g * (sc + 1.f); S[j] = ((const f32x4*)mp)[lane + 64 * j]; }
}
__device__ __forceinline__ void store_row_bf16(bf16* p, int lane, const f32x4 (&v)[4]) {
    unsigned long long* o8 = (unsigned long long*)p + lane;
#pragma unroll
    for (int j = 0; j < 4; ++j) o8[64 * j] = (unsigned long long)pk2(v[j].x, v[j].y) | ((unsigned long long)pk2(v[j].z, v[j].w) << 32);
}
__device__ __forceinline__ void pass_h(Ctx& F, int l, const float* xlo, const float* xhi) {
    const int off = (l * 2 + 0) * 3072; const float* gain = ((const float*)kin(10)) + l * D;
    for (int ch = F.gw; ch < MP / 8; ch += F.NGW) {
        const int b = ch >> 10; f32x4 A[4], S[4]; load_mod(((float*)(F.ws + WS_MODS)), b, off, gain, F.lane, A, S);
        for (int r = 0; r < 8; ++r) { const int row = ch * 8 + r, t = row & (SEQ - 1); f32x4 v[4]; load_row(xrow(xlo, xhi, row), F.lane, v); const float rs = row_rstd(v);
#pragma unroll
            for (int j = 0; j < 4; ++j) { v[j] = v[j] * rs * A[j] + S[j]; ((f32x4*)(((float*)(F.ws + WS_H0)) + (size_t)row * D))[F.lane + 64 * j] = v[j]; }
            if (t >= SEQ - 15) { float* po = F.out + O_POOLP + ((size_t)(l * 2 + b) * 15 + (t - (SEQ - 15))) * D;
#pragma unroll
                for (int j = 0; j < 4; ++j) ((f32x4*)po)[F.lane + 64 * j] = v[j]; } }
    }
    for (int s = F.gw; s < NBS; s += F.NGW) {
        const int row = MP + s; f32x4 A[4], S[4], v[4]; load_mod(((float*)(F.ws + WS_MODS)), 2 + s, off, gain, F.lane, A, S); load_row(xrow(xlo, xhi, row), F.lane, v); const float rs = row_rstd(v);
        const float* sp = ((const float*)kin(4)) + ((size_t)(l * 32 + s) * 15) * D; float* po = F.out + O_POOLS + ((size_t)(l * 32 + s) * 15) * D; f32x4 pl[4];
#pragma unroll
        for (int j = 0; j < 4; ++j) { v[j] = v[j] * rs * A[j] + S[j]; const int w = 2 << j; f32x4 sum = v[j];
            for (int k = 1; k < w; ++k) sum += ((const f32x4*)(sp + (size_t)(15 - k) * D))[F.lane + 64 * j];
            pl[j] = sum * (1.f / (float)w) - v[j]; ((f32x4*)(po + (size_t)14 * D))[F.lane + 64 * j] = v[j]; }
        store_row_bf16(((bf16*)(F.ws + WS_XN2)) + (size_t)row * D, F.lane, pl);
        for (int i = 0; i < 14; ++i)
#pragma unroll
            for (int j = 0; j < 4; ++j) ((f32x4*)(po + (size_t)i * D))[F.lane + 64 * j] = ((const f32x4*)(sp + (size_t)(i + 1) * D))[F.lane + 64 * j];
    }
}
__device__ __forceinline__ void pass_pool(Ctx& F) {
    for (int ch = F.gw; ch < MP / 8; ch += F.NGW) {
        const int row0 = ch * 8, t0 = row0 & (SEQ - 1); f32x4 Sw[4];
#pragma unroll
        for (int j = 0; j < 4; ++j) { const int w = 2 << j; Sw[j] = (f32x4){0.f, 0.f, 0.f, 0.f};
            for (int k = 1; k < w; ++k) if (t0 - k >= 0) Sw[j] += ((const f32x4*)(((float*)(F.ws + WS_H0)) + (size_t)(row0 - k) * D))[F.lane + 64 * j]; }
        for (int r = 0; r < 8; ++r) { const int row = row0 + r, t = t0 + r; f32x4 h[4], pl[4]; load_row(((float*)(F.ws + WS_H0)) + (size_t)row * D, F.lane, h);
#pragma unroll
            for (int j = 0; j < 4; ++j) { const int w = 2 << j; Sw[j] += h[j]; const int cnt = (t + 1) < w ? (t + 1) : w; pl[j] = Sw[j] * (1.f / (float)cnt) - h[j];
                if (t - w + 1 >= 0) Sw[j] -= ((const f32x4*)(((float*)(F.ws + WS_H0)) + (size_t)(row - w + 1) * D))[F.lane + 64 * j]; }
            store_row_bf16(((bf16*)(F.ws + WS_XN2)) + (size_t)row * D, F.lane, pl); }
    }
}
__device__ __forceinline__ void pass_norm(Ctx& F, const float* xlo, const float* xhi, const float* gain1, int off1, bf16* out1, const float* gain2, int off2, bf16* out2) {
    for (int ch = F.gw; ch < (MR + 7) / 8; ch += F.NGW) {
        const int row0 = ch * 8; const bool uni = row0 < MP; f32x4 A1[4], S1[4], A2[4], S2[4];
        if (uni) { load_mod(((float*)(F.ws + WS_MODS)), row0 >> 13, off1, gain1, F.lane, A1, S1); if (out2) load_mod(((float*)(F.ws + WS_MODS)), row0 >> 13, off2, gain2, F.lane, A2, S2); }
        for (int r = 0; r < 8; ++r) { const int row = row0 + r; if (row >= MR) break;
            if (!uni) { load_mod(((float*)(F.ws + WS_MODS)), bidx_of(row), off1, gain1, F.lane, A1, S1); if (out2) load_mod(((float*)(F.ws + WS_MODS)), bidx_of(row), off2, gain2, F.lane, A2, S2); }
            f32x4 v[4], o[4]; load_row(xrow(xlo, xhi, row), F.lane, v); const float rs = row_rstd(v);
#pragma unroll
            for (int j = 0; j < 4; ++j) o[j] = v[j] * rs * A1[j] + S1[j];
            store_row_bf16(out1 + (size_t)row * D, F.lane, o);
            if (out2) {
#pragma unroll
                for (int j = 0; j < 4; ++j) o[j] = v[j] * rs * A2[j] + S2[j];
                store_row_bf16(out2 + (size_t)row * D, F.lane, o); } }
    }
}
__device__ __forceinline__ float rope_lane(float v, int lane, const float* ropep  ) {
    const float other = __shfl_xor(v, 8);
    if (lane < 16) { const f32x2 cs = ((const f32x2*)ropep)[lane & 7]; v = (lane < 8) ? v * cs.x - other * cs.y : v * cs.x + other * cs.y; }
    return v;
}
__device__ __forceinline__ void pass_kvpost(Ctx& F) {
    const int lane = F.lane; const float kn1 = ((const float*)kin(18))[64 + lane], kn2 = ((const float*)kin(18))[128 + lane];
    for (int row = F.gw; row < MR; row += F.NGW) {
        const int pos = row < MP ? (row & (SEQ - 1)) : SEQ; const float* rp = ((float*)(F.ws + WS_ROPE)) + (size_t)pos * 16; const float* raw = ((float*)(F.ws + WS_RAWKV)) + (size_t)row * NKV;
        float* kvo = F.out + O_KV + (size_t)row * 1024; bf16* kvb = ((bf16*)(F.ws + WS_KVB)) + (size_t)row * 1024; bf16* wb = ((bf16*)(F.ws + WS_WINB)) + (size_t)row * 512;
        float* wo = nullptr;
        if (row < MP) { if (pos >= SEQ - 512) wo = F.out + O_WINP + ((size_t)(row >> 13) * 512 + (pos - (SEQ - 512))) * 512; } else wo = F.out + O_WINS + ((size_t)(row - MP) * 512 + 511) * 512;
#pragma unroll 4
        for (int hh = 0; hh < 24; ++hh) { const int slot = hh >> 2, kvh = hh & 3; float v = raw[hh * 64 + lane];
            if (slot == 2 || slot == 4) { const float ss = wave_sum(v * v); v = v * rsqrtf(ss * (1.f / 64.f) + EPS) * (slot == 2 ? kn1 : kn2); v = rope_lane(v, lane, rp); }
            if (slot < 4) { kvo[slot * 256 + kvh * 64 + lane] = v; kvb[slot * 256 + kvh * 64 + lane] = (bf16)f2bf(v); }
            else { wb[(slot - 4) * 256 + kvh * 64 + lane] = (bf16)f2bf(v); if (wo) wo[(slot - 4) * 256 + kvh * 64 + lane] = v; } }
    }
}
__device__ __forceinline__ void pass_qpost(Ctx& F, int j) {
    const int lane = F.lane; const float qn = ((const float*)kin(23))[j * 64 + lane];
    for (int row = F.gw; row < MR; row += F.NGW) {
        const int pos = row < MP ? (row & (SEQ - 1)) : SEQ; const float* rp = ((float*)(F.ws + WS_ROPE)) + (size_t)pos * 16; const float* raw = ((float*)(F.ws + WS_RAWQ)) + (size_t)row * NQGP; bf16* qb = ((bf16*)(F.ws + WS_QB)) + (size_t)row * D;
#pragma unroll 4
        for (int h = 0; h < 16; ++h) { float v = raw[h * 64 + lane]; const float ss = wave_sum(v * v); v = v * rsqrtf(ss * (1.f / 64.f) + EPS) * qn; v = rope_lane(v, lane, rp); qb[h * 64 + lane] = (bf16)f2bf(v * C2); }
        if (lane < 48) { const float g = raw[1024 + lane]; ((float*)(F.ws + WS_GATES))[(size_t)row * 48 + lane] = __builtin_amdgcn_rcpf(1.f + __builtin_amdgcn_exp2f(-1.4426950408889634f * g)); }
    }
}

__device__ __forceinline__ float gelu_tanh(float x) { const float u = 0.7978845608028654f * (x + 0.044715f * x * x * x); return x * __builtin_amdgcn_rcpf(1.f + __builtin_amdgcn_exp2f(-2.f * 1.4426950408889634f * u)); }
__device__ __forceinline__ bf16x8 pack8(const f32x4 a, const f32x4 b) { v4u w; w.x = pk2(a.x, a.y); w.y = pk2(a.z, a.w); w.z = pk2(b.x, b.y); w.w = pk2(b.z, b.w); return __builtin_bit_cast(bf16x8, w); }
__device__ __forceinline__ void compress_phase(Ctx& F) {
    const int lane = F.lane, wid = F.wave, tid = F.tid, n = lane & 15, kq = lane >> 4;
    const int nper = (NBLKT + F.G - 1) / F.G, c0 = F.vcu * nper; int n_cu = NBLKT - c0; n_cu = n_cu < 0 ? 0 : (n_cu > nper ? nper : n_cu);
    if (nper > 32) return;
    const int nbw = (nper + 7) / 8, bw0 = wid * nbw; int nb_w = n_cu - bw0; nb_w = nb_w < 0 ? 0 : (nb_w > nbw ? nbw : nb_w);
    const int bl = n >> 2, kvh = n & 3; const bool vcol = bl < nb_w;
    int gblk = c0 + bw0 + (vcol ? bl : 0); gblk = gblk < NBLKT ? gblk : NBLKT - 1;
    const int bb = gblk >> 7, blk = gblk & 127;
    const float* base = bb < 2 ? F.out + O_KV + ((size_t)(bb * SEQ + blk * 64)) * 1024 : ((const float*)kin(2)) + ((size_t)((const int*)kin(5))[(bb - 2) * 64 + (blk >> 1)] * 128 + (blk & 1) * 64) * 1024;
    const float* lp = base + kvh * 64 + 8 * kq;
    unsigned soff[2];
#pragma unroll
    for (int i = 0; i < 2; ++i) { int R, C; pg8::stage_rc(tid * 16 + i * 8192, R, C); soff[i] = (unsigned)(R * 4096 + C) * 2u; }
    const int foff = pg8::lds_byte(n, kq * 8);
    LAS unsigned char* lds = F.lds;
#define CSTAGE(buf, s) do { _Pragma("unroll") for (int sl = 0; sl < 2; ++sl) _Pragma("unroll") for (int _i = 0; _i < 2; ++_i) \
        __builtin_amdgcn_global_load_lds((const unsigned*)((const char*)(((bf16*)(F.ws + WS_W1T)) + (size_t)sl * 128 * 4096 + (size_t)(s) * 64) + soff[_i]), (LAS unsigned*)(lds + ((buf) * 2 + sl) * 16384 + wid * 1024 + _i * 8192), 16, 0, 0); } while (0)
    f32x4 acc[2][8];
#pragma unroll
    for (int sl = 0; sl < 2; ++sl)
#pragma unroll
        for (int mt = 0; mt < 8; ++mt) acc[sl][mt] = (f32x4){0.f, 0.f, 0.f, 0.f};
    f32x4 raw[2][2][2];
#define CLOAD(s) do { _Pragma("unroll") for (int sl = 0; sl < 2; ++sl) _Pragma("unroll") for (int e = 0; e < 2; ++e) { const float* p_ = lp + (size_t)(s) * 1024 + sl * 256 + 32 * e; raw[sl][e][0] = *(const f32x4*)p_; raw[sl][e][1] = *(const f32x4*)(p_ + 4); } } while (0)
    __syncthreads();
    CSTAGE(0, 0); CLOAD(0);
    VM_WAIT(); __syncthreads();
    for (int s = 0; s < 64; ++s) {
        const int buf = s & 1; bf16x8 bfr[2][2];
#pragma unroll
        for (int sl = 0; sl < 2; ++sl)
#pragma unroll
            for (int e = 0; e < 2; ++e) bfr[sl][e] = pack8(raw[sl][e][0], raw[sl][e][1]);
        if (s + 1 < 64) { CSTAGE(buf ^ 1, s + 1); CLOAD(s + 1); }
#pragma unroll
        for (int sl = 0; sl < 2; ++sl)
#pragma unroll
            for (int e = 0; e < 2; ++e) { bf16x8 af[8];
#pragma unroll
                for (int mt = 0; mt < 8; ++mt) af[mt] = *(const LAS bf16x8*)(lds + (buf * 2 + sl) * 16384 + foff + mt * 2048 + e * 1024);
#pragma unroll
                for (int mt = 0; mt < 8; ++mt) acc[sl][mt] = __builtin_amdgcn_mfma_f32_16x16x32_bf16(af[mt], bfr[sl][e], acc[sl][mt], 0, 0, 0);
                __builtin_amdgcn_sched_barrier(0); }
        VM_WAIT(); __syncthreads();
    }
#undef CSTAGE
#undef CLOAD
#pragma unroll
    for (int sl = 0; sl < 2; ++sl) {
        bf16x8 hb[4];
#pragma unroll
        for (int e2 = 0; e2 < 4; ++e2) { f32x4 a = acc[sl][2 * e2] + *(const f32x4*)(((float*)(F.ws + WS_BIASPE)) + sl * 128 + 32 * e2 + 4 * kq), b = acc[sl][2 * e2 + 1] + *(const f32x4*)(((float*)(F.ws + WS_BIASPE)) + sl * 128 + 32 * e2 + 16 + 4 * kq);
            a = (f32x4){gelu_tanh(a.x), gelu_tanh(a.y), gelu_tanh(a.z), gelu_tanh(a.w)}; b = (f32x4){gelu_tanh(b.x), gelu_tanh(b.y), gelu_tanh(b.z), gelu_tanh(b.w)}; hb[e2] = pack8(a, b); }
        f32x4 o[4];
        const float* w2b = ((const float*)kin(21)) + (size_t)sl * 128 * 64 + n;
#pragma unroll
        for (int mt2 = 0; mt2 < 4; ++mt2) { o[mt2] = (f32x4){0.f, 0.f, 0.f, 0.f};
#pragma unroll
            for (int e2 = 0; e2 < 4; ++e2) { const float* w2 = w2b + 16 * mt2; float wv[8];
#pragma unroll
                for (int jj = 0; jj < 8; ++jj) wv[jj] = w2[(size_t)(32 * e2 + 16 * (jj >> 2) + 4 * kq + (jj & 3)) * 64];
                const bf16x8 a = pack8((f32x4){wv[0], wv[1], wv[2], wv[3]}, (f32x4){wv[4], wv[5], wv[6], wv[7]});
                o[mt2] = __builtin_amdgcn_mfma_f32_16x16x32_bf16(a, hb[e2], o[mt2], 0, 0, 0); __builtin_amdgcn_sched_barrier(0); } }
        if (sl == 0) {
            float ss = 0.f;
#pragma unroll
            for (int mt2 = 0; mt2 < 4; ++mt2) ss += (o[mt2].x * o[mt2].x + o[mt2].y * o[mt2].y) + (o[mt2].z * o[mt2].z + o[mt2].w * o[mt2].w);
            ss += __shfl_xor(ss, 16); ss += __shfl_xor(ss, 32);
            const float rs = rsqrtf(ss * (1.f / 64.f) + EPS);
#pragma unroll
            for (int mt2 = 0; mt2 < 4; ++mt2) o[mt2] = o[mt2] * rs * *(const f32x4*)(((const float*)kin(18)) + 16 * mt2 + 4 * kq);
            const int pos = (blk + 1) * 64 - 1; const float* rp = ((float*)(F.ws + WS_ROPE)) + (size_t)pos * 16 + (4 * (kq & 1)) * 2;
            f32x4 other; other.x = __shfl_xor(o[0].x, 32); other.y = __shfl_xor(o[0].y, 32); other.z = __shfl_xor(o[0].z, 32); other.w = __shfl_xor(o[0].w, 32);
            const f32x4 cs0 = *(const f32x4*)rp, cs1 = *(const f32x4*)(rp + 4); const f32x4 cv = {cs0.x, cs0.z, cs1.x, cs1.z}, sv = {cs0.y, cs0.w, cs1.y, cs1.w};
            o[0] = (kq < 2) ? o[0] * cv - other * sv : o[0] * cv + other * sv;
        }
        if (vcol) { float* dst = (sl == 0 ? ((float*)(F.ws + WS_KC)) : ((float*)(F.ws + WS_VC))) + ((size_t)(bb * NBLK + blk) * 4 + kvh) * 64 + 4 * kq;
#pragma unroll
            for (int mt2 = 0; mt2 < 4; ++mt2) *(f32x4*)(dst + 16 * mt2) = o[mt2]; }
    }
    __syncthreads();
}

struct Soft { float m[4], l[4], o[4]; };
__device__ __forceinline__ void soft_init(Soft& s) {
#pragma unroll
    for (int g = 0; g < 4; ++g) { s.m[g] = -1e30f; s.l[g] = 0.f; s.o[g] = 0.f; } }
template <class KF, class VF>
__device__ __forceinline__ void attn_block64(LAS float* qs, LAS float* ps, bool valid, KF kf, VF vf, Soft& st, float (&sc)[4], int lane) {
#pragma unroll
    for (int g = 0; g < 4; ++g) sc[g] = 0.f;
#pragma unroll
    for (int d8 = 0; d8 < 8; ++d8) { float kv[8]; kf(d8, kv);
#pragma unroll
        for (int g = 0; g < 4; ++g) { const f32x4 q0 = *(const LAS f32x4*)(qs + g * 64 + d8 * 8), q1 = *(const LAS f32x4*)(qs + g * 64 + d8 * 8 + 4);
            sc[g] += (q0.x * kv[0] + q0.y * kv[1]) + (q0.z * kv[2] + q0.w * kv[3]) + (q1.x * kv[4] + q1.y * kv[5]) + (q1.z * kv[6] + q1.w * kv[7]); } }
    f32x4 pv;
#pragma unroll
    for (int g = 0; g < 4; ++g) { const float sg = valid ? sc[g] : -1e30f; const float mn = fmaxf(st.m[g], wave_max(sg));
        const float p = valid ? __builtin_amdgcn_exp2f(sg - mn) : 0.f; const float corr = __builtin_amdgcn_exp2f(st.m[g] - mn);
        st.l[g] = st.l[g] * corr + wave_sum(p); st.o[g] *= corr; st.m[g] = mn; pv[g] = p; }
    *(LAS f32x4*)(ps + lane * 4) = pv;
    LDS_WAIT(); asm volatile("" ::: "memory");
#pragma unroll 8
    for (int key = 0; key < 64; ++key) { const f32x4 pp = *(const LAS f32x4*)(ps + key * 4); const float v = vf(key);
        st.o[0] += pp.x * v; st.o[1] += pp.y * v; st.o[2] += pp.z * v; st.o[3] += pp.w * v; }
    LDS_WAIT(); asm volatile("" ::: "memory");
}
__device__ __forceinline__ void ld8_bf16(const bf16* p, float (&kv)[8]) { const v4u w = *(const v4u*)p;
    kv[0] = __builtin_bit_cast(float, w.x << 16); kv[1] = __builtin_bit_cast(float, w.x & 0xffff0000u); kv[2] = __builtin_bit_cast(float, w.y << 16); kv[3] = __builtin_bit_cast(float, w.y & 0xffff0000u);
    kv[4] = __builtin_bit_cast(float, w.z << 16); kv[5] = __builtin_bit_cast(float, w.z & 0xffff0000u); kv[6] = __builtin_bit_cast(float, w.w << 16); kv[7] = __builtin_bit_cast(float, w.w & 0xffff0000u); }
__device__ __forceinline__ void ld8_f32(const float* p, float (&kv)[8]) { const f32x4 a = *(const f32x4*)p, b = *(const f32x4*)(p + 4); kv[0] = a.x; kv[1] = a.y; kv[2] = a.z; kv[3] = a.w; kv[4] = b.x; kv[5] = b.y; kv[6] = b.z; kv[7] = b.w; }

__device__ __forceinline__ void cmp_and_select(Ctx& F, LAS float* qs, LAS float* ps, int bb, int kvh, int t, float (&oc)[4], unsigned long long& msk0, unsigned long long& msk1) {
    const int lane = F.lane, cur = t >> 6; Soft st; soft_init(st); float sc0[4], sc1[4];
    const float* kcb = ((float*)(F.ws + WS_KC)) + ((size_t)bb * NBLK * 4 + kvh) * 64; const float* vcb = ((float*)(F.ws + WS_VC)) + ((size_t)bb * NBLK * 4 + kvh) * 64;
    const bool v0 = (lane + 1) * 64 - 1 <= t, v1 = (lane + 65) * 64 - 1 <= t;
    attn_block64(qs, ps, v0, [&](int d8, float (&kv)[8]) { ld8_f32(kcb + (size_t)lane * 256 + d8 * 8, kv); }, [&](int key) { return vcb[(size_t)key * 256 + lane]; }, st, sc0, lane);
    attn_block64(qs, ps, v1, [&](int d8, float (&kv)[8]) { ld8_f32(kcb + (size_t)(64 + lane) * 256 + d8 * 8, kv); }, [&](int key) { return vcb[(size_t)(64 + key) * 256 + lane]; }, st, sc1, lane);
    float imp0 = 0.f, imp1 = 0.f;
#pragma unroll
    for (int g = 0; g < 4; ++g) { const float il = st.l[g] > 0.f ? 1.f / st.l[g] : 0.f; oc[g] = st.o[g] * il;
        imp0 += v0 ? __builtin_amdgcn_exp2f(sc0[g] - st.m[g]) * il : 0.f; imp1 += v1 ? __builtin_amdgcn_exp2f(sc1[g] - st.m[g]) * il : 0.f; }
    bool s0, s1;
    if (cur <= 15) { s0 = lane <= cur; s1 = false; }
    else {
        const int b0 = lane, b1 = lane + 64; const bool c0 = b0 >= 1 && b0 <= cur - 2, c1 = b1 >= 1 && b1 <= cur - 2;
        const float x0 = c0 ? imp0 : -1.f, x1 = c1 ? imp1 : -1.f; int r0 = 0, r1 = 0;
        for (int k = 0; k < 64; ++k) { const float y0 = __shfl(x0, k), y1 = __shfl(x1, k);
            r0 += (y0 > x0 || (y0 == x0 && k < b0)) ? 1 : 0; r0 += (y1 > x0 || (y1 == x0 && (k + 64) < b0)) ? 1 : 0;
            r1 += (y0 > x1 || (y0 == x1 && k < b1)) ? 1 : 0; r1 += (y1 > x1 || (y1 == x1 && (k + 64) < b1)) ? 1 : 0; }
        s0 = (b0 == 0) || (b0 == cur) || (b0 == cur - 1) || (c0 && r0 < 13); s1 = (b1 == cur) || (b1 == cur - 1) || (c1 && r1 < 13);
    }
    msk0 = __ballot(s0); msk1 = __ballot(s1);
}
__device__ __forceinline__ void attn_prompt_naive(Ctx& F) {
    const int lane = F.lane; LAS float* qs = (LAS float*)(F.lds + F.wave * 2048); LAS float* ps = qs + 256;
    for (int task = F.gw; task < MP * 4; task += F.NGW) {
        const int row = task >> 2, kvh = task & 3, b = row >> 13, t = row & (SEQ - 1);
#pragma unroll
        for (int g = 0; g < 4; ++g) qs[g * 64 + lane] = bf2f(((bf16*)(F.ws + WS_QB))[(size_t)row * D + (kvh * 4 + g) * 64 + lane]);
        LDS_WAIT(); asm volatile("" ::: "memory");
        float oc[4]; unsigned long long m0, m1; cmp_and_select(F, qs, ps, b, kvh, t, oc, m0, m1);
        Soft ss; soft_init(ss); float scd[4];
        for (int half = 0; half < 2; ++half) { unsigned long long mm = half ? m1 : m0;
            while (mm) { const int j = __builtin_ctzll(mm) + 64 * half; mm &= mm - 1; if (j * 64 > t) continue;
                const int kp = j * 64 + lane; const bf16* kb = ((bf16*)(F.ws + WS_KVB)) + ((size_t)(b * SEQ + kp) * 16 + 8 + kvh) * 64; const bf16* vb = ((bf16*)(F.ws + WS_KVB)) + ((size_t)(b * SEQ + j * 64) * 16 + 12 + kvh) * 64 + lane;
                attn_block64(qs, ps, kp <= t, [&](int d8, float (&kv)[8]) { ld8_bf16(kb + d8 * 8, kv); }, [&](int key) { return bf2f(vb[(size_t)key * 1024]); }, ss, scd, lane); } }
        Soft sw; soft_init(sw);
        for (int c = 0; c < 8; ++c) { const int p0 = t - 511 + 64 * c; if (p0 + 63 < 0) continue;
            const int p = p0 + lane, pc = p < 0 ? 0 : p; const bf16* kb = ((bf16*)(F.ws + WS_WINB)) + ((size_t)(b * SEQ + pc) * 8 + kvh) * 64;
            attn_block64(qs, ps, p >= 0, [&](int d8, float (&kv)[8]) { ld8_bf16(kb + d8 * 8, kv); },
                         [&](int key) { int pk = p0 + key; pk = pk < 0 ? 0 : pk; return bf2f(((bf16*)(F.ws + WS_WINB))[((size_t)(b * SEQ + pk) * 8 + 4 + kvh) * 64 + lane]); }, sw, scd, lane); }
#pragma unroll
        for (int g = 0; g < 4; ++g) { const float* gt = ((float*)(F.ws + WS_GATES)) + (size_t)row * 48 + (kvh * 4 + g) * 3;
            const float os = ss.l[g] > 0.f ? ss.o[g] / ss.l[g] : 0.f, ow = sw.l[g] > 0.f ? sw.o[g] / sw.l[g] : 0.f;
            ((bf16*)(F.ws + WS_OB))[(size_t)row * D + (kvh * 4 + g) * 64 + lane] = (bf16)f2bf(gt[0] * oc[g] + gt[1] * os + gt[2] * ow); }
    }
}
__device__ __forceinline__ void attn_sample_naive(Ctx& F) {
    const int lane = F.lane; LAS float* qs = (LAS float*)(F.lds + F.wave * 2048); LAS float* ps = qs + 256;
    for (int task = F.gw; task < NBS * 4; task += F.NGW) {
        const int s = task >> 2, kvh = task & 3, row = MP + s, t = SEQ;
#pragma unroll
        for (int g = 0; g < 4; ++g) qs[g * 64 + lane] = bf2f(((bf16*)(F.ws + WS_QB))[(size_t)row * D + (kvh * 4 + g) * 64 + lane]);
        LDS_WAIT(); asm volatile("" ::: "memory");
        float oc[4]; unsigned long long m0, m1; cmp_and_select(F, qs, ps, 2 + s, kvh, t, oc, m0, m1);
        Soft ss; soft_init(ss); float scd[4];
        for (int half = 0; half < 2; ++half) { unsigned long long mm = half ? m1 : m0;
            while (mm) { const int j = __builtin_ctzll(mm) + 64 * half; mm &= mm - 1;
                const float* pg = ((const float*)kin(2)) + ((size_t)((const int*)kin(5))[s * 64 + (j >> 1)] * 128 + (j & 1) * 64) * 1024;
                const float* kb = pg + (size_t)lane * 1024 + 512 + kvh * 64; const float* vb = pg + 768 + kvh * 64 + lane;
                attn_block64(qs, ps, true, [&](int d8, float (&kv)[8]) { ld8_f32(kb + d8 * 8, kv); }, [&](int key) { return vb[(size_t)key * 1024]; }, ss, scd, lane); } }
        {
            const float* nr = F.out + O_KV + (size_t)row * 1024;
            attn_block64(qs, ps, lane == 0, [&](int d8, float (&kv)[8]) { ld8_f32(nr + 512 + kvh * 64 + d8 * 8, kv); }, [&](int) { return nr[768 + kvh * 64 + lane]; }, ss, scd, lane); }
        Soft sw; soft_init(sw);
        const float* wb = F.out + O_WINS + (size_t)s * 512 * 512;
        for (int c = 0; c < 8; ++c) { const float* kb = wb + (size_t)(64 * c + lane) * 512 + kvh * 64; const float* vb = wb + (size_t)(64 * c) * 512 + 256 + kvh * 64 + lane;
            attn_block64(qs, ps, true, [&](int d8, float (&kv)[8]) { ld8_f32(kb + d8 * 8, kv); }, [&](int key) { return vb[(size_t)key * 512]; }, sw, scd, lane); }
#pragma unroll
        for (int g = 0; g < 4; ++g) { const float* gt = ((float*)(F.ws + WS_GATES)) + (size_t)row * 48 + (kvh * 4 + g) * 3;
            const float os = ss.l[g] > 0.f ? ss.o[g] / ss.l[g] : 0.f, ow = sw.l[g] > 0.f ? sw.o[g] / sw.l[g] : 0.f;
            ((bf16*)(F.ws + WS_OB))[(size_t)row * D + (kvh * 4 + g) * 64 + lane] = (bf16)f2bf(gt[0] * oc[g] + gt[1] * os + gt[2] * ow); }
    }
}

constexpr int NPHASES = 31;
__global__ void __launch_bounds__(512, 2) mk_fwd(Args args) {
    extern __shared__ __attribute__((aligned(16))) unsigned char lds_raw[];
    Ctx F;
    F.lds = (LAS unsigned char*)lds_raw; F.tid = threadIdx.x; F.lane = F.tid & 63; F.wave = __builtin_amdgcn_readfirstlane(F.tid >> 6);
    F.G = gridDim.x; { const int bx = blockIdx.x; F.vcu = (F.G % 8 == 0) ? (bx % 8) * (F.G / 8) + bx / 8 : bx; }
    F.gw = F.vcu * 8 + F.wave; F.NGW = F.G * 8;
    F.out = args.out; F.ws = args.ws; unsigned char* ws = args.ws;
    volatile LAS unsigned* MISC = (volatile LAS unsigned*)(F.lds + MISC_OFF);
    for (int u = F.tid; u < (LDS_BYTES - RING_BYTES) / 4; u += 512) ((LAS unsigned*)(F.lds + RING_BYTES))[u] = 0u;
    __syncthreads();
    unsigned* ctl = (unsigned*)(ws + WS_CTL);
    XcdBarrier bar; bar.bar = ctl + CW_BAR; bar.x = 0; bar.st = nullptr;
    const int lo = args.ph_lo, hi = args.ph_hi;
    if (hi - lo > 1) bar = xcd_barrier_post(ctl + CW_BAR, MISC + 8);
    int ph = 0;
    const Ctx& F0 = F;
#define PH_BEGIN if (ph >= lo && ph < hi) { Ctx F = fresh(F0); float* X = F.out + O_Y; (void)X;
#define PH_CLOSE } do { if (ph >= lo && ph + 1 < hi) xcd_barrier(bar); ++ph; } while (0)
#define XLO (l == 0 ? (const float*)kin(0) : (const float*)X)
#define XHI (l == 0 ? (const float*)kin(1) : (const float*)(X + (size_t)MP * D))
#define WSB(off) ((bf16*)(F.ws + (off)))
#define WSF(off) ((float*)(F.ws + (off)))
    const int bxi = (int)blockIdx.x;
    PH_BEGIN p0_prologue(F); PH_CLOSE;
    PH_BEGIN pg8::Gemm g{WSB(WS_CB), WSB(WS_ADAT), D, D, D, 0}; pg8::StaticOrder S; S.init(256, NADA, F.G, bxi); pg8::EpiF32 E{WSF(WS_MODS), NADA, 64, (const float*)kin(9), (const float*)kin(15), 8 * 3072};
        pg8::gemm_phase(F.lds, g, S, E); PH_CLOSE;
    for (int l = 0; l < 4; ++l) {
        if (l < 2) {
            PH_BEGIN pass_h(F, l, XLO, XHI); PH_CLOSE;
            PH_BEGIN pass_pool(F); PH_CLOSE;
            PH_BEGIN pg8::Gemm g{WSB(WS_XN2), WSB(WS_POOLW) + (size_t)l * 1024 * 256, D, 256, 256, 256}; pg8::StaticOrder S; S.init(MPAD, D, F.G, bxi);
                pg8::EpiRes E{XLO, XHI, X, WSF(WS_MODS), (l * 2 + 0) * 3072 + 2048, (const float*)kin(13) + l * D}; pg8::gemm_phase(F.lds, g, S, E); PH_CLOSE;
        } else {
            const int j = l - 2;
            PH_BEGIN if (l == 2) pass_norm(F, X, X + (size_t)MP * D, (const float*)kin(10) + l * D, (l * 2 + 0) * 3072, WSB(WS_XN), (const float*)kin(16), 8 * 3072, WSB(WS_XN2));
                     else pass_norm(F, X, X + (size_t)MP * D, (const float*)kin(10) + l * D, (l * 2 + 0) * 3072, WSB(WS_XN), nullptr, 0, nullptr); PH_CLOSE;
            PH_BEGIN
                if (l == 2) { pg8::Gemm g{WSB(WS_XN2), WSB(WS_WKV), D, D, D, 0}; pg8::StaticOrder S; S.init(MPAD, NKV, F.G, bxi); pg8::EpiF32 E{WSF(WS_RAWKV), NKV, MPAD, nullptr, nullptr, 0}; pg8::gemm_phase(F.lds, g, S, E); }
                { pg8::Gemm g{WSB(WS_XN), WSB(WS_WQG) + (size_t)j * NQGP * D, D, D, D, 0}; pg8::StaticOrder S; S.init(MPAD, NQGP, F.G, bxi); pg8::EpiF32 E{WSF(WS_RAWQ), NQGP, MPAD, nullptr, nullptr, 0}; pg8::gemm_phase(F.lds, g, S, E); }
            PH_CLOSE;
            PH_BEGIN if (l == 2) pass_kvpost(F); pass_qpost(F, j); PH_CLOSE;
            if (l == 2) { PH_BEGIN compress_phase(F); PH_CLOSE; }
            PH_BEGIN attn_sample_naive(F); attn_prompt_naive(F); PH_CLOSE;
            PH_BEGIN pg8::Gemm g{WSB(WS_OB), WSB(WS_WO) + (size_t)j * D * D, D, D, D, 0}; pg8::StaticOrder S; S.init(MPAD, D, F.G, bxi);
                pg8::EpiRes E{X, X + (size_t)MP * D, X, WSF(WS_MODS), (l * 2 + 0) * 3072 + 2048, nullptr}; pg8::gemm_phase(F.lds, g, S, E); PH_CLOSE;
        }
        PH_BEGIN pass_norm(F, X, X + (size_t)MP * D, (const float*)kin(11) + l * D, (l * 2 + 1) * 3072, WSB(WS_XN), nullptr, 0, nullptr); PH_CLOSE;
        PH_BEGIN pg8::Gemm g{WSB(WS_XN), WSB(WS_WGU) + (size_t)l * NGU * D, D, D, D, 0}; pg8::StaticOrder S; S.init(MPAD, NGU, F.G, bxi); pg8::EpiSwiglu E{WSB(WS_H), DFF}; pg8::gemm_phase(F.lds, g, S, E); PH_CLOSE;
        PH_BEGIN pg8::Gemm g{WSB(WS_H), WSB(WS_WDN) + (size_t)l * D * DFF, DFF, DFF, DFF, 0}; pg8::StaticOrder S; S.init(MPAD, D, F.G, bxi);
            pg8::EpiRes E{X, X + (size_t)MP * D, X, WSF(WS_MODS), (l * 2 + 1) * 3072 + 2048, nullptr}; pg8::gemm_phase(F.lds, g, S, E); PH_CLOSE;
    }
}

extern "C" void kernel_launch(void* const* d_in, const int* in_sizes, int n_in, void* d_out, int out_size, void* d_ws, size_t ws_size, hipStream_t stream) {
    static int grid = 0;
    if (grid == 0) {
        if (n_in != 27 || (size_t)out_size != O_END || ws_size < WS_END) { fprintf(stderr, "kernel_launch: unexpected shapes (n_in %d out %d ws %zu)\n", n_in, out_size, ws_size); grid = -1; return; }
        int dev = 0, cus = 0, per_cu = 0;
        if (hipGetDevice(&dev) != hipSuccess || hipDeviceGetAttribute(&cus, hipDeviceAttributeMultiprocessorCount, dev) != hipSuccess) { grid = -1; return; }
        if (hipFuncSetAttribute((const void*)mk_fwd, hipFuncAttributeMaxDynamicSharedMemorySize, LDS_BYTES) != hipSuccess) { fprintf(stderr, "kernel_launch: hipFuncSetAttribute failed\n"); grid = -1; return; }
        if (hipOccupancyMaxActiveBlocksPerMultiprocessor(&per_cu, (const void*)mk_fwd, 512, LDS_BYTES) != hipSuccess || per_cu < 1) fprintf(stderr, "kernel_launch: occupancy query reports %d\n", per_cu);
        (void)hipGetLastError();
        grid = cus;
    }
    if (grid < 0) return;
    (void)hipMemsetAsync((char*)d_ws + WS_CTL, 0, CTL_ZERO_BYTES, stream);
    Args a{};
    for (int i = 0; i < 27; ++i) a.in[i] = d_in[i];
    a.out = (float*)d_out; a.ws = (unsigned char*)d_ws;
#if MK_PER_PHASE
    for (int p = 0; p < NPHASES; ++p) { a.ph_lo = p; a.ph_hi = p + 1; hipLaunchKernelGGL(mk_fwd, dim3(grid), dim3(512), LDS_BYTES, stream, a); }
#else
    a.ph_lo = 0; a.ph_hi = NPHASES; hipLaunchKernelGGL(mk_fwd, dim3(grid), dim3(512), LDS_BYTES, stream, a);
#endif
}
```

```cpp
#include <hip/hip_runtime.h>
#include <cstdio>
#include <cstdint>

#ifndef MK_PER_PHASE
#define MK_PER_PHASE 0
#endif

constexpr int D = 1024, SEQ = 8192, NBP = 2, NBS = 32, MP = NBP * SEQ  , MR = MP + NBS  , MPAD = 16640  ;
constexpr int DFF = 2816, NGU = 2 * DFF, NKV = 1536, NQG = 1072, NQGP = 1280, NADA = 8 * 3072 + 2048  ;
constexpr int NBLK = 128, NBATCH = NBP + NBS  , NBLKT = NBATCH * NBLK  ;
constexpr float EPS = 1e-6f;
constexpr float C2 = 0.125f * 1.4426950408889634f;

constexpr size_t O_Y = 0, O_KV = (size_t)MR * 1024, O_WINP = O_KV + (size_t)MR * 1024, O_WINS = O_WINP + (size_t)2 * 512 * 512, O_POOLP = O_WINS + (size_t)32 * 512 * 512,
                 O_POOLS = O_POOLP + (size_t)2 * 2 * 15 * 1024, O_END = O_POOLS + (size_t)2 * 32 * 15 * 1024;
static_assert(O_END == 43577344, "output size");

constexpr size_t MiB = 1u << 20;
constexpr size_t WS_CTL = 0, CTL_ZERO_BYTES = 1 * MiB;
constexpr size_t WS_MODS = 1 * MiB, WS_CB = 8 * MiB, WS_ROPE = 9 * MiB, WS_BIASPE = 10 * MiB;
constexpr size_t WS_ADAT = 16 * MiB, WS_WGU = 68 * MiB, WS_WDN = 112 * MiB, WS_WKV = 134 * MiB, WS_WQG = 137 * MiB, WS_WO = 142 * MiB, WS_POOLW = 146 * MiB, WS_W1T = 147 * MiB;
constexpr size_t WS_XN = 160 * MiB, WS_XN2 = 193 * MiB, WS_H0 = 226 * MiB, WS_H = 291 * MiB, WS_RAWKV = 381 * MiB, WS_RAWQ = 479 * MiB, WS_KVB = 561 * MiB, WS_WINB = 594 * MiB,
                 WS_QB = 611 * MiB, WS_OB = 644 * MiB, WS_GATES = 677 * MiB, WS_KC = 681 * MiB, WS_VC = 686 * MiB, WS_END = 700 * MiB;
constexpr int CW_BAR = 4096;

#define GAS __attribute__((address_space(1)))
#define LAS __attribute__((address_space(3)))
typedef unsigned short bf16;
typedef float f32x4 __attribute__((ext_vector_type(4)));
typedef float f32x2 __attribute__((ext_vector_type(2)));
typedef unsigned v4u __attribute__((ext_vector_type(4)));
typedef unsigned v2u __attribute__((ext_vector_type(2)));
typedef short bf16x8 __attribute__((ext_vector_type(8)));
#define RLX_AGENT __ATOMIC_RELAXED, __HIP_MEMORY_SCOPE_AGENT
#define LDS_WAIT() asm volatile("s_waitcnt lgkmcnt(0)" ::: "memory")
#define VM_WAIT() asm volatile("s_waitcnt vmcnt(0)" ::: "memory")

__device__ __forceinline__ unsigned f2bf(float f) { unsigned u = __builtin_bit_cast(unsigned, f); return (u + 0x7fffu + ((u >> 16) & 1u)) >> 16; }
__device__ __forceinline__ unsigned pk2(float lo, float hi) { return f2bf(lo) | (f2bf(hi) << 16); }
__device__ __forceinline__ float bf2f(unsigned short u) { return __builtin_bit_cast(float, (unsigned)u << 16); }
__device__ __forceinline__ float wave_sum(float v) {
#pragma unroll
    for (int o = 1; o < 64; o <<= 1) v += __shfl_xor(v, o);
    return v;
}
__device__ __forceinline__ float wave_max(float v) {
#pragma unroll
    for (int o = 1; o < 64; o <<= 1) v = fmaxf(v, __shfl_xor(v, o));
    return v;
}
__device__ __forceinline__ int bidx_of(int row) { return row < MP ? (row >> 13) : ((row - MP + 2) < NBATCH ? (row - MP + 2) : NBATCH - 1); }

namespace pg8 {
#define PG8_LAS __attribute__((address_space(3)))
typedef unsigned short bf16_t;
typedef short bf16x8 __attribute__((ext_vector_type(8)));
typedef float f32x4 __attribute__((ext_vector_type(4)));
typedef unsigned u32x4 __attribute__((ext_vector_type(4)));
constexpr int BM = 256, BK = 64, HALF = 128, HTB = HALF * BK * 2, STAGE_BYTES = 8 * HTB, NXCD = 8, WGM = 8;
__host__ __device__ __forceinline__ int lds_byte(int r, int c) { const int st = (r >> 4) * 2 + (c >> 5), rr = r & 15, cc = c & 31, ob = rr * 64 + cc * 2; return st * 1024 + (ob ^ (((ob >> 9) & 1) << 5)); }
__host__ __device__ __forceinline__ void stage_rc(int b, int& R, int& C) { const int st = b / 1024, sb = b % 1024, swz = sb ^ (((sb >> 9) & 1) << 5); R = (st >> 1) * 16 + swz / 64; C = (st & 1) * 32 + (swz % 64) / 2; }
__host__ __device__ __forceinline__ int perm32(int rho) { const int n = rho >> 4, i = rho & 15; return 8 * (i >> 2) + 4 * n + (i & 3); }
struct Unit { int pm, pn; };
struct Gemm { const bf16_t* A; const bf16_t* Bt; int lda, ldb, K, a_pn_off; };
struct StaticOrder {
    int nM, nN, nwg, G, c;
    __host__ __device__ void init(int M, int N, int G_, int c_) { nM = M / BM; nN = N / BM; nwg = nM * nN; G = G_; c = c_; }
    __host__ __device__ bool next(int i, Unit& u) const {
        const long L = (long)i * G + c; if (L >= nwg) return false;
        int wgid = (int)L; { const int q = nwg / NXCD, r = nwg % NXCD, xcd = wgid % NXCD, off = wgid / NXCD; wgid = (xcd < r ? xcd * (q + 1) : r * (q + 1) + (xcd - r) * q) + off; }
        const int nig = WGM * nN, gid = wgid / nig, fm = gid * WGM, gsz = (nM - fm) < WGM ? (nM - fm) : WGM;
        u.pm = fm + ((wgid % nig) % gsz); u.pn = (wgid % nig) / gsz; return true;
    }
};
template <class Epi>
__device__ __forceinline__ void gemm_phase(PG8_LAS unsigned char* lds, const Gemm g, const StaticOrder& S, const Epi& E) {
    int tid = threadIdx.x; asm volatile("" : "+v"(tid));
    const int wid = __builtin_amdgcn_readfirstlane(tid >> 6), lane = tid & 63, wr = wid >> 2, wc = wid & 3, fr = lane & 15, fq = lane >> 4;
    const int K = g.K, nt = K / BK;
    unsigned voffA[2], voffB[2];
#pragma unroll
    for (int i = 0; i < 2; ++i) { int R, C; stage_rc(tid * 16 + i * 8192, R, C); const int Rb = Epi::PERM ? ((R & ~31) + perm32(R & 31)) : R;
        voffA[i] = (unsigned)(R * g.lda + C) * 2u; voffB[i] = (unsigned)(Rb * g.ldb + C) * 2u; }
    const size_t kstep = (size_t)(BK * 2);
    const size_t hstepA = (size_t)HALF * g.lda * 2, hstepB = (size_t)HALF * g.ldb * 2, tstepA = 2 * hstepA, tstepB = 2 * hstepB;
    const unsigned ldsw = (unsigned)wid * 1024u;
    const int aoff = lds_byte(wr * 64 + fr, fq * 8), boff = lds_byte(wc * 32 + fr, fq * 8);
#define PG8_SA(b, h) (((b) * 2 + (h)) * HTB)
#define PG8_SB(b, h) ((4 + (b) * 2 + (h)) * HTB)
#define PG8_STAGE(bufoff, gbase, voff) do { _Pragma("unroll") for (int _i = 0; _i < 2; ++_i) \
        __builtin_amdgcn_global_load_lds((const unsigned*)((const char*)(gbase) + (voff)[_i]), (PG8_LAS unsigned*)(lds + (bufoff) + ldsw + _i * 8192), 16, 0, 0); } while (0)
#define PG8_LDA(dst, b, h) do { _Pragma("unroll") for (int m = 0; m < 4; ++m) _Pragma("unroll") for (int k = 0; k < 2; ++k) dst[m][k] = *(const PG8_LAS bf16x8*)(lds + PG8_SA(b, h) + aoff + m * 2048 + k * 1024); } while (0)
#define PG8_LDB(dst, b, h) do { _Pragma("unroll") for (int n = 0; n < 2; ++n) _Pragma("unroll") for (int k = 0; k < 2; ++k) dst[n][k] = *(const PG8_LAS bf16x8*)(lds + PG8_SB(b, h) + boff + n * 2048 + k * 1024); } while (0)
#define PG8_MMA(ai, bj, At, Bt) do { __builtin_amdgcn_s_setprio(1); _Pragma("unroll") for (int m = 0; m < 4; ++m) _Pragma("unroll") for (int n = 0; n < 2; ++n) _Pragma("unroll") for (int k = 0; k < 2; ++k) \
        acc[ai][bj][m][n] = __builtin_amdgcn_mfma_f32_16x16x32_bf16(Bt[n][k], At[m][k], acc[ai][bj][m][n], 0, 0, 0); __builtin_amdgcn_s_setprio(0); } while (0)
#define PG8_WAIT_V(n) asm volatile("s_waitcnt vmcnt(" #n ")" ::: "memory")
#define PG8_WAIT_L(n) asm volatile("s_waitcnt lgkmcnt(" #n ")" ::: "memory")
#define PG8_BAR __builtin_amdgcn_s_barrier()
#define PG8_SCHED __builtin_amdgcn_sched_barrier(0)
    Unit cur, nxt; int ui = 0;
    if (!S.next(0, cur)) return;
    f32x4 acc[2][2][4][2];
#pragma unroll
    for (int a = 0; a < 2; ++a)
#pragma unroll
        for (int b = 0; b < 2; ++b)
#pragma unroll
            for (int m = 0; m < 4; ++m)
#pragma unroll
                for (int n = 0; n < 2; ++n) acc[a][b][m][n] = (f32x4){0.f, 0.f, 0.f, 0.f};
    bf16x8 At[4][2], B0[2][2], B1[2][2];
    const char* cA = (const char*)g.A + (size_t)cur.pm * tstepA + (size_t)cur.pn * g.a_pn_off * 2; const char* cB = (const char*)g.Bt + (size_t)cur.pn * tstepB;
    PG8_STAGE(PG8_SB(0, 0), cB, voffB); PG8_STAGE(PG8_SB(0, 1), cB + hstepB, voffB); PG8_STAGE(PG8_SA(0, 0), cA, voffA); PG8_STAGE(PG8_SA(0, 1), cA + hstepA, voffA);
    if (wr == 1) PG8_BAR;
    PG8_WAIT_V(2); PG8_BAR;
    PG8_STAGE(PG8_SB(1, 0), cB + kstep, voffB); PG8_STAGE(PG8_SA(1, 0), cA + kstep, voffA); PG8_STAGE(PG8_SB(1, 1), cB + hstepB + kstep, voffB);
    PG8_WAIT_V(6); PG8_BAR;
    for (;;) {
        const bool has_next = S.next(ui + 1, nxt);
        const char* nA = has_next ? (const char*)g.A + (size_t)nxt.pm * tstepA + (size_t)nxt.pn * g.a_pn_off * 2 : cA; const char* nB = has_next ? (const char*)g.Bt + (size_t)nxt.pn * tstepB : cB;
        for (int t = 0; t < nt; t += 2) {
            const bool last = (t == nt - 2);
            const char* a1 = cA + (size_t)(t + 1) * kstep;
            const char* a2 = last ? nA : cA + (size_t)(t + 2) * kstep; const char* b2 = last ? nB : cB + (size_t)(t + 2) * kstep;
            const char* a3 = a2 + kstep; const char* b3 = b2 + kstep;
            PG8_LDB(B0, 0, 0); PG8_LDB(B1, 0, 1); PG8_SCHED; PG8_LDA(At, 0, 0); PG8_STAGE(PG8_SA(1, 1), a1 + hstepA, voffA);
            PG8_WAIT_V(8); PG8_WAIT_L(0); PG8_BAR; PG8_MMA(0, 0, At, B0); PG8_MMA(0, 1, At, B1); PG8_BAR; PG8_SCHED;
            PG8_LDA(At, 0, 1); PG8_STAGE(PG8_SB(0, 0), b2, voffB); PG8_STAGE(PG8_SB(0, 1), b2 + hstepB, voffB); PG8_STAGE(PG8_SA(0, 0), a2, voffA);
            PG8_WAIT_V(8); PG8_WAIT_L(0); PG8_BAR; PG8_MMA(1, 0, At, B0); PG8_MMA(1, 1, At, B1); PG8_BAR; PG8_SCHED;
            PG8_LDB(B0, 1, 0); PG8_LDB(B1, 1, 1); PG8_SCHED; PG8_LDA(At, 1, 0); PG8_STAGE(PG8_SA(0, 1), a2 + hstepA, voffA);
            PG8_WAIT_V(8); PG8_WAIT_L(0); PG8_BAR; PG8_MMA(0, 0, At, B0); PG8_MMA(0, 1, At, B1); PG8_BAR; PG8_SCHED;
            PG8_LDA(At, 1, 1); PG8_STAGE(PG8_SB(1, 0), b3, voffB); PG8_STAGE(PG8_SB(1, 1), b3 + hstepB, voffB); PG8_STAGE(PG8_SA(1, 0), a3, voffA);
            PG8_WAIT_V(8); PG8_WAIT_L(0); PG8_BAR; PG8_MMA(1, 0, At, B0); PG8_MMA(1, 1, At, B1); PG8_BAR; PG8_SCHED;
        }
        if (wr == 0) PG8_BAR;
        E(acc, cur, wr, wc, fr, fq);
        if (!has_next) break;
#pragma unroll
        for (int a = 0; a < 2; ++a)
#pragma unroll
            for (int b = 0; b < 2; ++b)
#pragma unroll
                for (int m = 0; m < 4; ++m)
#pragma unroll
                    for (int n = 0; n < 2; ++n) acc[a][b][m][n] = (f32x4){0.f, 0.f, 0.f, 0.f};
        cur = nxt; cA = nA; cB = nB; ++ui;
        if (wr == 1) PG8_BAR;
    }
    PG8_WAIT_V(0);
    PG8_BAR;
#undef PG8_SA
#undef PG8_SB
#undef PG8_STAGE
#undef PG8_LDA
#undef PG8_LDB
#undef PG8_MMA
#undef PG8_WAIT_V
#undef PG8_WAIT_L
#undef PG8_BAR
#undef PG8_SCHED
}

__device__ __forceinline__ unsigned cvt_pk_bf16(float lo, float hi) { unsigned r; asm volatile("v_cvt_pk_bf16_f32 %0, %1, %2" : "=v"(r) : "v"(lo), "v"(hi)); return r; }
struct EpiF32 {
    static constexpr bool PERM = false;
    float* out; int ldc; int rows_valid; const float* bias_a; const float* bias_b; int bias_split;
    __device__ __forceinline__ void operator()(const f32x4 (&acc)[2][2][4][2], const Unit& u, int wr, int wc, int fr, int fq) const {
#pragma unroll
        for (int ai = 0; ai < 2; ++ai)
#pragma unroll
            for (int m = 0; m < 4; ++m) { const int row = u.pm * BM + ai * HALF + wr * 64 + m * 16 + fr;
                if (row < rows_valid) {
#pragma unroll
                    for (int bj = 0; bj < 2; ++bj)
#pragma unroll
                        for (int n = 0; n < 2; ++n) { const int col = u.pn * BM + bj * HALF + wc * 32 + n * 16 + 4 * fq; f32x4 v = acc[ai][bj][m][n];
                            if (bias_a) { const f32x4 b = (col < bias_split) ? *(const f32x4*)(bias_a + col) : *(const f32x4*)(bias_b + (col - bias_split)); v += b; }
                            *(f32x4*)(out + (size_t)row * ldc + col) = v; } } }
    }
};
struct EpiRes {
    static constexpr bool PERM = false;
    const float* in_lo; const float* in_hi; float* out; const float* mods; int gate_off; const float* cscale;
    __device__ __forceinline__ void operator()(const f32x4 (&acc)[2][2][4][2], const Unit& u, int wr, int wc, int fr, int fq) const {
#pragma unroll
        for (int ai = 0; ai < 2; ++ai)
#pragma unroll
            for (int m = 0; m < 4; ++m) { const int row = u.pm * BM + ai * HALF + wr * 64 + m * 16 + fr;
                if (row < MR) { const float* gp = mods + (size_t)bidx_of(row) * NADA + gate_off; const float* ip = row < MP ? in_lo + (size_t)row * D : in_hi + (size_t)(row - MP) * D; float* op = out + (size_t)row * D;
#pragma unroll
                    for (int bj = 0; bj < 2; ++bj)
#pragma unroll
                        for (int n = 0; n < 2; ++n) { const int col = u.pn * BM + bj * HALF + wc * 32 + n * 16 + 4 * fq; f32x4 gt = *(const f32x4*)(gp + col);
                            if (cscale) gt *= *(const f32x4*)(cscale + col);
                            const f32x4 x = *(const f32x4*)(ip + col); *(f32x4*)(op + col) = x + gt * acc[ai][bj][m][n]; } } }
    }
};
__device__ __forceinline__ float silu_f(float x) { return x * __builtin_amdgcn_rcpf(1.f + __builtin_amdgcn_exp2f(-1.4426950408889634f * x)); }
struct EpiSwiglu {
    static constexpr bool PERM = true;
    bf16_t* H; int ldh;
    __device__ __forceinline__ void operator()(const f32x4 (&acc)[2][2][4][2], const Unit& u, int wr, int wc, int fr, int fq) const {
        const int row0 = u.pm * BM + wr * 64 + fr, col0 = u.pn * HALF + wc * 32 + 8 * fq;
#pragma unroll
        for (int ai = 0; ai < 2; ++ai)
#pragma unroll
            for (int m = 0; m < 4; ++m) { bf16_t* rowp = H + (size_t)(row0 + ai * HALF + m * 16) * ldh + col0;
                const f32x4 g0 = acc[ai][0][m][0], g1 = acc[ai][0][m][1], u0 = acc[ai][1][m][0], u1 = acc[ai][1][m][1];
                u32x4 w; w.x = cvt_pk_bf16(silu_f(g0[0]) * u0[0], silu_f(g0[1]) * u0[1]); w.y = cvt_pk_bf16(silu_f(g0[2]) * u0[2], silu_f(g0[3]) * u0[3]);
                w.z = cvt_pk_bf16(silu_f(g1[0]) * u1[0], silu_f(g1[1]) * u1[1]); w.w = cvt_pk_bf16(silu_f(g1[2]) * u1[2], silu_f(g1[3]) * u1[3]);
                *(u32x4*)rowp = w; }
    }
};
}

#define XB_TMO      128
#define XB_XCNT(j)  (256  + 64 * (j))
#define XB_XSUB(j)  (1280 + 64 * (j))
#define XB_XGEN(j)  (2304 + 64 * (j))
#define XB_TOP      3328
#define XB_TOPGEN   3392
#define XCD_BAR_WORDS 3456
#define XB_SPIN_CAP (1u << 18)
__device__ __forceinline__ unsigned xb_ld(unsigned* p)              { return __hip_atomic_load(p, __ATOMIC_RELAXED, __HIP_MEMORY_SCOPE_AGENT); }
__device__ __forceinline__ unsigned xb_add(unsigned* p, unsigned v) { return __hip_atomic_fetch_add(p, v, __ATOMIC_RELAXED, __HIP_MEMORY_SCOPE_AGENT); }
__device__ __forceinline__ unsigned xb_xcc_id() { return (unsigned)__builtin_amdgcn_s_getreg((3 << 11) | 20) & 0xFu; }
#define XB_SPIN(cond, bar) do { unsigned _sp = 0; while (cond) { __builtin_amdgcn_s_sleep(1); \
    if ((++_sp & 255u) == 0u) { if (xb_ld(&(bar)[XB_TMO])) break; if (_sp > XB_SPIN_CAP) { atomicAdd(&(bar)[XB_TMO], 1u); break; } } } } while (0)
struct XcdBarrier { unsigned* bar; unsigned x; volatile LAS unsigned* st; };
__device__ __forceinline__ XcdBarrier xcd_barrier_post(unsigned* bar, volatile LAS unsigned* st) {
    XcdBarrier b; b.bar = bar; b.x = xb_xcc_id(); b.st = st;
    if (threadIdx.x == 0) (void)xb_add(&bar[XB_XCNT(b.x)], 1u);
    return b;
}
__device__ __forceinline__ void xcd_barrier_complete(unsigned* bar, unsigned x, unsigned& nloc, unsigned& nx) {
    const unsigned G = gridDim.x * gridDim.y * gridDim.z;
    unsigned sum, cnt, mine, sp = 0u;
    for (;;) {
        sum = 0u; cnt = 0u; mine = 0u;
#pragma unroll
        for (unsigned j = 0; j < 16; ++j) { const unsigned c = xb_ld(&bar[XB_XCNT(j)]); sum += c; cnt += (c > 0u) ? 1u : 0u; mine = (j == x) ? c : mine; }
        if (sum == G) break;
        __builtin_amdgcn_s_sleep(1);
        if ((++sp & 255u) == 0u) { if (xb_ld(&bar[XB_TMO])) break; if (sp > XB_SPIN_CAP) { atomicAdd(&bar[XB_TMO], 1u); break; } }
    }
    nloc = mine > 0u ? mine : 1u; nx = cnt > 0u ? cnt : 1u;
}
__device__ __forceinline__ void xcd_barrier(const XcdBarrier& b) {
    asm volatile("s_waitcnt vmcnt(0)" ::: "memory");
    __syncthreads();
    if (threadIdx.x == 0) {
        unsigned* bar = b.bar;
        __builtin_amdgcn_s_waitcnt(0);
        unsigned nloc = b.st[0], nx = b.st[1];
        if (nloc == 0u) { xcd_barrier_complete(bar, b.x, nloc, nx); b.st[0] = nloc; b.st[1] = nx; }
        const unsigned old = xb_add(&bar[XB_XSUB(b.x)], 1u);
        const unsigned gen = old / nloc;
        if (old + 1u == (gen + 1u) * nloc) {
            __builtin_amdgcn_fence(__ATOMIC_RELEASE, "agent");
            asm volatile("s_waitcnt vmcnt(0)" ::: "memory");
            const unsigned og = xb_add(&bar[XB_TOP], 1u);
            const unsigned tg = og / nx;
            if (og + 1u == (tg + 1u) * nx) xb_add(&bar[XB_TOPGEN], 1u);
            else XB_SPIN(xb_ld(&bar[XB_TOPGEN]) == tg, bar);
            __builtin_amdgcn_fence(__ATOMIC_ACQUIRE, "agent");
            xb_add(&bar[XB_XGEN(b.x)], 1u);
            asm volatile("s_waitcnt vmcnt(0)" ::: "memory");
        } else {
            XB_SPIN(xb_ld(&bar[XB_XGEN(b.x)]) == gen, bar);
            __builtin_amdgcn_fence(__ATOMIC_ACQUIRE, "agent");
            asm volatile("s_waitcnt vmcnt(0)" ::: "memory");
        }
    }
    __syncthreads();
}

constexpr int RING_BYTES = 131072, MISC_OFF = RING_BYTES + 320, LDS_BYTES = 147456;
struct Args { const void* in[27]; float* out; unsigned char* ws; int ph_lo, ph_hi; };
struct Ctx {
    LAS unsigned char* lds; int tid, lane, wave, vcu, G, gw, NGW;
    float* out; unsigned char* ws;
};

__device__ __forceinline__ Ctx fresh(const Ctx& F) { Ctx C = F; asm volatile("" : "+v"(C.tid), "+v"(C.lane), "+s"(C.wave), "+s"(C.vcu), "+s"(C.G), "+s"(C.gw), "+s"(C.NGW), "+s"(C.out), "+s"(C.ws)); return C; }
__device__ __forceinline__ const void* kin(int i) { const char __attribute__((address_space(4)))* kp = (const char __attribute__((address_space(4)))*)__builtin_amdgcn_kernarg_segment_ptr(); asm volatile("" : "+s"(kp));
    return *(const void* const __attribute__((address_space(4)))*)(kp + 8 * i); }
__device__ __forceinline__ void tr_item(const float* W, int N, int K, bf16* WT, int kb, int n0, int drow0, LAS float* scr, int lane) {
    const int k0 = 64 * kb, nn = n0 + (lane & 31); const bool ok = nn < N;
#pragma unroll 8
    for (int i = 0; i < 32; ++i) { const int kk = 2 * i + (lane >> 5); scr[kk * 33 + (lane & 31)] = ok ? W[(size_t)(k0 + kk) * N + nn] : 0.f; }
    LDS_WAIT(); asm volatile("" ::: "memory");
    const int c = lane & 7;
#pragma unroll
    for (int j = 0; j < 4; ++j) { const int n = (lane >> 3) + 8 * j; const LAS float* s = scr + (8 * c) * 33 + n;
        v4u o; o.x = pk2(s[0 * 33], s[1 * 33]); o.y = pk2(s[2 * 33], s[3 * 33]); o.z = pk2(s[4 * 33], s[5 * 33]); o.w = pk2(s[6 * 33], s[7 * 33]);
        *(GAS v4u*)(WT + (size_t)(drow0 + n) * K + k0 + 8 * c) = o; }
    LDS_WAIT(); asm volatile("" ::: "memory");
}
__device__ __forceinline__ void tr_job(const float* W, int N, int K, bf16* WT, int it, int mode, LAS float* scr, int lane) {
    const int nblk = (N + 31) / 32, kb = it / nblk, n0 = 32 * (it % nblk);
    int drow0 = n0;
    if (mode == 1) drow0 = (n0 < DFF) ? 256 * (n0 / 128) + (n0 % 128) : 256 * ((n0 - DFF) / 128) + 128 + ((n0 - DFF) % 128);
    tr_item(W, N, K, WT, kb, n0, drow0, scr, lane);
}
__device__ __forceinline__ void p0_prologue(Ctx& F) {
    LAS float* scr = (LAS float*)(F.lds + F.wave * 16384);
    constexpr int I_ADA = 16 * 96, I_ADAKV = 16 * 64, I_GU = 16 * 176, I_DN = 44 * 32, I_KV = 16 * 48, I_QG = 16 * 34, I_WO = 16 * 32, I_PW = 4 * 8, I_W1 = 64 * 4;
    constexpr int NIT = 8 * I_ADA + I_ADAKV + 4 * I_GU + 4 * I_DN + I_KV + 2 * I_QG + 2 * I_WO + 8 * I_PW + 2 * I_W1;
    for (int it = F.gw; it < NIT; it += F.NGW) {
        int r = it;
        if (r < 8 * I_ADA) { const int s = r / I_ADA; tr_job(((const float*)kin(8)) + (size_t)s * 1024 * 3072, 3072, 1024, ((bf16*)(F.ws + WS_ADAT)) + (size_t)s * 3072 * 1024, r % I_ADA, 0, scr, F.lane); continue; } r -= 8 * I_ADA;
        if (r < I_ADAKV) { tr_job(((const float*)kin(14)), 2048, 1024, ((bf16*)(F.ws + WS_ADAT)) + (size_t)24576 * 1024, r, 0, scr, F.lane); continue; } r -= I_ADAKV;
        if (r < 4 * I_GU) { const int s = r / I_GU; tr_job(((const float*)kin(25)) + (size_t)s * 1024 * NGU, NGU, 1024, ((bf16*)(F.ws + WS_WGU)) + (size_t)s * NGU * 1024, r % I_GU, 1, scr, F.lane); continue; } r -= 4 * I_GU;
        if (r < 4 * I_DN) { const int s = r / I_DN; tr_job(((const float*)kin(26)) + (size_t)s * DFF * 1024, 1024, DFF, ((bf16*)(F.ws + WS_WDN)) + (size_t)s * 1024 * DFF, r % I_DN, 0, scr, F.lane); continue; } r -= 4 * I_DN;
        if (r < I_KV) { tr_job(((const float*)kin(17)), NKV, 1024, ((bf16*)(F.ws + WS_WKV)), r, 0, scr, F.lane); continue; } r -= I_KV;
        if (r < 2 * I_QG) { const int s = r / I_QG; tr_job(((const float*)kin(22)) + (size_t)s * 1024 * NQG, NQG, 1024, ((bf16*)(F.ws + WS_WQG)) + (size_t)s * NQGP * 1024, r % I_QG, 0, scr, F.lane); continue; } r -= 2 * I_QG;
        if (r < 2 * I_WO) { const int s = r / I_WO; tr_job(((const float*)kin(24)) + (size_t)s * 1024 * 1024, 1024, 1024, ((bf16*)(F.ws + WS_WO)) + (size_t)s * 1024 * 1024, r % I_WO, 0, scr, F.lane); continue; } r -= 2 * I_WO;
        if (r < 8 * I_PW) { const int s = r / I_PW; tr_job(((const float*)kin(12)) + (size_t)s * 256 * 256, 256, 256, ((bf16*)(F.ws + WS_POOLW)) + (size_t)s * 256 * 256, r % I_PW, 0, scr, F.lane); continue; } r -= 8 * I_PW;
        { const int s = r / I_W1; tr_job(((const float*)kin(20)) + (size_t)s * 4096 * 128, 128, 4096, ((bf16*)(F.ws + WS_W1T)) + (size_t)s * 128 * 4096, r % I_W1, 0, scr, F.lane); }
    }
    for (int r = F.gw; r < 256; r += F.NGW) {
        const float* src = r < 2 ? ((const float*)kin(6)) + (size_t)r * D : (r < NBATCH ? ((const float*)kin(7)) + (size_t)(r - 2) * D : nullptr);
        unsigned long long* o8 = (unsigned long long*)(((bf16*)(F.ws + WS_CB)) + (size_t)r * D) + F.lane;
#pragma unroll
        for (int j = 0; j < 4; ++j) { f32x4 v = src ? ((const f32x4*)src)[F.lane + 64 * j] : (f32x4){0.f, 0.f, 0.f, 0.f}; o8[64 * j] = (unsigned long long)pk2(v.x, v.y) | ((unsigned long long)pk2(v.z, v.w) << 32); }
    }
    for (int r = F.gw; r < 2 * (NQGP - 1088); r += F.NGW) { const int s = r / (NQGP - 1088), rr = 1088 + r % (NQGP - 1088);
        unsigned long long* o8 = (unsigned long long*)(((bf16*)(F.ws + WS_WQG)) + ((size_t)s * NQGP + rr) * D) + F.lane;
#pragma unroll
        for (int j = 0; j < 4; ++j) o8[64 * j] = 0ull; }
    const int gt = F.gw * 64 + F.lane, NGT = F.NGW * 64;
    for (int e = gt; e < 8193 * 8; e += NGT) { const int pos = e >> 3, i = e & 7;
        const float invs[8] = {1.0f, 0.1939227432012558f, 0.03760603070259094f, 0.007292664609849453f, 0.0014142135623842478f, 0.00027424818836152554f, 5.318296098266728e-05f, 1.0313386155758053e-05f};
        float inv = invs[0];
#pragma unroll
        for (int q = 1; q < 8; ++q) inv = (i == q) ? invs[q] : inv;
        const float ang = (float)pos * inv; const double rev = (double)ang * 0.15915494309189535; const float fr = (float)(rev - floor(rev));
        ((f32x2*)((float*)(F.ws + WS_ROPE)))[e] = (f32x2){__builtin_amdgcn_cosf(fr), __builtin_amdgcn_sinf(fr)}; }
    for (int o = F.gw; o < 256; o += F.NGW) { const int slot = o >> 7, hid = o & 127; float s = 0.f;
        for (int k = F.lane; k < 4096; k += 64) s += ((const float*)kin(19))[slot * 4096 + k] * ((const float*)kin(20))[((size_t)slot * 4096 + k) * 128 + hid];
        s = wave_sum(s); if (F.lane == 0) ((float*)(F.ws + WS_BIASPE))[o] = s; }
    for (int e = gt; e < 32 * 511 * 128; e += NGT) { const int s = e / (511 * 128), r = e % (511 * 128), i = r >> 7, c = r & 127;
        ((f32x4*)(F.out + O_WINS))[((size_t)s * 512 + i) * 128 + c] = ((const f32x4*)((const float*)kin(3)))[((size_t)s * 512 + i + 1) * 128 + c]; }
}

__device__ __forceinline__ const float* xrow(const float* lo, const float* hi, int row) { return row < MP ? lo + (size_t)row * D : hi + (size_t)(row - MP) * D; }
__device__ __forceinline__ void load_row(const float* p, int lane, f32x4 (&v)[4]) {
#pragma unroll
    for (int j = 0; j < 4; ++j) v[j] = ((const f32x4*)p)[lane + 64 * j];
}
__device__ __forceinline__ float row_rstd(const f32x4 (&v)[4]) { float s = 0.f;
#pragma unroll
    for (int j = 0; j < 4; ++j) s += (v[j].x * v[j].x + v[j].y * v[j].y) + (v[j].z * v[j].z + v[j].w * v[j].w);
    return rsqrtf(wave_sum(s) * (1.f / D) + EPS); }
__device__ __forceinline__ void load_mod(const float* mods, int bi, int off, const float* gain, int lane, f32x4 (&A)[4], f32x4 (&S)[4]) {
    const float* mp = mods + (size_t)bi * NADA + off;
#pragma unroll
    for (int j = 0; j < 4; ++j) { const f32x4 g = ((const f32x4*)gain)[lane + 64 * j], sc = ((const f32x4*)(mp + 1024))[lane + 64 * j]; A[j] = g * (sc + 1.f); S[j] = ((const f32x4*)mp)[lane + 64 * j]; }
}
__device__ __forceinline__ void store_row_bf16(bf16* p, int lane, const f32x4 (&v)[4]) {
    unsigned long long* o8 = (unsigned long long*)p + lane;
#pragma unroll
    for (int j = 0; j < 4; ++j) o8[64 * j] = (unsigned long long)pk2(v[j].x, v[j].y) | ((unsigned long long)pk2(v[j].z, v[j].w) << 32);
}
__device__ __forceinline__ void pass_h(Ctx& F, int l, const float* xlo, const float* xhi) {
    const int off = (l * 2 + 0) * 3072; const float* gain = ((const float*)kin(10)) + l * D;
    for (int ch = F.gw; ch < MP / 8; ch += F.NGW) {
        const int b = ch >> 10; f32x4 A[4], S[4]; load_mod(((float*)(F.ws + WS_MODS)), b, off, gain, F.lane, A, S);
        for (int r = 0; r < 8; ++r) { const int row = ch * 8 + r, t = row & (SEQ - 1); f32x4 v[4]; load_row(xrow(xlo, xhi, row), F.lane, v); const float rs = row_rstd(v);
#pragma unroll
            for (int j = 0; j < 4; ++j) { v[j] = v[j] * rs * A[j] + S[j]; ((f32x4*)(((float*)(F.ws + WS_H0)) + (size_t)row * D))[F.lane + 64 * j] = v[j]; }
            if (t >= SEQ - 15) { float* po = F.out + O_POOLP + ((size_t)(l * 2 + b) * 15 + (t - (SEQ - 15))) * D;
#pragma unroll
                for (int j = 0; j < 4; ++j) ((f32x4*)po)[F.lane + 64 * j] = v[j]; } }
    }
    for (int s = F.gw; s < NBS; s += F.NGW) {
        const int row = MP + s; f32x4 A[4], S[4], v[4]; load_mod(((float*)(F.ws + WS_MODS)), 2 + s, off, gain, F.lane, A, S); load_row(xrow(xlo, xhi, row), F.lane, v); const float rs = row_rstd(v);
        const float* sp = ((const float*)kin(4)) + ((size_t)(l * 32 + s) * 15) * D; float* po = F.out + O_POOLS + ((size_t)(l * 32 + s) * 15) * D; f32x4 pl[4];
#pragma unroll
        for (int j = 0; j < 4; ++j) { v[j] = v[j] * rs * A[j] + S[j]; const int w = 2 << j; f32x4 sum = v[j];
            for (int k = 1; k < w; ++k) sum += ((const f32x4*)(sp + (size_t)(15 - k) * D))[F.lane + 64 * j];
            pl[j] = sum * (1.f / (float)w) - v[j]; ((f32x4*)(po + (size_t)14 * D))[F.lane + 64 * j] = v[j]; }
        store_row_bf16(((bf16*)(F.ws + WS_XN2)) + (size_t)row * D, F.lane, pl);
        for (int i = 0; i < 14; ++i)
#pragma unroll
            for (int j = 0; j < 4; ++j) ((f32x4*)(po + (size_t)i * D))[F.lane + 64 * j] = ((const f32x4*)(sp + (size_t)(i + 1) * D))[F.lane + 64 * j];
    }
}
__device__ __forceinline__ void pass_pool(Ctx& F) {
    for (int ch = F.gw; ch < MP / 8; ch += F.NGW) {
        const int row0 = ch * 8, t0 = row0 & (SEQ - 1); f32x4 Sw[4];
#pragma unroll
        for (int j = 0; j < 4; ++j) { const int w = 2 << j; Sw[j] = (f32x4){0.f, 0.f, 0.f, 0.f};
            for (int k = 1; k < w; ++k) if (t0 - k >= 0) Sw[j] += ((const f32x4*)(((float*)(F.ws + WS_H0)) + (size_t)(row0 - k) * D))[F.lane + 64 * j]; }
        for (int r = 0; r < 8; ++r) { const int row = row0 + r, t = t0 + r; f32x4 h[4], pl[4]; load_row(((float*)(F.ws + WS_H0)) + (size_t)row * D, F.lane, h);
#pragma unroll
            for (int j = 0; j < 4; ++j) { const int w = 2 << j; Sw[j] += h[j]; const int cnt = (t + 1) < w ? (t + 1) : w; pl[j] = Sw[j] * (1.f / (float)cnt) - h[j];
                if (t - w + 1 >= 0) Sw[j] -= ((const f32x4*)(((float*)(F.ws + WS_H0)) + (size_t)(row - w + 1) * D))[F.lane + 64 * j]; }
            store_row_bf16(((bf16*)(F.ws + WS_XN2)) + (size_t)row * D, F.lane, pl); }
    }
}
__device__ __forceinline__ void pass_norm(Ctx& F, const float* xlo, const float* xhi, const float* gain1, int off1, bf16* out1, const float* gain2, int off2, bf16* out2) {
    for (int ch = F.gw; ch < (MR + 7) / 8; ch += F.NGW) {
        const int row0 = ch * 8; const bool uni = row0 < MP; f32x4 A1[4], S1[4], A2[4], S2[4];
        if (uni) { load_mod(((float*)(F.ws + WS_MODS)), row0 >> 13, off1, gain1, F.lane, A1, S1); if (out2) load_mod(((float*)(F.ws + WS_MODS)), row0 >> 13, off2, gain2, F.lane, A2, S2); }
        for (int r = 0; r < 8; ++r) { const int row = row0 + r; if (row >= MR) break;
            if (!uni) { load_mod(((float*)(F.ws + WS_MODS)), bidx_of(row), off1, gain1, F.lane, A1, S1); if (out2) load_mod(((float*)(F.ws + WS_MODS)), bidx_of(row), off2, gain2, F.lane, A2, S2); }
            f32x4 v[4], o[4]; load_row(xrow(xlo, xhi, row), F.lane, v); const float rs = row_rstd(v);
#pragma unroll
            for (int j = 0; j < 4; ++j) o[j] = v[j] * rs * A1[j] + S1[j];
            store_row_bf16(out1 + (size_t)row * D, F.lane, o);
            if (out2) {
#pragma unroll
                for (int j = 0; j < 4; ++j) o[j] = v[j] * rs * A2[j] + S2[j];
                store_row_bf16(out2 + (size_t)row * D, F.lane, o); } }
    }
}
__device__ __forceinline__ float rope_lane(float v, int lane, const float* ropep  ) {
    const float other = __shfl_xor(v, 8);
    if (lane < 16) { const f32x2 cs = ((const f32x2*)ropep)[lane & 7]; v = (lane < 8) ? v * cs.x - other * cs.y : v * cs.x + other * cs.y; }
    return v;
}
__device__ __forceinline__ void pass_kvpost(Ctx& F) {
    const int lane = F.lane; const float kn1 = ((const float*)kin(18))[64 + lane], kn2 = ((const float*)kin(18))[128 + lane];
    for (int row = F.gw; row < MR; row += F.NGW) {
        const int pos = row < MP ? (row & (SEQ - 1)) : SEQ; const float* rp = ((float*)(F.ws + WS_ROPE)) + (size_t)pos * 16; const float* raw = ((float*)(F.ws + WS_RAWKV)) + (size_t)row * NKV;
        float* kvo = F.out + O_KV + (size_t)row * 1024; bf16* kvb = ((bf16*)(F.ws + WS_KVB)) + (size_t)row * 1024; bf16* wb = ((bf16*)(F.ws + WS_WINB)) + (size_t)row * 512;
        float* wo = nullptr;
        if (row < MP) { if (pos >= SEQ - 512) wo = F.out + O_WINP + ((size_t)(row >> 13) * 512 + (pos - (SEQ - 512))) * 512; } else wo = F.out + O_WINS + ((size_t)(row - MP) * 512 + 511) * 512;
#pragma unroll 4
        for (int hh = 0; hh < 24; ++hh) { const int slot = hh >> 2, kvh = hh & 3; float v = raw[hh * 64 + lane];
            if (slot == 2 || slot == 4) { const float ss = wave_sum(v * v); v = v * rsqrtf(ss * (1.f / 64.f) + EPS) * (slot == 2 ? kn1 : kn2); v = rope_lane(v, lane, rp); }
            if (slot < 4) { kvo[slot * 256 + kvh * 64 + lane] = v; kvb[slot * 256 + kvh * 64 + lane] = (bf16)f2bf(v); }
            else { wb[(slot - 4) * 256 + kvh * 64 + lane] = (bf16)f2bf(v); if (wo) wo[(slot - 4) * 256 + kvh * 64 + lane] = v; } }
    }
}
__device__ __forceinline__ void pass_qpost(Ctx& F, int j) {
    const int lane = F.lane; const float qn = ((const float*)kin(23))[j * 64 + lane];
    for (int row = F.gw; row < MR; row += F.NGW) {
        const int pos = row < MP ? (row & (SEQ - 1)) : SEQ; const float* rp = ((float*)(F.ws + WS_ROPE)) + (size_t)pos * 16; const float* raw = ((float*)(F.ws + WS_RAWQ)) + (size_t)row * NQGP; bf16* qb = ((bf16*)(F.ws + WS_QB)) + (size_t)row * D;
#pragma unroll 4
        for (int h = 0; h < 16; ++h) { float v = raw[h * 64 + lane]; const float ss = wave_sum(v * v); v = v * rsqrtf(ss * (1.f / 64.f) + EPS) * qn; v = rope_lane(v, lane, rp); qb[h * 64 + lane] = (bf16)f2bf(v * C2); }
        if (lane < 48) { const float g = raw[1024 + lane]; ((float*)(F.ws + WS_GATES))[(size_t)row * 48 + lane] = __builtin_amdgcn_rcpf(1.f + __builtin_amdgcn_exp2f(-1.4426950408889634f * g)); }
    }
}

__device__ __forceinline__ float gelu_tanh(float x) { const float u = 0.7978845608028654f * (x + 0.044715f * x * x * x); return x * __builtin_amdgcn_rcpf(1.f + __builtin_amdgcn_exp2f(-2.f * 1.4426950408889634f * u)); }
__device__ __forceinline__ bf16x8 pack8(const f32x4 a, const f32x4 b) { v4u w; w.x = pk2(a.x, a.y); w.y = pk2(a.z, a.w); w.z = pk2(b.x, b.y); w.w = pk2(b.z, b.w); return __builtin_bit_cast(bf16x8, w); }
__device__ __forceinline__ void compress_phase(Ctx& F) {
    const int lane = F.lane, wid = F.wave, tid = F.tid, n = lane & 15, kq = lane >> 4;
    const int nper = (NBLKT + F.G - 1) / F.G, c0 = F.vcu * nper; int n_cu = NBLKT - c0; n_cu = n_cu < 0 ? 0 : (n_cu > nper ? nper : n_cu);
    if (nper > 32) return;
    const int nbw = (nper + 7) / 8, bw0 = wid * nbw; int nb_w = n_cu - bw0; nb_w = nb_w < 0 ? 0 : (nb_w > nbw ? nbw : nb_w);
    const int bl = n >> 2, kvh = n & 3; const bool vcol = bl < nb_w;
    int gblk = c0 + bw0 + (vcol ? bl : 0); gblk = gblk < NBLKT ? gblk : NBLKT - 1;
    const int bb = gblk >> 7, blk = gblk & 127;
    const float* base = bb < 2 ? F.out + O_KV + ((size_t)(bb * SEQ + blk * 64)) * 1024 : ((const float*)kin(2)) + ((size_t)((const int*)kin(5))[(bb - 2) * 64 + (blk >> 1)] * 128 + (blk & 1) * 64) * 1024;
    const float* lp = base + kvh * 64 + 8 * kq;
    unsigned soff[2];
#pragma unroll
    for (int i = 0; i < 2; ++i) { int R, C; pg8::stage_rc(tid * 16 + i * 8192, R, C); soff[i] = (unsigned)(R * 4096 + C) * 2u; }
    const int foff = pg8::lds_byte(n, kq * 8);
    LAS unsigned char* lds = F.lds;
#define CSTAGE(buf, s) do { _Pragma("unroll") for (int sl = 0; sl < 2; ++sl) _Pragma("unroll") for (int _i = 0; _i < 2; ++_i) \
        __builtin_amdgcn_global_load_lds((const unsigned*)((const char*)(((bf16*)(F.ws + WS_W1T)) + (size_t)sl * 128 * 4096 + (size_t)(s) * 64) + soff[_i]), (LAS unsigned*)(lds + ((buf) * 2 + sl) * 16384 + wid * 1024 + _i * 8192), 16, 0, 0); } while (0)
    f32x4 acc[2][8];
#pragma unroll
    for (int sl = 0; sl < 2; ++sl)
#pragma unroll
        for (int mt = 0; mt < 8; ++mt) acc[sl][mt] = (f32x4){0.f, 0.f, 0.f, 0.f};
    f32x4 raw[2][2][2];
#define CLOAD(s) do { _Pragma("unroll") for (int sl = 0; sl < 2; ++sl) _Pragma("unroll") for (int e = 0; e < 2; ++e) { const float* p_ = lp + (size_t)(s) * 1024 + sl * 256 + 32 * e; raw[sl][e][0] = *(const f32x4*)p_; raw[sl][e][1] = *(const f32x4*)(p_ + 4); } } while (0)
    __syncthreads();
    CSTAGE(0, 0); CLOAD(0);
    VM_WAIT(); __syncthreads();
    for (int s = 0; s < 64; ++s) {
        const int buf = s & 1; bf16x8 bfr[2][2];
#pragma unroll
        for (int sl = 0; sl < 2; ++sl)
#pragma unroll
            for (int e = 0; e < 2; ++e) bfr[sl][e] = pack8(raw[sl][e][0], raw[sl][e][1]);
        if (s + 1 < 64) { CSTAGE(buf ^ 1, s + 1); CLOAD(s + 1); }
#pragma unroll
        for (int sl = 0; sl < 2; ++sl)
#pragma unroll
            for (int e = 0; e < 2; ++e) { bf16x8 af[8];
#pragma unroll
                for (int mt = 0; mt < 8; ++mt) af[mt] = *(const LAS bf16x8*)(lds + (buf * 2 + sl) * 16384 + foff + mt * 2048 + e * 1024);
#pragma unroll
                for (int mt = 0; mt < 8; ++mt) acc[sl][mt] = __builtin_amdgcn_mfma_f32_16x16x32_bf16(af[mt], bfr[sl][e], acc[sl][mt], 0, 0, 0);
                __builtin_amdgcn_sched_barrier(0); }
        VM_WAIT(); __syncthreads();
    }
#undef CSTAGE
#undef CLOAD
#pragma unroll
    for (int sl = 0; sl < 2; ++sl) {
        bf16x8 hb[4];
#pragma unroll
        for (int e2 = 0; e2 < 4; ++e2) { f32x4 a = acc[sl][2 * e2] + *(const f32x4*)(((float*)(F.ws + WS_BIASPE)) + sl * 128 + 32 * e2 + 4 * kq), b = acc[sl][2 * e2 + 1] + *(const f32x4*)(((float*)(F.ws + WS_BIASPE)) + sl * 128 + 32 * e2 + 16 + 4 * kq);
            a = (f32x4){gelu_tanh(a.x), gelu_tanh(a.y), gelu_tanh(a.z), gelu_tanh(a.w)}; b = (f32x4){gelu_tanh(b.x), gelu_tanh(b.y), gelu_tanh(b.z), gelu_tanh(b.w)}; hb[e2] = pack8(a, b); }
        f32x4 o[4];
        const float* w2b = ((const float*)kin(21)) + (size_t)sl * 128 * 64 + n;
#pragma unroll
        for (int mt2 = 0; mt2 < 4; ++mt2) { o[mt2] = (f32x4){0.f, 0.f, 0.f, 0.f};
#pragma unroll
            for (int e2 = 0; e2 < 4; ++e2) { const float* w2 = w2b + 16 * mt2; float wv[8];
#pragma unroll
                for (int jj = 0; jj < 8; ++jj) wv[jj] = w2[(size_t)(32 * e2 + 16 * (jj >> 2) + 4 * kq + (jj & 3)) * 64];
                const bf16x8 a = pack8((f32x4){wv[0], wv[1], wv[2], wv[3]}, (f32x4){wv[4], wv[5], wv[6], wv[7]});
                o[mt2] = __builtin_amdgcn_mfma_f32_16x16x32_bf16(a, hb[e2], o[mt2], 0, 0, 0); __builtin_amdgcn_sched_barrier(0); } }
        if (sl == 0) {
            float ss = 0.f;
#pragma unroll
            for (int mt2 = 0; mt2 < 4; ++mt2) ss += (o[mt2].x * o[mt2].x + o[mt2].y * o[mt2].y) + (o[mt2].z * o[mt2].z + o[mt2].w * o[mt2].w);
            ss += __shfl_xor(ss, 16); ss += __shfl_xor(ss, 32);
            const float rs = rsqrtf(ss * (1.f / 64.f) + EPS);
#pragma unroll
            for (int mt2 = 0; mt2 < 4; ++mt2) o[mt2] = o[mt2] * rs * *(const f32x4*)(((const float*)kin(18)) + 16 * mt2 + 4 * kq);
            const int pos = (blk + 1) * 64 - 1; const float* rp = ((float*)(F.ws + WS_ROPE)) + (size_t)pos * 16 + (4 * (kq & 1)) * 2;
            f32x4 other; other.x = __shfl_xor(o[0].x, 32); other.y = __shfl_xor(o[0].y, 32); other.z = __shfl_xor(o[0].z, 32); other.w = __shfl_xor(o[0].w, 32);
            const f32x4 cs0 = *(const f32x4*)rp, cs1 = *(const f32x4*)(rp + 4); const f32x4 cv = {cs0.x, cs0.z, cs1.x, cs1.z}, sv = {cs0.y, cs0.w, cs1.y, cs1.w};
            o[0] = (kq < 2) ? o[0] * cv - other * sv : o[0] * cv + other * sv;
        }
        if (vcol) { float* dst = (sl == 0 ? ((float*)(F.ws + WS_KC)) : ((float*)(F.ws + WS_VC))) + ((size_t)(bb * NBLK + blk) * 4 + kvh) * 64 + 4 * kq;
#pragma unroll
            for (int mt2 = 0; mt2 < 4; ++mt2) *(f32x4*)(dst + 16 * mt2) = o[mt2]; }
    }
    __syncthreads();
}

struct Soft { float m[4], l[4], o[4]; };
__device__ __forceinline__ void soft_init(Soft& s) {
#pragma unroll
    for (int g = 0; g < 4; ++g) { s.m[g] = -1e30f; s.l[g] = 0.f; s.o[g] = 0.f; } }
template <class KF, class VF>
__device__ __forceinline__ void attn_block64(LAS float* qs, LAS float* ps, bool valid, KF kf, VF vf, Soft& st, float (&sc)[4], int lane) {
#pragma unroll
    for (int g = 0; g < 4; ++g) sc[g] = 0.f;
#pragma unroll
    for (int d8 = 0; d8 < 8; ++d8) { float kv[8]; kf(d8, kv);
#pragma unroll
        for (int g = 0; g < 4; ++g) { const f32x4 q0 = *(const LAS f32x4*)(qs + g * 64 + d8 * 8), q1 = *(const LAS f32x4*)(qs + g * 64 + d8 * 8 + 4);
            sc[g] += (q0.x * kv[0] + q0.y * kv[1]) + (q0.z * kv[2] + q0.w * kv[3]) + (q1.x * kv[4] + q1.y * kv[5]) + (q1.z * kv[6] + q1.w * kv[7]); } }
    f32x4 pv;
#pragma unroll
    for (int g = 0; g < 4; ++g) { const float sg = valid ? sc[g] : -1e30f; const float mn = fmaxf(st.m[g], wave_max(sg));
        const float p = valid ? __builtin_amdgcn_exp2f(sg - mn) : 0.f; const float corr = __builtin_amdgcn_exp2f(st.m[g] - mn);
        st.l[g] = st.l[g] * corr + wave_sum(p); st.o[g] *= corr; st.m[g] = mn; pv[g] = p; }
    *(LAS f32x4*)(ps + lane * 4) = pv;
    LDS_WAIT(); asm volatile("" ::: "memory");
#pragma unroll 8
    for (int key = 0; key < 64; ++key) { const f32x4 pp = *(const LAS f32x4*)(ps + key * 4); const float v = vf(key);
        st.o[0] += pp.x * v; st.o[1] += pp.y * v; st.o[2] += pp.z * v; st.o[3] += pp.w * v; }
    LDS_WAIT(); asm volatile("" ::: "memory");
}
__device__ __forceinline__ void ld8_bf16(const bf16* p, float (&kv)[8]) { const v4u w = *(const v4u*)p;
    kv[0] = __builtin_bit_cast(float, w.x << 16); kv[1] = __builtin_bit_cast(float, w.x & 0xffff0000u); kv[2] = __builtin_bit_cast(float, w.y << 16); kv[3] = __builtin_bit_cast(float, w.y & 0xffff0000u);
    kv[4] = __builtin_bit_cast(float, w.z << 16); kv[5] = __builtin_bit_cast(float, w.z & 0xffff0000u); kv[6] = __builtin_bit_cast(float, w.w << 16); kv[7] = __builtin_bit_cast(float, w.w & 0xffff0000u); }
__device__ __forceinline__ void ld8_f32(const float* p, float (&kv)[8]) { const f32x4 a = *(const f32x4*)p, b = *(const f32x4*)(p + 4); kv[0] = a.x; kv[1] = a.y; kv[2] = a.z; kv[3] = a.w; kv[4] = b.x; kv[5] = b.y; kv[6] = b.z; kv[7] = b.w; }

__device__ __forceinline__ void cmp_and_select(Ctx& F, LAS float* qs, LAS float* ps, int bb, int kvh, int t, float (&oc)[4], unsigned long long& msk0, unsigned long long& msk1) {
    const int lane = F.lane, cur = t >> 6; Soft st; soft_init(st); float sc0[4], sc1[4];
    const float* kcb = ((float*)(F.ws + WS_KC)) + ((size_t)bb * NBLK * 4 + kvh) * 64; const float* vcb = ((float*)(F.ws + WS_VC)) + ((size_t)bb * NBLK * 4 + kvh) * 64;
    const bool v0 = (lane + 1) * 64 - 1 <= t, v1 = (lane + 65) * 64 - 1 <= t;
    attn_block64(qs, ps, v0, [&](int d8, float (&kv)[8]) { ld8_f32(kcb + (size_t)lane * 256 + d8 * 8, kv); }, [&](int key) { return vcb[(size_t)key * 256 + lane]; }, st, sc0, lane);
    attn_block64(qs, ps, v1, [&](int d8, float (&kv)[8]) { ld8_f32(kcb + (size_t)(64 + lane) * 256 + d8 * 8, kv); }, [&](int key) { return vcb[(size_t)(64 + key) * 256 + lane]; }, st, sc1, lane);
    float imp0 = 0.f, imp1 = 0.f;
#pragma unroll
    for (int g = 0; g < 4; ++g) { const float il = st.l[g] > 0.f ? 1.f / st.l[g] : 0.f; oc[g] = st.o[g] * il;
        imp0 += v0 ? __builtin_amdgcn_exp2f(sc0[g] - st.m[g]) * il : 0.f; imp1 += v1 ? __builtin_amdgcn_exp2f(sc1[g] - st.m[g]) * il : 0.f; }
    bool s0, s1;
    if (cur <= 15) { s0 = lane <= cur; s1 = false; }
    else {
        const int b0 = lane, b1 = lane + 64; const bool c0 = b0 >= 1 && b0 <= cur - 2, c1 = b1 >= 1 && b1 <= cur - 2;
        const float x0 = c0 ? imp0 : -1.f, x1 = c1 ? imp1 : -1.f; int r0 = 0, r1 = 0;
        for (int k = 0; k < 64; ++k) { const float y0 = __shfl(x0, k), y1 = __shfl(x1, k);
            r0 += (y0 > x0 || (y0 == x0 && k < b0)) ? 1 : 0; r0 += (y1 > x0 || (y1 == x0 && (k + 64) < b0)) ? 1 : 0;
            r1 += (y0 > x1 || (y0 == x1 && k < b1)) ? 1 : 0; r1 += (y1 > x1 || (y1 == x1 && (k + 64) < b1)) ? 1 : 0; }
        s0 = (b0 == 0) || (b0 == cur) || (b0 == cur - 1) || (c0 && r0 < 13); s1 = (b1 == cur) || (b1 == cur - 1) || (c1 && r1 < 13);
    }
    msk0 = __ballot(s0); msk1 = __ballot(s1);
}
__device__ __forceinline__ void attn_prompt_naive(Ctx& F) {
    const int lane = F.lane; LAS float* qs = (LAS float*)(F.lds + F.wave * 2048); LAS float* ps = qs + 256;
    for (int task = F.gw; task < MP * 4; task += F.NGW) {
        const int row = task >> 2, kvh = task & 3, b = row >> 13, t = row & (SEQ - 1);
#pragma unroll
        for (int g = 0; g < 4; ++g) qs[g * 64 + lane] = bf2f(((bf16*)(F.ws + WS_QB))[(size_t)row * D + (kvh * 4 + g) * 64 + lane]);
        LDS_WAIT(); asm volatile("" ::: "memory");
        float oc[4]; unsigned long long m0, m1; cmp_and_select(F, qs, ps, b, kvh, t, oc, m0, m1);
        Soft ss; soft_init(ss); float scd[4];
        for (int half = 0; half < 2; ++half) { unsigned long long mm = half ? m1 : m0;
            while (mm) { const int j = __builtin_ctzll(mm) + 64 * half; mm &= mm - 1; if (j * 64 > t) continue;
                const int kp = j * 64 + lane; const bf16* kb = ((bf16*)(F.ws + WS_KVB)) + ((size_t)(b * SEQ + kp) * 16 + 8 + kvh) * 64; const bf16* vb = ((bf16*)(F.ws + WS_KVB)) + ((size_t)(b * SEQ + j * 64) * 16 + 12 + kvh) * 64 + lane;
                attn_block64(qs, ps, kp <= t, [&](int d8, float (&kv)[8]) { ld8_bf16(kb + d8 * 8, kv); }, [&](int key) { return bf2f(vb[(size_t)key * 1024]); }, ss, scd, lane); } }
        Soft sw; soft_init(sw);
        for (int c = 0; c < 8; ++c) { const int p0 = t - 511 + 64 * c; if (p0 + 63 < 0) continue;
            const int p = p0 + lane, pc = p < 0 ? 0 : p; const bf16* kb = ((bf16*)(F.ws + WS_WINB)) + ((size_t)(b * SEQ + pc) * 8 + kvh) * 64;
            attn_block64(qs, ps, p >= 0, [&](int d8, float (&kv)[8]) { ld8_bf16(kb + d8 * 8, kv); },
                         [&](int key) { int pk = p0 + key; pk = pk < 0 ? 0 : pk; return bf2f(((bf16*)(F.ws + WS_WINB))[((size_t)(b * SEQ + pk) * 8 + 4 + kvh) * 64 + lane]); }, sw, scd, lane); }
#pragma unroll
        for (int g = 0; g < 4; ++g) { const float* gt = ((float*)(F.ws + WS_GATES)) + (size_t)row * 48 + (kvh * 4 + g) * 3;
            const float os = ss.l[g] > 0.f ? ss.o[g] / ss.l[g] : 0.f, ow = sw.l[g] > 0.f ? sw.o[g] / sw.l[g] : 0.f;
            ((bf16*)(F.ws + WS_OB))[(size_t)row * D + (kvh * 4 + g) * 64 + lane] = (bf16)f2bf(gt[0] * oc[g] + gt[1] * os + gt[2] * ow); }
    }
}
__device__ __forceinline__ void attn_sample_naive(Ctx& F) {
    const int lane = F.lane; LAS float* qs = (LAS float*)(F.lds + F.wave * 2048); LAS float* ps = qs + 256;
    for (int task = F.gw; task < NBS * 4; task += F.NGW) {
        const int s = task >> 2, kvh = task & 3, row = MP + s, t = SEQ;
#pragma unroll
        for (int g = 0; g < 4; ++g) qs[g * 64 + lane] = bf2f(((bf16*)(F.ws + WS_QB))[(size_t)row * D + (kvh * 4 + g) * 64 + lane]);
        LDS_WAIT(); asm volatile("" ::: "memory");
        float oc[4]; unsigned long long m0, m1; cmp_and_select(F, qs, ps, 2 + s, kvh, t, oc, m0, m1);
        Soft ss; soft_init(ss); float scd[4];
        for (int half = 0; half < 2; ++half) { unsigned long long mm = half ? m1 : m0;
            while (mm) { const int j = __builtin_ctzll(mm) + 64 * half; mm &= mm - 1;
                const float* pg = ((const float*)kin(2)) + ((size_t)((const int*)kin(5))[s * 64 + (j >> 1)] * 128 + (j & 1) * 64) * 1024;
                const float* kb = pg + (size_t)lane * 1024 + 512 + kvh * 64; const float* vb = pg + 768 + kvh * 64 + lane;
                attn_block64(qs, ps, true, [&](int d8, float (&kv)[8]) { ld8_f32(kb + d8 * 8, kv); }, [&](int key) { return vb[(size_t)key * 1024]; }, ss, scd, lane); } }
        {
            const float* nr = F.out + O_KV + (size_t)row * 1024;
            attn_block64(qs, ps, lane == 0, [&](int d8, float (&kv)[8]) { ld8_f32(nr + 512 + kvh * 64 + d8 * 8, kv); }, [&](int) { return nr[768 + kvh * 64 + lane]; }, ss, scd, lane); }
        Soft sw; soft_init(sw);
        const float* wb = F.out + O_WINS + (size_t)s * 512 * 512;
        for (int c = 0; c < 8; ++c) { const float* kb = wb + (size_t)(64 * c + lane) * 512 + kvh * 64; const float* vb = wb + (size_t)(64 * c) * 512 + 256 + kvh * 64 + lane;
            attn_block64(qs, ps, true, [&](int d8, float (&kv)[8]) { ld8_f32(kb + d8 * 8, kv); }, [&](int key) { return vb[(size_t)key * 512]; }, sw, scd, lane); }
#pragma unroll
        for (int g = 0; g < 4; ++g) { const float* gt = ((float*)(F.ws + WS_GATES)) + (size_t)row * 48 + (kvh * 4 + g) * 3;
            const float os = ss.l[g] > 0.f ? ss.o[g] / ss.l[g] : 0.f, ow = sw.l[g] > 0.f ? sw.o[g] / sw.l[g] : 0.f;
            ((bf16*)(F.ws + WS_OB))[(size_t)row * D + (kvh * 4 + g) * 64 + lane] = (bf16)f2bf(gt[0] * oc[g] + gt[1] * os + gt[2] * ow); }
    }
}

constexpr int NPHASES = 31;
__global__ void __launch_bounds__(512, 2) mk_fwd(Args args) {
    extern __shared__ __attribute__((aligned(16))) unsigned char lds_raw[];
    Ctx F;
    F.lds = (LAS unsigned char*)lds_raw; F.tid = threadIdx.x; F.lane = F.tid & 63; F.wave = __builtin_amdgcn_readfirstlane(F.tid >> 6);
    F.G = gridDim.x; { const int bx = blockIdx.x; F.vcu = (F.G % 8 == 0) ? (bx % 8) * (F.G / 8) + bx / 8 : bx; }
    F.gw = F.vcu * 8 + F.wave; F.NGW = F.G * 8;
    F.out = args.out; F.ws = args.ws; unsigned char* ws = args.ws;
    volatile LAS unsigned* MISC = (volatile LAS unsigned*)(F.lds + MISC_OFF);
    for (int u = F.tid; u < (LDS_BYTES - RING_BYTES) / 4; u += 512) ((LAS unsigned*)(F.lds + RING_BYTES))[u] = 0u;
    __syncthreads();
    unsigned* ctl = (unsigned*)(ws + WS_CTL);
    XcdBarrier bar; bar.bar = ctl + CW_BAR; bar.x = 0; bar.st = nullptr;
    const int lo = args.ph_lo, hi = args.ph_hi;
    if (hi - lo > 1) bar = xcd_barrier_post(ctl + CW_BAR, MISC + 8);
    int ph = 0;
    const Ctx& F0 = F;
#define PH_BEGIN if (ph >= lo && ph < hi) { Ctx F = fresh(F0); float* X = F.out + O_Y; (void)X;
#define PH_CLOSE } do { if (ph >= lo && ph + 1 < hi) xcd_barrier(bar); ++ph; } while (0)
#define XLO (l == 0 ? (const float*)kin(0) : (const float*)X)
#define XHI (l == 0 ? (const float*)kin(1) : (const float*)(X + (size_t)MP * D))
#define WSB(off) ((bf16*)(F.ws + (off)))
#define WSF(off) ((float*)(F.ws + (off)))
    const int bxi = (int)blockIdx.x;
    PH_BEGIN p0_prologue(F); PH_CLOSE;
    PH_BEGIN pg8::Gemm g{WSB(WS_CB), WSB(WS_ADAT), D, D, D, 0}; pg8::StaticOrder S; S.init(256, NADA, F.G, bxi); pg8::EpiF32 E{WSF(WS_MODS), NADA, 64, (const float*)kin(9), (const float*)kin(15), 8 * 3072};
        pg8::gemm_phase(F.lds, g, S, E); PH_CLOSE;
    for (int l = 0; l < 4; ++l) {
        if (l < 2) {
            PH_BEGIN pass_h(F, l, XLO, XHI); PH_CLOSE;
            PH_BEGIN pass_pool(F); PH_CLOSE;
            PH_BEGIN pg8::Gemm g{WSB(WS_XN2), WSB(WS_POOLW) + (size_t)l * 1024 * 256, D, 256, 256, 256}; pg8::StaticOrder S; S.init(MPAD, D, F.G, bxi);
                pg8::EpiRes E{XLO, XHI, X, WSF(WS_MODS), (l * 2 + 0) * 3072 + 2048, (const float*)kin(13) + l * D}; pg8::gemm_phase(F.lds, g, S, E); PH_CLOSE;
        } else {
            const int j = l - 2;
            PH_BEGIN if (l == 2) pass_norm(F, X, X + (size_t)MP * D, (const float*)kin(10) + l * D, (l * 2 + 0) * 3072, WSB(WS_XN), (const float*)kin(16), 8 * 3072, WSB(WS_XN2));
                     else pass_norm(F, X, X + (size_t)MP * D, (const float*)kin(10) + l * D, (l * 2 + 0) * 3072, WSB(WS_XN), nullptr, 0, nullptr); PH_CLOSE;
            PH_BEGIN
                if (l == 2) { pg8::Gemm g{WSB(WS_XN2), WSB(WS_WKV), D, D, D, 0}; pg8::StaticOrder S; S.init(MPAD, NKV, F.G, bxi); pg8::EpiF32 E{WSF(WS_RAWKV), NKV, MPAD, nullptr, nullptr, 0}; pg8::gemm_phase(F.lds, g, S, E); }
                { pg8::Gemm g{WSB(WS_XN), WSB(WS_WQG) + (size_t)j * NQGP * D, D, D, D, 0}; pg8::StaticOrder S; S.init(MPAD, NQGP, F.G, bxi); pg8::EpiF32 E{WSF(WS_RAWQ), NQGP, MPAD, nullptr, nullptr, 0}; pg8::gemm_phase(F.lds, g, S, E); }
            PH_CLOSE;
            PH_BEGIN if (l == 2) pass_kvpost(F); pass_qpost(F, j); PH_CLOSE;
            if (l == 2) { PH_BEGIN compress_phase(F); PH_CLOSE; }
            PH_BEGIN attn_sample_naive(F); attn_prompt_naive(F); PH_CLOSE;
            PH_BEGIN pg8::Gemm g{WSB(WS_OB), WSB(WS_WO) + (size_t)j * D * D, D, D, D, 0}; pg8::StaticOrder S; S.init(MPAD, D, F.G, bxi);
                pg8::EpiRes E{X, X + (size_t)MP * D, X, WSF(WS_MODS), (l * 2 + 0) * 3072 + 2048, nullptr}; pg8::gemm_phase(F.lds, g, S, E); PH_CLOSE;
        }
        PH_BEGIN pass_norm(F, X, X + (size_t)MP * D, (const float*)kin(11) + l * D, (l * 2 + 1) * 3072, WSB(WS_XN), nullptr, 0, nullptr); PH_CLOSE;
        PH_BEGIN pg8::Gemm g{WSB(WS_XN), WSB(WS_WGU) + (size_t)l * NGU * D, D, D, D, 0}; pg8::StaticOrder S; S.init(MPAD, NGU, F.G, bxi); pg8::EpiSwiglu E{WSB(WS_H), DFF}; pg8::gemm_phase(F.lds, g, S, E); PH_CLOSE;
        PH_BEGIN pg8::Gemm g{WSB(WS_H), WSB(WS_WDN) + (size_t)l * D * DFF, DFF, DFF, DFF, 0}; pg8::StaticOrder S; S.init(MPAD, D, F.G, bxi);
            pg8::EpiRes E{X, X + (size_t)MP * D, X, WSF(WS_MODS), (l * 2 + 1) * 3072 + 2048, nullptr}; pg8::gemm_phase(F.lds, g, S, E); PH_CLOSE;
    }
}

extern "C" void kernel_launch(void* const* d_in, const int* in_sizes, int n_in, void* d_out, int out_size, void* d_ws, size_t ws_size, hipStream_t stream) {
    static int grid = 0;
    if (grid == 0) {
        if (n_in != 27 || (size_t)out_size != O_END || ws_size < WS_END) { fprintf(stderr, "kernel_launch: unexpected shapes (n_in %d out %d ws %zu)\n", n_in, out_size, ws_size); grid = -1; return; }
        int dev = 0, cus = 0, per_cu = 0;
        if (hipGetDevice(&dev) != hipSuccess || hipDeviceGetAttribute(&cus, hipDeviceAttributeMultiprocessorCount, dev) != hipSuccess) { grid = -1; return; }
        if (hipFuncSetAttribute((const void*)mk_fwd, hipFuncAttributeMaxDynamicSharedMemorySize, LDS_BYTES) != hipSuccess) { fprintf(stderr, "kernel_launch: hipFuncSetAttribute failed\n"); grid = -1; return; }
        if (hipOccupancyMaxActiveBlocksPerMultiprocessor(&per_cu, (const void*)mk_fwd, 512, LDS_BYTES) != hipSuccess || per_cu < 1) fprintf(stderr, "kernel_launch: occupancy query reports %d\n", per_cu);
        (void)hipGetLastError();
        grid = cus;
    }
    if (grid < 0) return;
    (void)hipMemsetAsync((char*)d_ws + WS_CTL, 0, CTL_ZERO_BYTES, stream);
    Args a{};
    for (int i = 0; i < 27; ++i) a.in[i] = d_in[i];
    a.out = (float*)d_out; a.ws = (unsigned char*)d_ws;
#if MK_PER_PHASE
    for (int p = 0; p < NPHASES; ++p) { a.ph_lo = p; a.ph_hi = p + 1; hipLaunchKernelGGL(mk_fwd, dim3(grid), dim3(512), LDS_BYTES, stream, a); }
#else
    a.ph_lo = 0; a.ph_hi = NPHASES; hipLaunchKernelGGL(mk_fwd, dim3(grid), dim3(512), LDS_BYTES, stream, a);
#endif
}
```

```cpp
#include <hip/hip_runtime.h>
#include <cstdio>
#include <cstdint>
#include <hip/hip_bf16.h>
#include <cmath>

#ifndef MK_PER_PHASE
#define MK_PER_PHASE 0
#endif

constexpr int D = 1024, SEQ = 8192, NBP = 2, NBS = 32, MP = NBP * SEQ  , MR = MP + NBS  , MPAD = 16640  ;
constexpr int DFF = 2816, NGU = 2 * DFF, NKV = 1536, NQG = 1072, NQGP = 1280, NADA = 8 * 3072 + 2048  ;
constexpr int NBLK = 128, NBATCH = NBP + NBS  , NBLKT = NBATCH * NBLK  ;
constexpr float EPS = 1e-6f;
constexpr float C2 = 0.125f * 1.4426950408889634f;

constexpr size_t O_Y = 0, O_KV = (size_t)MR * 1024, O_WINP = O_KV + (size_t)MR * 1024, O_WINS = O_WINP + (size_t)2 * 512 * 512, O_POOLP = O_WINS + (size_t)32 * 512 * 512,
                 O_POOLS = O_POOLP + (size_t)2 * 2 * 15 * 1024, O_END = O_POOLS + (size_t)2 * 32 * 15 * 1024;
static_assert(O_END == 43577344, "output size");

constexpr size_t MiB = 1u << 20;
constexpr size_t WS_CTL = 0, CTL_ZERO_BYTES = 1 * MiB;
constexpr size_t WS_MODS = 1 * MiB, WS_CB = 8 * MiB, WS_ROPE = 9 * MiB, WS_BIASPE = 10 * MiB;
constexpr size_t WS_ADAT = 16 * MiB, WS_WGU = 68 * MiB, WS_WDN = 112 * MiB, WS_WKV = 134 * MiB, WS_WQG = 137 * MiB, WS_WO = 142 * MiB, WS_POOLW = 146 * MiB, WS_W1T = 147 * MiB;
constexpr size_t WS_XN = 160 * MiB, WS_XN2 = 193 * MiB, WS_H0 = 226 * MiB, WS_H = 291 * MiB, WS_RAWKV = 381 * MiB, WS_RAWQ = 479 * MiB, WS_KVB = 561 * MiB, WS_WINB = 594 * MiB,
                 WS_QB = 611 * MiB, WS_OB = 644 * MiB, WS_GATES = 677 * MiB, WS_KC = 681 * MiB, WS_VC = 686 * MiB, WS_SELM = 691 * MiB, WS_END = 700 * MiB;
constexpr int CW_BAR = 4096;

#define GAS __attribute__((address_space(1)))
#define LAS __attribute__((address_space(3)))
typedef unsigned short bf16;
typedef float f32x4 __attribute__((ext_vector_type(4)));
typedef float f32x2 __attribute__((ext_vector_type(2)));
typedef unsigned v4u __attribute__((ext_vector_type(4)));
typedef unsigned v2u __attribute__((ext_vector_type(2)));
typedef short bf16x8 __attribute__((ext_vector_type(8)));
#define RLX_AGENT __ATOMIC_RELAXED, __HIP_MEMORY_SCOPE_AGENT
#define LDS_WAIT() asm volatile("s_waitcnt lgkmcnt(0)" ::: "memory")
#define VM_WAIT() asm volatile("s_waitcnt vmcnt(0)" ::: "memory")

__device__ __forceinline__ unsigned f2bf(float f) { unsigned u = __builtin_bit_cast(unsigned, f); return (u + 0x7fffu + ((u >> 16) & 1u)) >> 16; }
__device__ __forceinline__ unsigned pk2(float lo, float hi) { return f2bf(lo) | (f2bf(hi) << 16); }
__device__ __forceinline__ float bf2f(unsigned short u) { return __builtin_bit_cast(float, (unsigned)u << 16); }
__device__ __forceinline__ float wave_sum(float v) {
#pragma unroll
    for (int o = 1; o < 64; o <<= 1) v += __shfl_xor(v, o);
    return v;
}
__device__ __forceinline__ float wave_max(float v) {
#pragma unroll
    for (int o = 1; o < 64; o <<= 1) v = fmaxf(v, __shfl_xor(v, o));
    return v;
}
__device__ __forceinline__ int bidx_of(int row) { return row < MP ? (row >> 13) : ((row - MP + 2) < NBATCH ? (row - MP + 2) : NBATCH - 1); }

namespace pg8 {
#define PG8_LAS __attribute__((address_space(3)))
typedef unsigned short bf16_t;
typedef short bf16x8 __attribute__((ext_vector_type(8)));
typedef float f32x4 __attribute__((ext_vector_type(4)));
typedef unsigned u32x4 __attribute__((ext_vector_type(4)));
constexpr int BM = 256, BK = 64, HALF = 128, HTB = HALF * BK * 2, STAGE_BYTES = 8 * HTB, NXCD = 8, WGM = 8;
__host__ __device__ __forceinline__ int lds_byte(int r, int c) { const int st = (r >> 4) * 2 + (c >> 5), rr = r & 15, cc = c & 31, ob = rr * 64 + cc * 2; return st * 1024 + (ob ^ (((ob >> 9) & 1) << 5)); }
__host__ __device__ __forceinline__ void stage_rc(int b, int& R, int& C) { const int st = b / 1024, sb = b % 1024, swz = sb ^ (((sb >> 9) & 1) << 5); R = (st >> 1) * 16 + swz / 64; C = (st & 1) * 32 + (swz % 64) / 2; }
__host__ __device__ __forceinline__ int perm32(int rho) { const int n = rho >> 4, i = rho & 15; return 8 * (i >> 2) + 4 * n + (i & 3); }
struct Unit { int pm, pn; };
struct Gemm { const bf16_t* A; const bf16_t* Bt; int lda, ldb, K, a_pn_off; };
struct StaticOrder {
    int nM, nN, nwg, G, c;
    __host__ __device__ void init(int M, int N, int G_, int c_) { nM = M / BM; nN = N / BM; nwg = nM * nN; G = G_; c = c_; }
    __host__ __device__ bool next(int i, Unit& u) const {
        const long L = (long)i * G + c; if (L >= nwg) return false;
        int wgid = (int)L; { const int q = nwg / NXCD, r = nwg % NXCD, xcd = wgid % NXCD, off = wgid / NXCD; wgid = (xcd < r ? xcd * (q + 1) : r * (q + 1) + (xcd - r) * q) + off; }
        const int nig = WGM * nN, gid = wgid / nig, fm = gid * WGM, gsz = (nM - fm) < WGM ? (nM - fm) : WGM;
        u.pm = fm + ((wgid % nig) % gsz); u.pn = (wgid % nig) / gsz; return true;
    }
};
template <class Epi>
__device__ __forceinline__ void gemm_phase(PG8_LAS unsigned char* lds, const Gemm g, const StaticOrder& S, const Epi& E) {
    int tid = threadIdx.x; asm volatile("" : "+v"(tid));
    const int wid = __builtin_amdgcn_readfirstlane(tid >> 6), lane = tid & 63, wr = wid >> 2, wc = wid & 3, fr = lane & 15, fq = lane >> 4;
    const int K = g.K, nt = K / BK;
    unsigned voffA[2], voffB[2];
#pragma unroll
    for (int i = 0; i < 2; ++i) { int R, C; stage_rc(tid * 16 + i * 8192, R, C); const int Rb = Epi::PERM ? ((R & ~31) + perm32(R & 31)) : R;
        voffA[i] = (unsigned)(R * g.lda + C) * 2u; voffB[i] = (unsigned)(Rb * g.ldb + C) * 2u; }
    const size_t kstep = (size_t)(BK * 2);
    const size_t hstepA = (size_t)HALF * g.lda * 2, hstepB = (size_t)HALF * g.ldb * 2, tstepA = 2 * hstepA, tstepB = 2 * hstepB;
    const unsigned ldsw = (unsigned)wid * 1024u;
    const int aoff = lds_byte(wr * 64 + fr, fq * 8), boff = lds_byte(wc * 32 + fr, fq * 8);
#define PG8_SA(b, h) (((b) * 2 + (h)) * HTB)
#define PG8_SB(b, h) ((4 + (b) * 2 + (h)) * HTB)
#define PG8_STAGE(bufoff, gbase, voff) do { _Pragma("unroll") for (int _i = 0; _i < 2; ++_i) \
        __builtin_amdgcn_global_load_lds((const unsigned*)((const char*)(gbase) + (voff)[_i]), (PG8_LAS unsigned*)(lds + (bufoff) + ldsw + _i * 8192), 16, 0, 0); } while (0)
#define PG8_LDA(dst, b, h) do { _Pragma("unroll") for (int m = 0; m < 4; ++m) _Pragma("unroll") for (int k = 0; k < 2; ++k) dst[m][k] = *(const PG8_LAS bf16x8*)(lds + PG8_SA(b, h) + aoff + m * 2048 + k * 1024); } while (0)
#define PG8_LDB(dst, b, h) do { _Pragma("unroll") for (int n = 0; n < 2; ++n) _Pragma("unroll") for (int k = 0; k < 2; ++k) dst[n][k] = *(const PG8_LAS bf16x8*)(lds + PG8_SB(b, h) + boff + n * 2048 + k * 1024); } while (0)
#define PG8_MMA(ai, bj, At, Bt) do { __builtin_amdgcn_s_setprio(1); _Pragma("unroll") for (int m = 0; m < 4; ++m) _Pragma("unroll") for (int n = 0; n < 2; ++n) _Pragma("unroll") for (int k = 0; k < 2; ++k) \
        acc[ai][bj][m][n] = __builtin_amdgcn_mfma_f32_16x16x32_bf16(Bt[n][k], At[m][k], acc[ai][bj][m][n], 0, 0, 0); __builtin_amdgcn_s_setprio(0); } while (0)
#define PG8_WAIT_V(n) asm volatile("s_waitcnt vmcnt(" #n ")" ::: "memory")
#define PG8_WAIT_L(n) asm volatile("s_waitcnt lgkmcnt(" #n ")" ::: "memory")
#define PG8_BAR __builtin_amdgcn_s_barrier()
#define PG8_SCHED __builtin_amdgcn_sched_barrier(0)
    Unit cur, nxt; int ui = 0;
    if (!S.next(0, cur)) return;
    f32x4 acc[2][2][4][2];
#pragma unroll
    for (int a = 0; a < 2; ++a)
#pragma unroll
        for (int b = 0; b < 2; ++b)
#pragma unroll
            for (int m = 0; m < 4; ++m)
#pragma unroll
                for (int n = 0; n < 2; ++n) acc[a][b][m][n] = (f32x4){0.f, 0.f, 0.f, 0.f};
    bf16x8 At[4][2], B0[2][2], B1[2][2];
    const char* cA = (const char*)g.A + (size_t)cur.pm * tstepA + (size_t)cur.pn * g.a_pn_off * 2; const char* cB = (const char*)g.Bt + (size_t)cur.pn * tstepB;
    PG8_STAGE(PG8_SB(0, 0), cB, voffB); PG8_STAGE(PG8_SB(0, 1), cB + hstepB, voffB); PG8_STAGE(PG8_SA(0, 0), cA, voffA); PG8_STAGE(PG8_SA(0, 1), cA + hstepA, voffA);
    if (wr == 1) PG8_BAR;
    PG8_WAIT_V(2); PG8_BAR;
    PG8_STAGE(PG8_SB(1, 0), cB + kstep, voffB); PG8_STAGE(PG8_SA(1, 0), cA + kstep, voffA); PG8_STAGE(PG8_SB(1, 1), cB + hstepB + kstep, voffB);
    PG8_WAIT_V(6); PG8_BAR;
    for (;;) {
        const bool has_next = S.next(ui + 1, nxt);
        const char* nA = has_next ? (const char*)g.A + (size_t)nxt.pm * tstepA + (size_t)nxt.pn * g.a_pn_off * 2 : cA; const char* nB = has_next ? (const char*)g.Bt + (size_t)nxt.pn * tstepB : cB;
        for (int t = 0; t < nt; t += 2) {
            const bool last = (t == nt - 2);
            const char* a1 = cA + (size_t)(t + 1) * kstep;
            const char* a2 = last ? nA : cA + (size_t)(t + 2) * kstep; const char* b2 = last ? nB : cB + (size_t)(t + 2) * kstep;
            const char* a3 = a2 + kstep; const char* b3 = b2 + kstep;
            PG8_LDB(B0, 0, 0); PG8_LDB(B1, 0, 1); PG8_SCHED; PG8_LDA(At, 0, 0); PG8_STAGE(PG8_SA(1, 1), a1 + hstepA, voffA);
            PG8_WAIT_V(8); PG8_WAIT_L(0); PG8_BAR; PG8_MMA(0, 0, At, B0); PG8_MMA(0, 1, At, B1); PG8_BAR; PG8_SCHED;
            PG8_LDA(At, 0, 1); PG8_STAGE(PG8_SB(0, 0), b2, voffB); PG8_STAGE(PG8_SB(0, 1), b2 + hstepB, voffB); PG8_STAGE(PG8_SA(0, 0), a2, voffA);
            PG8_WAIT_V(8); PG8_WAIT_L(0); PG8_BAR; PG8_MMA(1, 0, At, B0); PG8_MMA(1, 1, At, B1); PG8_BAR; PG8_SCHED;
            PG8_LDB(B0, 1, 0); PG8_LDB(B1, 1, 1); PG8_SCHED; PG8_LDA(At, 1, 0); PG8_STAGE(PG8_SA(0, 1), a2 + hstepA, voffA);
            PG8_WAIT_V(8); PG8_WAIT_L(0); PG8_BAR; PG8_MMA(0, 0, At, B0); PG8_MMA(0, 1, At, B1); PG8_BAR; PG8_SCHED;
            PG8_LDA(At, 1, 1); PG8_STAGE(PG8_SB(1, 0), b3, voffB); PG8_STAGE(PG8_SB(1, 1), b3 + hstepB, voffB); PG8_STAGE(PG8_SA(1, 0), a3, voffA);
            PG8_WAIT_V(8); PG8_WAIT_L(0); PG8_BAR; PG8_MMA(1, 0, At, B0); PG8_MMA(1, 1, At, B1); PG8_BAR; PG8_SCHED;
        }
        if (wr == 0) PG8_BAR;
        E(acc, cur, wr, wc, fr, fq);
        if (!has_next) break;
#pragma unroll
        for (int a = 0; a < 2; ++a)
#pragma unroll
            for (int b = 0; b < 2; ++b)
#pragma unroll
                for (int m = 0; m < 4; ++m)
#pragma unroll
                    for (int n = 0; n < 2; ++n) acc[a][b][m][n] = (f32x4){0.f, 0.f, 0.f, 0.f};
        cur = nxt; cA = nA; cB = nB; ++ui;
        if (wr == 1) PG8_BAR;
    }
    PG8_WAIT_V(0);
    PG8_BAR;
#undef PG8_SA
#undef PG8_SB
#undef PG8_STAGE
#undef PG8_LDA
#undef PG8_LDB
#undef PG8_MMA
#undef PG8_WAIT_V
#undef PG8_WAIT_L
#undef PG8_BAR
#undef PG8_SCHED
}

__device__ __forceinline__ unsigned cvt_pk_bf16(float lo, float hi) { unsigned r; asm volatile("v_cvt_pk_bf16_f32 %0, %1, %2" : "=v"(r) : "v"(lo), "v"(hi)); return r; }
struct EpiF32 {
    static constexpr bool PERM = false;
    float* out; int ldc; int rows_valid; const float* bias_a; const float* bias_b; int bias_split;
    __device__ __forceinline__ void operator()(const f32x4 (&acc)[2][2][4][2], const Unit& u, int wr, int wc, int fr, int fq) const {
#pragma unroll
        for (int ai = 0; ai < 2; ++ai)
#pragma unroll
            for (int m = 0; m < 4; ++m) { const int row = u.pm * BM + ai * HALF + wr * 64 + m * 16 + fr;
                if (row < rows_valid) {
#pragma unroll
                    for (int bj = 0; bj < 2; ++bj)
#pragma unroll
                        for (int n = 0; n < 2; ++n) { const int col = u.pn * BM + bj * HALF + wc * 32 + n * 16 + 4 * fq; f32x4 v = acc[ai][bj][m][n];
                            if (bias_a) { const f32x4 b = (col < bias_split) ? *(const f32x4*)(bias_a + col) : *(const f32x4*)(bias_b + (col - bias_split)); v += b; }
                            *(f32x4*)(out + (size_t)row * ldc + col) = v; } } }
    }
};
struct EpiRes {
    static constexpr bool PERM = false;
    const float* in_lo; const float* in_hi; float* out; const float* mods; int gate_off; const float* cscale;
    __device__ __forceinline__ void operator()(const f32x4 (&acc)[2][2][4][2], const Unit& u, int wr, int wc, int fr, int fq) const {
#pragma unroll
        for (int ai = 0; ai < 2; ++ai)
#pragma unroll
            for (int m = 0; m < 4; ++m) { const int row = u.pm * BM + ai * HALF + wr * 64 + m * 16 + fr;
                if (row < MR) { const float* gp = mods + (size_t)bidx_of(row) * NADA + gate_off; const float* ip = row < MP ? in_lo + (size_t)row * D : in_hi + (size_t)(row - MP) * D; float* op = out + (size_t)row * D;
#pragma unroll
                    for (int bj = 0; bj < 2; ++bj)
#pragma unroll
                        for (int n = 0; n < 2; ++n) { const int col = u.pn * BM + bj * HALF + wc * 32 + n * 16 + 4 * fq; f32x4 gt = *(const f32x4*)(gp + col);
                            if (cscale) gt *= *(const f32x4*)(cscale + col);
                            const f32x4 x = *(const f32x4*)(ip + col); *(f32x4*)(op + col) = x + gt * acc[ai][bj][m][n]; } } }
    }
};
__device__ __forceinline__ float silu_f(float x) { return x * __builtin_amdgcn_rcpf(1.f + __builtin_amdgcn_exp2f(-1.4426950408889634f * x)); }
struct EpiSwiglu {
    static constexpr bool PERM = true;
    bf16_t* H; int ldh;
    __device__ __forceinline__ void operator()(const f32x4 (&acc)[2][2][4][2], const Unit& u, int wr, int wc, int fr, int fq) const {
        const int row0 = u.pm * BM + wr * 64 + fr, col0 = u.pn * HALF + wc * 32 + 8 * fq;
#pragma unroll
        for (int ai = 0; ai < 2; ++ai)
#pragma unroll
            for (int m = 0; m < 4; ++m) { bf16_t* rowp = H + (size_t)(row0 + ai * HALF + m * 16) * ldh + col0;
                const f32x4 g0 = acc[ai][0][m][0], g1 = acc[ai][0][m][1], u0 = acc[ai][1][m][0], u1 = acc[ai][1][m][1];
                u32x4 w; w.x = cvt_pk_bf16(silu_f(g0[0]) * u0[0], silu_f(g0[1]) * u0[1]); w.y = cvt_pk_bf16(silu_f(g0[2]) * u0[2], silu_f(g0[3]) * u0[3]);
                w.z = cvt_pk_bf16(silu_f(g1[0]) * u1[0], silu_f(g1[1]) * u1[1]); w.w = cvt_pk_bf16(silu_f(g1[2]) * u1[2], silu_f(g1[3]) * u1[3]);
                *(u32x4*)rowp = w; }
    }
};
}

#define XB_TMO      128
#define XB_XCNT(j)  (256  + 64 * (j))
#define XB_XSUB(j)  (1280 + 64 * (j))
#define XB_XGEN(j)  (2304 + 64 * (j))
#define XB_TOP      3328
#define XB_TOPGEN   3392
#define XCD_BAR_WORDS 3456
#define XB_SPIN_CAP (1u << 18)
__device__ __forceinline__ unsigned xb_ld(unsigned* p)              { return __hip_atomic_load(p, __ATOMIC_RELAXED, __HIP_MEMORY_SCOPE_AGENT); }
__device__ __forceinline__ unsigned xb_add(unsigned* p, unsigned v) { return __hip_atomic_fetch_add(p, v, __ATOMIC_RELAXED, __HIP_MEMORY_SCOPE_AGENT); }
__device__ __forceinline__ unsigned xb_xcc_id() { return (unsigned)__builtin_amdgcn_s_getreg((3 << 11) | 20) & 0xFu; }
#define XB_SPIN(cond, bar) do { unsigned _sp = 0; while (cond) { __builtin_amdgcn_s_sleep(1); \
    if ((++_sp & 255u) == 0u) { if (xb_ld(&(bar)[XB_TMO])) break; if (_sp > XB_SPIN_CAP) { atomicAdd(&(bar)[XB_TMO], 1u); break; } } } } while (0)
struct XcdBarrier { unsigned* bar; unsigned x; volatile LAS unsigned* st; };
__device__ __forceinline__ XcdBarrier xcd_barrier_post(unsigned* bar, volatile LAS unsigned* st) {
    XcdBarrier b; b.bar = bar; b.x = xb_xcc_id(); b.st = st;
    if (threadIdx.x == 0) (void)xb_add(&bar[XB_XCNT(b.x)], 1u);
    return b;
}
__device__ __forceinline__ void xcd_barrier_complete(unsigned* bar, unsigned x, unsigned& nloc, unsigned& nx) {
    const unsigned G = gridDim.x * gridDim.y * gridDim.z;
    unsigned sum, cnt, mine, sp = 0u;
    for (;;) {
        sum = 0u; cnt = 0u; mine = 0u;
#pragma unroll
        for (unsigned j = 0; j < 16; ++j) { const unsigned c = xb_ld(&bar[XB_XCNT(j)]); sum += c; cnt += (c > 0u) ? 1u : 0u; mine = (j == x) ? c : mine; }
        if (sum == G) break;
        __builtin_amdgcn_s_sleep(1);
        if ((++sp & 255u) == 0u) { if (xb_ld(&bar[XB_TMO])) break; if (sp > XB_SPIN_CAP) { atomicAdd(&bar[XB_TMO], 1u); break; } }
    }
    nloc = mine > 0u ? mine : 1u; nx = cnt > 0u ? cnt : 1u;
}
__device__ __forceinline__ void xcd_barrier(const XcdBarrier& b) {
    asm volatile("s_waitcnt vmcnt(0)" ::: "memory");
    __syncthreads();
    if (threadIdx.x == 0) {
        unsigned* bar = b.bar;
        __builtin_amdgcn_s_waitcnt(0);
        unsigned nloc = b.st[0], nx = b.st[1];
        if (nloc == 0u) { xcd_barrier_complete(bar, b.x, nloc, nx); b.st[0] = nloc; b.st[1] = nx; }
        const unsigned old = xb_add(&bar[XB_XSUB(b.x)], 1u);
        const unsigned gen = old / nloc;
        if (old + 1u == (gen + 1u) * nloc) {
            __builtin_amdgcn_fence(__ATOMIC_RELEASE, "agent");
            asm volatile("s_waitcnt vmcnt(0)" ::: "memory");
            const unsigned og = xb_add(&bar[XB_TOP], 1u);
            const unsigned tg = og / nx;
            if (og + 1u == (tg + 1u) * nx) xb_add(&bar[XB_TOPGEN], 1u);
            else XB_SPIN(xb_ld(&bar[XB_TOPGEN]) == tg, bar);
            __builtin_amdgcn_fence(__ATOMIC_ACQUIRE, "agent");
            xb_add(&bar[XB_XGEN(b.x)], 1u);
            asm volatile("s_waitcnt vmcnt(0)" ::: "memory");
        } else {
            XB_SPIN(xb_ld(&bar[XB_XGEN(b.x)]) == gen, bar);
            __builtin_amdgcn_fence(__ATOMIC_ACQUIRE, "agent");
            asm volatile("s_waitcnt vmcnt(0)" ::: "memory");
        }
    }
    __syncthreads();
}

constexpr int RING_BYTES = 131072, MISC_OFF = RING_BYTES + 320, LDS_BYTES = 147456;
struct Args { const void* in[27]; float* out; unsigned char* ws; int ph_lo, ph_hi; };
struct Ctx {
    LAS unsigned char* lds; int tid, lane, wave, vcu, G, gw, NGW;
    float* out; unsigned char* ws;
};

__device__ __forceinline__ Ctx fresh(const Ctx& F) { Ctx C = F; GAS float* go = (GAS float*)F.out; GAS unsigned char* gw_ = (GAS unsigned char*)F.ws;
    asm volatile("" : "+v"(C.tid), "+s"(C.wave), "+s"(C.vcu), "+s"(C.G), "+s"(go), "+s"(gw_)); C.lane = C.tid & 63; C.gw = C.vcu * 8 + C.wave; C.NGW = C.G * 8;
    C.out = (float*)go; C.ws = (unsigned char*)gw_;
    return C; }
__device__ __forceinline__ const void* kin(int i) { const char __attribute__((address_space(4)))* kp = (const char __attribute__((address_space(4)))*)__builtin_amdgcn_kernarg_segment_ptr(); asm volatile("" : "+s"(kp));
    const GAS void* p = *(const GAS void* const __attribute__((address_space(4)))*)(kp + 8 * i); return (const void*)p; }
__device__ __forceinline__ void tr_item(const float* W, int N, int K, bf16* WT, int kb, int n0, int drow0, LAS float* scr, int lane) {
    const int k0 = 64 * kb, nn = n0 + (lane & 31); const bool ok = nn < N;
#pragma unroll 8
    for (int i = 0; i < 32; ++i) { const int kk = 2 * i + (lane >> 5); scr[kk * 33 + (lane & 31)] = ok ? W[(size_t)(k0 + kk) * N + nn] : 0.f; }
    LDS_WAIT(); asm volatile("" ::: "memory");
    const int c = lane & 7;
#pragma unroll
    for (int j = 0; j < 4; ++j) { const int n = (lane >> 3) + 8 * j; const LAS float* s = scr + (8 * c) * 33 + n;
        v4u o; o.x = pk2(s[0 * 33], s[1 * 33]); o.y = pk2(s[2 * 33], s[3 * 33]); o.z = pk2(s[4 * 33], s[5 * 33]); o.w = pk2(s[6 * 33], s[7 * 33]);
        *(GAS v4u*)(WT + (size_t)(drow0 + n) * K + k0 + 8 * c) = o; }
    LDS_WAIT(); asm volatile("" ::: "memory");
}
__device__ __forceinline__ void tr_job(const float* W, int N, int K, bf16* WT, int it, int mode, LAS float* scr, int lane) {
    const int nblk = (N + 31) / 32, kb = it / nblk, n0 = 32 * (it % nblk);
    int drow0 = n0;
    if (mode == 1) drow0 = (n0 < DFF) ? 256 * (n0 / 128) + (n0 % 128) : 256 * ((n0 - DFF) / 128) + 128 + ((n0 - DFF) % 128);
    tr_item(W, N, K, WT, kb, n0, drow0, scr, lane);
}
__device__ __forceinline__ void p0_prologue(Ctx& F) {
    LAS float* scr = (LAS float*)(F.lds + F.wave * 16384);
    constexpr int I_ADA = 16 * 96, I_ADAKV = 16 * 64, I_GU = 16 * 176, I_DN = 44 * 32, I_KV = 16 * 48, I_QG = 16 * 34, I_WO = 16 * 32, I_PW = 4 * 8, I_W1 = 64 * 4;
    constexpr int NIT = 8 * I_ADA + I_ADAKV + 4 * I_GU + 4 * I_DN + I_KV + 2 * I_QG + 2 * I_WO + 8 * I_PW + 2 * I_W1;
    for (int it = F.gw; it < NIT; it += F.NGW) {
        int r = it;
        if (r < 8 * I_ADA) { const int s = r / I_ADA; tr_job(((const float*)kin(8)) + (size_t)s * 1024 * 3072, 3072, 1024, ((bf16*)(F.ws + WS_ADAT)) + (size_t)s * 3072 * 1024, r % I_ADA, 0, scr, F.lane); continue; } r -= 8 * I_ADA;
        if (r < I_ADAKV) { tr_job(((const float*)kin(14)), 2048, 1024, ((bf16*)(F.ws + WS_ADAT)) + (size_t)24576 * 1024, r, 0, scr, F.lane); continue; } r -= I_ADAKV;
        if (r < 4 * I_GU) { const int s = r / I_GU; tr_job(((const float*)kin(25)) + (size_t)s * 1024 * NGU, NGU, 1024, ((bf16*)(F.ws + WS_WGU)) + (size_t)s * NGU * 1024, r % I_GU, 1, scr, F.lane); continue; } r -= 4 * I_GU;
        if (r < 4 * I_DN) { const int s = r / I_DN; tr_job(((const float*)kin(26)) + (size_t)s * DFF * 1024, 1024, DFF, ((bf16*)(F.ws + WS_WDN)) + (size_t)s * 1024 * DFF, r % I_DN, 0, scr, F.lane); continue; } r -= 4 * I_DN;
        if (r < I_KV) { tr_job(((const float*)kin(17)), NKV, 1024, ((bf16*)(F.ws + WS_WKV)), r, 0, scr, F.lane); continue; } r -= I_KV;
        if (r < 2 * I_QG) { const int s = r / I_QG; tr_job(((const float*)kin(22)) + (size_t)s * 1024 * NQG, NQG, 1024, ((bf16*)(F.ws + WS_WQG)) + (size_t)s * NQGP * 1024, r % I_QG, 0, scr, F.lane); continue; } r -= 2 * I_QG;
        if (r < 2 * I_WO) { const int s = r / I_WO; tr_job(((const float*)kin(24)) + (size_t)s * 1024 * 1024, 1024, 1024, ((bf16*)(F.ws + WS_WO)) + (size_t)s * 1024 * 1024, r % I_WO, 0, scr, F.lane); continue; } r -= 2 * I_WO;
        if (r < 8 * I_PW) { const int s = r / I_PW; tr_job(((const float*)kin(12)) + (size_t)s * 256 * 256, 256, 256, ((bf16*)(F.ws + WS_POOLW)) + (size_t)s * 256 * 256, r % I_PW, 0, scr, F.lane); continue; } r -= 8 * I_PW;
        { const int s = r / I_W1; tr_job(((const float*)kin(20)) + (size_t)s * 4096 * 128, 128, 4096, ((bf16*)(F.ws + WS_W1T)) + (size_t)s * 128 * 4096, r % I_W1, 0, scr, F.lane); }
    }
    for (int r = F.gw; r < 256; r += F.NGW) {
        const float* src = r < 2 ? ((const float*)kin(6)) + (size_t)r * D : (r < NBATCH ? ((const float*)kin(7)) + (size_t)(r - 2) * D : nullptr);
        unsigned long long* o8 = (unsigned long long*)(((bf16*)(F.ws + WS_CB)) + (size_t)r * D) + F.lane;
#pragma unroll
        for (int j = 0; j < 4; ++j) { f32x4 v = src ? ((const f32x4*)src)[F.lane + 64 * j] : (f32x4){0.f, 0.f, 0.f, 0.f}; o8[64 * j] = (unsigned long long)pk2(v.x, v.y) | ((unsigned long long)pk2(v.z, v.w) << 32); }
    }
    for (int r = F.gw; r < 2 * (NQGP - 1088); r += F.NGW) { const int s = r / (NQGP - 1088), rr = 1088 + r % (NQGP - 1088);
        unsigned long long* o8 = (unsigned long long*)(((bf16*)(F.ws + WS_WQG)) + ((size_t)s * NQGP + rr) * D) + F.lane;
#pragma unroll
        for (int j = 0; j < 4; ++j) o8[64 * j] = 0ull; }
    const int gt = F.gw * 64 + F.lane, NGT = F.NGW * 64;
    for (int e = gt; e < 8193 * 8; e += NGT) { const int pos = e >> 3, i = e & 7;
        const float invs[8] = {1.0f, 0.1939227432012558f, 0.03760603070259094f, 0.007292664609849453f, 0.0014142135623842478f, 0.00027424818836152554f, 5.318296098266728e-05f, 1.0313386155758053e-05f};
        float inv = invs[0];
#pragma unroll
        for (int q = 1; q < 8; ++q) inv = (i == q) ? invs[q] : inv;
        const float ang = (float)pos * inv; const double rev = (double)ang * 0.15915494309189535; const float fr = (float)(rev - floor(rev));
        ((f32x2*)((float*)(F.ws + WS_ROPE)))[e] = (f32x2){__builtin_amdgcn_cosf(fr), __builtin_amdgcn_sinf(fr)}; }
    for (int o = F.gw; o < 256; o += F.NGW) { const int slot = o >> 7, hid = o & 127; float s = 0.f;
        for (int k = F.lane; k < 4096; k += 64) s += ((const float*)kin(19))[slot * 4096 + k] * ((const float*)kin(20))[((size_t)slot * 4096 + k) * 128 + hid];
        s = wave_sum(s); if (F.lane == 0) ((float*)(F.ws + WS_BIASPE))[o] = s; }
    for (int e = gt; e < 32 * 511 * 128; e += NGT) { const int s = e / (511 * 128), r = e % (511 * 128), i = r >> 7, c = r & 127;
        ((f32x4*)(F.out + O_WINS))[((size_t)s * 512 + i) * 128 + c] = ((const f32x4*)((const float*)kin(3)))[((size_t)s * 512 + i + 1) * 128 + c]; }
}

__device__ __forceinline__ const float* xrow(const float* lo, const float* hi, int row) { return row < MP ? lo + (size_t)row * D : hi + (size_t)(row - MP) * D; }
__device__ __forceinline__ void load_row(const float* p, int lane, f32x4 (&v)[4]) {
#pragma unroll
    for (int j = 0; j < 4; ++j) v[j] = ((const f32x4*)p)[lane + 64 * j];
}
__device__ __forceinline__ float row_rstd(const f32x4 (&v)[4]) { float s = 0.f;
#pragma unroll
    for (int j = 0; j < 4; ++j) s += (v[j].x * v[j].x + v[j].y * v[j].y) + (v[j].z * v[j].z + v[j].w * v[j].w);
    return rsqrtf(wave_sum(s) * (1.f / D) + EPS); }
__device__ __forceinline__ void load_mod(const float* mods, int bi, int off, const float* gain, int lane, f32x4 (&A)[4], f32x4 (&S)[4]) {
    const float* mp = mods + (size_t)bi * NADA + off;
#pragma unroll
    for (int j = 0; j < 4; ++j) { const f32x4 g = ((const f32x4*)gain)[lane + 64 * j], sc = ((const f32x4*)(mp + 1024))[lane + 64 * j]; A[j] = g * (sc + 1.f); S[j] = ((const f32x4*)mp)[lane + 64 * j]; }
}
__device__ __forceinline__ void store_row_bf16(bf16* p, int lane, const f32x4 (&v)[4]) {
    unsigned long long* o8 = (unsigned long long*)p + lane;
#pragma unroll
    for (int j = 0; j < 4; ++j) o8[64 * j] = (unsigned long long)pk2(v[j].x, v[j].y) | ((unsigned long long)pk2(v[j].z, v[j].w) << 32);
}
__device__ __forceinline__ void pass_h(Ctx& F, int l, const float* xlo, const float* xhi) {
    const int off = (l * 2 + 0) * 3072; const float* gain = ((const float*)kin(10)) + l * D;
    for (int ch = F.gw; ch < MP / 8; ch += F.NGW) {
        const int b = ch >> 10; f32x4 A[4], S[4]; load_mod(((float*)(F.ws + WS_MODS)), b, off, gain, F.lane, A, S);
        for (int r = 0; r < 8; ++r) { const int row = ch * 8 + r, t = row & (SEQ - 1); f32x4 v[4]; load_row(xrow(xlo, xhi, row), F.lane, v); const float rs = row_rstd(v);
#pragma unroll
            for (int j = 0; j < 4; ++j) { v[j] = v[j] * rs * A[j] + S[j]; ((f32x4*)(((float*)(F.ws + WS_H0)) + (size_t)row * D))[F.lane + 64 * j] = v[j]; }
            if (t >= SEQ - 15) { float* po = F.out + O_POOLP + ((size_t)(l * 2 + b) * 15 + (t - (SEQ - 15))) * D;
#pragma unroll
                for (int j = 0; j < 4; ++j) ((f32x4*)po)[F.lane + 64 * j] = v[j]; } }
    }
    for (int s = F.gw; s < NBS; s += F.NGW) {
        const int row = MP + s; f32x4 A[4], S[4], v[4]; load_mod(((float*)(F.ws + WS_MODS)), 2 + s, off, gain, F.lane, A, S); load_row(xrow(xlo, xhi, row), F.lane, v); const float rs = row_rstd(v);
        const float* sp = ((const float*)kin(4)) + ((size_t)(l * 32 + s) * 15) * D; float* po = F.out + O_POOLS + ((size_t)(l * 32 + s) * 15) * D; f32x4 pl[4];
#pragma unroll
        for (int j = 0; j < 4; ++j) { v[j] = v[j] * rs * A[j] + S[j]; const int w = 2 << j; f32x4 sum = v[j];
            for (int k = 1; k < w; ++k) sum += ((const f32x4*)(sp + (size_t)(15 - k) * D))[F.lane + 64 * j];
            pl[j] = sum * (1.f / (float)w) - v[j]; ((f32x4*)(po + (size_t)14 * D))[F.lane + 64 * j] = v[j]; }
        store_row_bf16(((bf16*)(F.ws + WS_XN2)) + (size_t)row * D, F.lane, pl);
        for (int i = 0; i < 14; ++i)
#pragma unroll
            for (int j = 0; j < 4; ++j) ((f32x4*)(po + (size_t)i * D))[F.lane + 64 * j] = ((const f32x4*)(sp + (size_t)(i + 1) * D))[F.lane + 64 * j];
    }
}
__device__ __forceinline__ void pass_pool(Ctx& F) {
    for (int ch = F.gw; ch < MP / 8; ch += F.NGW) {
        const int row0 = ch * 8, t0 = row0 & (SEQ - 1); f32x4 Sw[4];
#pragma unroll
        for (int j = 0; j < 4; ++j) { const int w = 2 << j; Sw[j] = (f32x4){0.f, 0.f, 0.f, 0.f};
            for (int k = 1; k < w; ++k) if (t0 - k >= 0) Sw[j] += ((const f32x4*)(((float*)(F.ws + WS_H0)) + (size_t)(row0 - k) * D))[F.lane + 64 * j]; }
        for (int r = 0; r < 8; ++r) { const int row = row0 + r, t = t0 + r; f32x4 h[4], pl[4]; load_row(((float*)(F.ws + WS_H0)) + (size_t)row * D, F.lane, h);
#pragma unroll
            for (int j = 0; j < 4; ++j) { const int w = 2 << j; Sw[j] += h[j]; const int cnt = (t + 1) < w ? (t + 1) : w; pl[j] = Sw[j] * (1.f / (float)cnt) - h[j];
                if (t - w + 1 >= 0) Sw[j] -= ((const f32x4*)(((float*)(F.ws + WS_H0)) + (size_t)(row - w + 1) * D))[F.lane + 64 * j]; }
            store_row_bf16(((bf16*)(F.ws + WS_XN2)) + (size_t)row * D, F.lane, pl); }
    }
}
__device__ __forceinline__ void pass_norm(Ctx& F, const float* xlo, const float* xhi, const float* gain1, int off1, bf16* out1, const float* gain2, int off2, bf16* out2) {
    for (int ch = F.gw; ch < (MR + 7) / 8; ch += F.NGW) {
        const int row0 = ch * 8; const bool uni = row0 < MP; f32x4 A1[4], S1[4], A2[4], S2[4];
        if (uni) { load_mod(((float*)(F.ws + WS_MODS)), row0 >> 13, off1, gain1, F.lane, A1, S1); if (out2) load_mod(((float*)(F.ws + WS_MODS)), row0 >> 13, off2, gain2, F.lane, A2, S2); }
        for (int r = 0; r < 8; ++r) { const int row = row0 + r; if (row >= MR) break;
            if (!uni) { load_mod(((float*)(F.ws + WS_MODS)), bidx_of(row), off1, gain1, F.lane, A1, S1); if (out2) load_mod(((float*)(F.ws + WS_MODS)), bidx_of(row), off2, gain2, F.lane, A2, S2); }
            f32x4 v[4], o[4]; load_row(xrow(xlo, xhi, row), F.lane, v); const float rs = row_rstd(v);
#pragma unroll
            for (int j = 0; j < 4; ++j) o[j] = v[j] * rs * A1[j] + S1[j];
            store_row_bf16(out1 + (size_t)row * D, F.lane, o);
            if (out2) {
#pragma unroll
                for (int j = 0; j < 4; ++j) o[j] = v[j] * rs * A2[j] + S2[j];
                store_row_bf16(out2 + (size_t)row * D, F.lane, o); } }
    }
}
__device__ __forceinline__ float rope_lane(float v, int lane, const float* ropep  ) {
    const float other = __shfl_xor(v, 8);
    if (lane < 16) { const f32x2 cs = ((const f32x2*)ropep)[lane & 7]; v = (lane < 8) ? v * cs.x - other * cs.y : v * cs.x + other * cs.y; }
    return v;
}
__device__ __forceinline__ void pass_kvpost(Ctx& F) {
    const int lane = F.lane; const float kn1 = ((const float*)kin(18))[64 + lane], kn2 = ((const float*)kin(18))[128 + lane];
    for (int row = F.gw; row < MR; row += F.NGW) {
        const int pos = row < MP ? (row & (SEQ - 1)) : SEQ; const float* rp = ((float*)(F.ws + WS_ROPE)) + (size_t)pos * 16; const float* raw = ((float*)(F.ws + WS_RAWKV)) + (size_t)row * NKV;
        float* kvo = F.out + O_KV + (size_t)row * 1024; bf16* kvb = ((bf16*)(F.ws + WS_KVB)) + (size_t)row * 1024; bf16* wb = ((bf16*)(F.ws + WS_WINB)) + (size_t)row * 512;
        float* wo = nullptr;
        if (row < MP) { if (pos >= SEQ - 512) wo = F.out + O_WINP + ((size_t)(row >> 13) * 512 + (pos - (SEQ - 512))) * 512; } else wo = F.out + O_WINS + ((size_t)(row - MP) * 512 + 511) * 512;
#pragma unroll 4
        for (int hh = 0; hh < 24; ++hh) { const int slot = hh >> 2, kvh = hh & 3; float v = raw[hh * 64 + lane];
            if (slot == 2 || slot == 4) { const float ss = wave_sum(v * v); v = v * rsqrtf(ss * (1.f / 64.f) + EPS) * (slot == 2 ? kn1 : kn2); v = rope_lane(v, lane, rp); }
            if (slot < 4) { kvo[slot * 256 + kvh * 64 + lane] = v; kvb[slot * 256 + kvh * 64 + lane] = (bf16)f2bf(v); }
            else { wb[(slot - 4) * 256 + kvh * 64 + lane] = (bf16)f2bf(v); if (wo) wo[(slot - 4) * 256 + kvh * 64 + lane] = v; } }
    }
}
__device__ __forceinline__ void pass_qpost(Ctx& F, int j) {
    const int lane = F.lane; const float qn = ((const float*)kin(23))[j * 64 + lane];
    for (int row = F.gw; row < MR; row += F.NGW) {
        const int pos = row < MP ? (row & (SEQ - 1)) : SEQ; const float* rp = ((float*)(F.ws + WS_ROPE)) + (size_t)pos * 16; const float* raw = ((float*)(F.ws + WS_RAWQ)) + (size_t)row * NQGP; bf16* qb = ((bf16*)(F.ws + WS_QB)) + (size_t)row * D;
#pragma unroll 4
        for (int h = 0; h < 16; ++h) { float v = raw[h * 64 + lane]; const float ss = wave_sum(v * v); v = v * rsqrtf(ss * (1.f / 64.f) + EPS) * qn; v = rope_lane(v, lane, rp); qb[h * 64 + lane] = (bf16)f2bf(v * C2); }
        if (lane < 48) { const float g = raw[1024 + lane]; ((float*)(F.ws + WS_GATES))[(size_t)row * 48 + lane] = __builtin_amdgcn_rcpf(1.f + __builtin_amdgcn_exp2f(-1.4426950408889634f * g)); }
    }
}

__device__ __forceinline__ float gelu_tanh(float x) { const float u = 0.7978845608028654f * (x + 0.044715f * x * x * x); return x * __builtin_amdgcn_rcpf(1.f + __builtin_amdgcn_exp2f(-2.f * 1.4426950408889634f * u)); }
__device__ __forceinline__ bf16x8 pack8(const f32x4 a, const f32x4 b) { v4u w; w.x = pk2(a.x, a.y); w.y = pk2(a.z, a.w); w.z = pk2(b.x, b.y); w.w = pk2(b.z, b.w); return __builtin_bit_cast(bf16x8, w); }
__device__ __forceinline__ void compress_phase(Ctx& F) {
    const int lane = F.lane, wid = F.wave, tid = F.tid, n = lane & 15, kq = lane >> 4;
    const int nper = (NBLKT + F.G - 1) / F.G, c0 = F.vcu * nper; int n_cu = NBLKT - c0; n_cu = n_cu < 0 ? 0 : (n_cu > nper ? nper : n_cu);
    if (nper > 32) return;
    const int nbw = (nper + 7) / 8, bw0 = wid * nbw; int nb_w = n_cu - bw0; nb_w = nb_w < 0 ? 0 : (nb_w > nbw ? nbw : nb_w);
    const int bl = n >> 2, kvh = n & 3; const bool vcol = bl < nb_w;
    int gblk = c0 + bw0 + (vcol ? bl : 0); gblk = gblk < NBLKT ? gblk : NBLKT - 1;
    const int bb = gblk >> 7, blk = gblk & 127;
    const float* base = bb < 2 ? F.out + O_KV + ((size_t)(bb * SEQ + blk * 64)) * 1024 : ((const float*)kin(2)) + ((size_t)((const int*)kin(5))[(bb - 2) * 64 + (blk >> 1)] * 128 + (blk & 1) * 64) * 1024;
    const float* lp = base + kvh * 64 + 8 * kq;
    unsigned soff[2];
#pragma unroll
    for (int i = 0; i < 2; ++i) { int R, C; pg8::stage_rc(tid * 16 + i * 8192, R, C); soff[i] = (unsigned)(R * 4096 + C) * 2u; }
    const int foff = pg8::lds_byte(n, kq * 8);
    LAS unsigned char* lds = F.lds;
#define CSTAGE(buf, s) do { _Pragma("unroll") for (int sl = 0; sl < 2; ++sl) _Pragma("unroll") for (int _i = 0; _i < 2; ++_i) \
        __builtin_amdgcn_global_load_lds((const unsigned*)((const char*)(((bf16*)(F.ws + WS_W1T)) + (size_t)sl * 128 * 4096 + (size_t)(s) * 64) + soff[_i]), (LAS unsigned*)(lds + ((buf) * 2 + sl) * 16384 + wid * 1024 + _i * 8192), 16, 0, 0); } while (0)
    f32x4 acc[2][8];
#pragma unroll
    for (int sl = 0; sl < 2; ++sl)
#pragma unroll
        for (int mt = 0; mt < 8; ++mt) acc[sl][mt] = (f32x4){0.f, 0.f, 0.f, 0.f};
    f32x4 raw[2][2][2];
#define CLOAD(s) do { _Pragma("unroll") for (int sl = 0; sl < 2; ++sl) _Pragma("unroll") for (int e = 0; e < 2; ++e) { const float* p_ = lp + (size_t)(s) * 1024 + sl * 256 + 32 * e; raw[sl][e][0] = *(const f32x4*)p_; raw[sl][e][1] = *(const f32x4*)(p_ + 4); } } while (0)
    __syncthreads();
    CSTAGE(0, 0); CLOAD(0);
    VM_WAIT(); __syncthreads();
    for (int s = 0; s < 64; ++s) {
        const int buf = s & 1; bf16x8 bfr[2][2];
#pragma unroll
        for (int sl = 0; sl < 2; ++sl)
#pragma unroll
            for (int e = 0; e < 2; ++e) bfr[sl][e] = pack8(raw[sl][e][0], raw[sl][e][1]);
        if (s + 1 < 64) { CSTAGE(buf ^ 1, s + 1); CLOAD(s + 1); }
#pragma unroll
        for (int sl = 0; sl < 2; ++sl)
#pragma unroll
            for (int e = 0; e < 2; ++e) { bf16x8 af[8];
#pragma unroll
                for (int mt = 0; mt < 8; ++mt) af[mt] = *(const LAS bf16x8*)(lds + (buf * 2 + sl) * 16384 + foff + mt * 2048 + e * 1024);
#pragma unroll
                for (int mt = 0; mt < 8; ++mt) acc[sl][mt] = __builtin_amdgcn_mfma_f32_16x16x32_bf16(af[mt], bfr[sl][e], acc[sl][mt], 0, 0, 0);
                __builtin_amdgcn_sched_barrier(0); }
        VM_WAIT(); __syncthreads();
    }
#undef CSTAGE
#undef CLOAD
#pragma unroll
    for (int sl = 0; sl < 2; ++sl) {
        bf16x8 hb[4];
#pragma unroll
        for (int e2 = 0; e2 < 4; ++e2) { f32x4 a = acc[sl][2 * e2] + *(const f32x4*)(((float*)(F.ws + WS_BIASPE)) + sl * 128 + 32 * e2 + 4 * kq), b = acc[sl][2 * e2 + 1] + *(const f32x4*)(((float*)(F.ws + WS_BIASPE)) + sl * 128 + 32 * e2 + 16 + 4 * kq);
            a = (f32x4){gelu_tanh(a.x), gelu_tanh(a.y), gelu_tanh(a.z), gelu_tanh(a.w)}; b = (f32x4){gelu_tanh(b.x), gelu_tanh(b.y), gelu_tanh(b.z), gelu_tanh(b.w)}; hb[e2] = pack8(a, b); }
        f32x4 o[4];
        const float* w2b = ((const float*)kin(21)) + (size_t)sl * 128 * 64 + n;
#pragma unroll
        for (int mt2 = 0; mt2 < 4; ++mt2) { o[mt2] = (f32x4){0.f, 0.f, 0.f, 0.f};
#pragma unroll
            for (int e2 = 0; e2 < 4; ++e2) { const float* w2 = w2b + 16 * mt2; float wv[8];
#pragma unroll
                for (int jj = 0; jj < 8; ++jj) wv[jj] = w2[(size_t)(32 * e2 + 16 * (jj >> 2) + 4 * kq + (jj & 3)) * 64];
                const bf16x8 a = pack8((f32x4){wv[0], wv[1], wv[2], wv[3]}, (f32x4){wv[4], wv[5], wv[6], wv[7]});
                o[mt2] = __builtin_amdgcn_mfma_f32_16x16x32_bf16(a, hb[e2], o[mt2], 0, 0, 0); __builtin_amdgcn_sched_barrier(0); } }
        if (sl == 0) {
            float ss = 0.f;
#pragma unroll
            for (int mt2 = 0; mt2 < 4; ++mt2) ss += (o[mt2].x * o[mt2].x + o[mt2].y * o[mt2].y) + (o[mt2].z * o[mt2].z + o[mt2].w * o[mt2].w);
            ss += __shfl_xor(ss, 16); ss += __shfl_xor(ss, 32);
            const float rs = rsqrtf(ss * (1.f / 64.f) + EPS);
#pragma unroll
            for (int mt2 = 0; mt2 < 4; ++mt2) o[mt2] = o[mt2] * rs * *(const f32x4*)(((const float*)kin(18)) + 16 * mt2 + 4 * kq);
            const int pos = (blk + 1) * 64 - 1; const float* rp = ((float*)(F.ws + WS_ROPE)) + (size_t)pos * 16 + (4 * (kq & 1)) * 2;
            f32x4 other; other.x = __shfl_xor(o[0].x, 32); other.y = __shfl_xor(o[0].y, 32); other.z = __shfl_xor(o[0].z, 32); other.w = __shfl_xor(o[0].w, 32);
            const f32x4 cs0 = *(const f32x4*)rp, cs1 = *(const f32x4*)(rp + 4); const f32x4 cv = {cs0.x, cs0.z, cs1.x, cs1.z}, sv = {cs0.y, cs0.w, cs1.y, cs1.w};
            o[0] = (kq < 2) ? o[0] * cv - other * sv : o[0] * cv + other * sv;
        }
        if (vcol) { float* dst = (sl == 0 ? ((float*)(F.ws + WS_KC)) : ((float*)(F.ws + WS_VC))) + ((size_t)(bb * NBLK + blk) * 4 + kvh) * 64 + 4 * kq;
#pragma unroll
            for (int mt2 = 0; mt2 < 4; ++mt2) *(f32x4*)(dst + 16 * mt2) = o[mt2]; }
    }
    __syncthreads();
}

struct Soft { float m[4], l[4], o[4]; };
__device__ __forceinline__ void soft_init(Soft& s) {
#pragma unroll
    for (int g = 0; g < 4; ++g) { s.m[g] = -1e30f; s.l[g] = 0.f; s.o[g] = 0.f; } }
template <class KF, class VF>
__device__ __forceinline__ void attn_block64(LAS float* qs, LAS float* ps, bool valid, KF kf, VF vf, Soft& st, float (&sc)[4], int lane) {
#pragma unroll
    for (int g = 0; g < 4; ++g) sc[g] = 0.f;
#pragma unroll
    for (int d8 = 0; d8 < 8; ++d8) { float kv[8]; kf(d8, kv);
#pragma unroll
        for (int g = 0; g < 4; ++g) { const f32x4 q0 = *(const LAS f32x4*)(qs + g * 64 + d8 * 8), q1 = *(const LAS f32x4*)(qs + g * 64 + d8 * 8 + 4);
            sc[g] += (q0.x * kv[0] + q0.y * kv[1]) + (q0.z * kv[2] + q0.w * kv[3]) + (q1.x * kv[4] + q1.y * kv[5]) + (q1.z * kv[6] + q1.w * kv[7]); } }
    f32x4 pv;
#pragma unroll
    for (int g = 0; g < 4; ++g) { const float sg = valid ? sc[g] : -1e30f; const float mn = fmaxf(st.m[g], wave_max(sg));
        const float p = valid ? __builtin_amdgcn_exp2f(sg - mn) : 0.f; const float corr = __builtin_amdgcn_exp2f(st.m[g] - mn);
        st.l[g] = st.l[g] * corr + wave_sum(p); st.o[g] *= corr; st.m[g] = mn; pv[g] = p; }
    *(LAS f32x4*)(ps + lane * 4) = pv;
    LDS_WAIT(); asm volatile("" ::: "memory");
#pragma unroll 8
    for (int key = 0; key < 64; ++key) { const f32x4 pp = *(const LAS f32x4*)(ps + key * 4); const float v = vf(key);
        st.o[0] += pp.x * v; st.o[1] += pp.y * v; st.o[2] += pp.z * v; st.o[3] += pp.w * v; }
    LDS_WAIT(); asm volatile("" ::: "memory");
}
__device__ __forceinline__ void ld8_bf16(const bf16* p, float (&kv)[8]) { const v4u w = *(const v4u*)p;
    kv[0] = __builtin_bit_cast(float, w.x << 16); kv[1] = __builtin_bit_cast(float, w.x & 0xffff0000u); kv[2] = __builtin_bit_cast(float, w.y << 16); kv[3] = __builtin_bit_cast(float, w.y & 0xffff0000u);
    kv[4] = __builtin_bit_cast(float, w.z << 16); kv[5] = __builtin_bit_cast(float, w.z & 0xffff0000u); kv[6] = __builtin_bit_cast(float, w.w << 16); kv[7] = __builtin_bit_cast(float, w.w & 0xffff0000u); }
__device__ __forceinline__ void ld8_f32(const float* p, float (&kv)[8]) { const f32x4 a = *(const f32x4*)p, b = *(const f32x4*)(p + 4); kv[0] = a.x; kv[1] = a.y; kv[2] = a.z; kv[3] = a.w; kv[4] = b.x; kv[5] = b.y; kv[6] = b.z; kv[7] = b.w; }

__device__ __forceinline__ void cmp_and_select(Ctx& F, LAS float* qs, LAS float* ps, int bb, int kvh, int t, float (&oc)[4], unsigned long long& msk0, unsigned long long& msk1) {
    const int lane = F.lane, cur = t >> 6; Soft st; soft_init(st); float sc0[4], sc1[4];
    const float* kcb = ((float*)(F.ws + WS_KC)) + ((size_t)bb * NBLK * 4 + kvh) * 64; const float* vcb = ((float*)(F.ws + WS_VC)) + ((size_t)bb * NBLK * 4 + kvh) * 64;
    const bool v0 = (lane + 1) * 64 - 1 <= t, v1 = (lane + 65) * 64 - 1 <= t;
    attn_block64(qs, ps, v0, [&](int d8, float (&kv)[8]) { ld8_f32(kcb + (size_t)lane * 256 + d8 * 8, kv); }, [&](int key) { return vcb[(size_t)key * 256 + lane]; }, st, sc0, lane);
    attn_block64(qs, ps, v1, [&](int d8, float (&kv)[8]) { ld8_f32(kcb + (size_t)(64 + lane) * 256 + d8 * 8, kv); }, [&](int key) { return vcb[(size_t)(64 + key) * 256 + lane]; }, st, sc1, lane);
    float imp0 = 0.f, imp1 = 0.f;
#pragma unroll
    for (int g = 0; g < 4; ++g) { const float il = st.l[g] > 0.f ? 1.f / st.l[g] : 0.f; oc[g] = st.o[g] * il;
        imp0 += v0 ? __builtin_amdgcn_exp2f(sc0[g] - st.m[g]) * il : 0.f; imp1 += v1 ? __builtin_amdgcn_exp2f(sc1[g] - st.m[g]) * il : 0.f; }
    bool s0, s1;
    if (cur <= 15) { s0 = lane <= cur; s1 = false; }
    else {
        const int b0 = lane, b1 = lane + 64; const bool c0 = b0 >= 1 && b0 <= cur - 2, c1 = b1 >= 1 && b1 <= cur - 2;
        const float x0 = c0 ? imp0 : -1.f, x1 = c1 ? imp1 : -1.f; int r0 = 0, r1 = 0;
        for (int k = 0; k < 64; ++k) { const float y0 = __shfl(x0, k), y1 = __shfl(x1, k);
            r0 += (y0 > x0 || (y0 == x0 && k < b0)) ? 1 : 0; r0 += (y1 > x0 || (y1 == x0 && (k + 64) < b0)) ? 1 : 0;
            r1 += (y0 > x1 || (y0 == x1 && k < b1)) ? 1 : 0; r1 += (y1 > x1 || (y1 == x1 && (k + 64) < b1)) ? 1 : 0; }
        s0 = (b0 == 0) || (b0 == cur) || (b0 == cur - 1) || (c0 && r0 < 13); s1 = (b1 == cur) || (b1 == cur - 1) || (c1 && r1 < 13);
    }
    msk0 = __ballot(s0); msk1 = __ballot(s1);
}
__device__ __forceinline__ void attn_prompt_naive(Ctx& F) {
    const int lane = F.lane; LAS float* qs = (LAS float*)(F.lds + F.wave * 2048); LAS float* ps = qs + 256;
    for (int task = F.gw; task < MP * 4; task += F.NGW) {
        const int row = task >> 2, kvh = task & 3, b = row >> 13, t = row & (SEQ - 1);
#pragma unroll
        for (int g = 0; g < 4; ++g) qs[g * 64 + lane] = bf2f(((bf16*)(F.ws + WS_QB))[(size_t)row * D + (kvh * 4 + g) * 64 + lane]);
        LDS_WAIT(); asm volatile("" ::: "memory");
        float oc[4]; unsigned long long m0, m1; cmp_and_select(F, qs, ps, b, kvh, t, oc, m0, m1);
        Soft ss; soft_init(ss); float scd[4];
        for (int half = 0; half < 2; ++half) { unsigned long long mm = half ? m1 : m0;
            while (mm) { const int j = __builtin_ctzll(mm) + 64 * half; mm &= mm - 1; if (j * 64 > t) continue;
                const int kp = j * 64 + lane; const bf16* kb = ((bf16*)(F.ws + WS_KVB)) + ((size_t)(b * SEQ + kp) * 16 + 8 + kvh) * 64; const bf16* vb = ((bf16*)(F.ws + WS_KVB)) + ((size_t)(b * SEQ + j * 64) * 16 + 12 + kvh) * 64 + lane;
                attn_block64(qs, ps, kp <= t, [&](int d8, float (&kv)[8]) { ld8_bf16(kb + d8 * 8, kv); }, [&](int key) { return bf2f(vb[(size_t)key * 1024]); }, ss, scd, lane); } }
        Soft sw; soft_init(sw);
        for (int c = 0; c < 8; ++c) { const int p0 = t - 511 + 64 * c; if (p0 + 63 < 0) continue;
            const int p = p0 + lane, pc = p < 0 ? 0 : p; const bf16* kb = ((bf16*)(F.ws + WS_WINB)) + ((size_t)(b * SEQ + pc) * 8 + kvh) * 64;
            attn_block64(qs, ps, p >= 0, [&](int d8, float (&kv)[8]) { ld8_bf16(kb + d8 * 8, kv); },
                         [&](int key) { int pk = p0 + key; pk = pk < 0 ? 0 : pk; return bf2f(((bf16*)(F.ws + WS_WINB))[((size_t)(b * SEQ + pk) * 8 + 4 + kvh) * 64 + lane]); }, sw, scd, lane); }
#pragma unroll
        for (int g = 0; g < 4; ++g) { const float* gt = ((float*)(F.ws + WS_GATES)) + (size_t)row * 48 + (kvh * 4 + g) * 3;
            const float os = ss.l[g] > 0.f ? ss.o[g] / ss.l[g] : 0.f, ow = sw.l[g] > 0.f ? sw.o[g] / sw.l[g] : 0.f;
            ((bf16*)(F.ws + WS_OB))[(size_t)row * D + (kvh * 4 + g) * 64 + lane] = (bf16)f2bf(gt[0] * oc[g] + gt[1] * os + gt[2] * ow); }
    }
}
__device__ __forceinline__ void attn_sample_naive(Ctx& F) {
    const int lane = F.lane; LAS float* qs = (LAS float*)(F.lds + F.wave * 2048); LAS float* ps = qs + 256;
    for (int task = F.gw; task < NBS * 4; task += F.NGW) {
        const int s = task >> 2, kvh = task & 3, row = MP + s, t = SEQ;
#pragma unroll
        for (int g = 0; g < 4; ++g) qs[g * 64 + lane] = bf2f(((bf16*)(F.ws + WS_QB))[(size_t)row * D + (kvh * 4 + g) * 64 + lane]);
        LDS_WAIT(); asm volatile("" ::: "memory");
        float oc[4]; unsigned long long m0, m1; cmp_and_select(F, qs, ps, 2 + s, kvh, t, oc, m0, m1);
        Soft ss; soft_init(ss); float scd[4];
        for (int half = 0; half < 2; ++half) { unsigned long long mm = half ? m1 : m0;
            while (mm) { const int j = __builtin_ctzll(mm) + 64 * half; mm &= mm - 1;
                const float* pg = ((const float*)kin(2)) + ((size_t)((const int*)kin(5))[s * 64 + (j >> 1)] * 128 + (j & 1) * 64) * 1024;
                const float* kb = pg + (size_t)lane * 1024 + 512 + kvh * 64; const float* vb = pg + 768 + kvh * 64 + lane;
                attn_block64(qs, ps, true, [&](int d8, float (&kv)[8]) { ld8_f32(kb + d8 * 8, kv); }, [&](int key) { return vb[(size_t)key * 1024]; }, ss, scd, lane); } }
        {
            const float* nr = F.out + O_KV + (size_t)row * 1024;
            attn_block64(qs, ps, lane == 0, [&](int d8, float (&kv)[8]) { ld8_f32(nr + 512 + kvh * 64 + d8 * 8, kv); }, [&](int) { return nr[768 + kvh * 64 + lane]; }, ss, scd, lane); }
        Soft sw; soft_init(sw);
        const float* wb = F.out + O_WINS + (size_t)s * 512 * 512;
        for (int c = 0; c < 8; ++c) { const float* kb = wb + (size_t)(64 * c + lane) * 512 + kvh * 64; const float* vb = wb + (size_t)(64 * c) * 512 + 256 + kvh * 64 + lane;
            attn_block64(qs, ps, true, [&](int d8, float (&kv)[8]) { ld8_f32(kb + d8 * 8, kv); }, [&](int key) { return vb[(size_t)key * 512]; }, sw, scd, lane); }
#pragma unroll
        for (int g = 0; g < 4; ++g) { const float* gt = ((float*)(F.ws + WS_GATES)) + (size_t)row * 48 + (kvh * 4 + g) * 3;
            const float os = ss.l[g] > 0.f ? ss.o[g] / ss.l[g] : 0.f, ow = sw.l[g] > 0.f ? sw.o[g] / sw.l[g] : 0.f;
            ((bf16*)(F.ws + WS_OB))[(size_t)row * D + (kvh * 4 + g) * 64 + lane] = (bf16)f2bf(gt[0] * oc[g] + gt[1] * os + gt[2] * ow); }
    }
}

namespace attn_body {
using bf16=__hip_bfloat16;
using bf16x8=__attribute__((ext_vector_type(8)))short;
using s16x4=__attribute__((ext_vector_type(4)))short;
using f32x16=__attribute__((ext_vector_type(16)))float;
using u32x4=__attribute__((ext_vector_type(4)))unsigned;
constexpr int BATCH=2,NHEAD=16,SEQ=8192,D=64,DM=NHEAD*D;
constexpr int NW=8,QBLK=32,QB=QBLK*NW,KVBLK=64,NQB=SEQ/QB;
constexpr int ATTN_PITCH=DM, ATTN_UNIT_ROWS=QB;
__device__ __forceinline__ int crow(int r,int hi){return (r&3)+8*(r>>2)+4*hi;}
#define SBAR() __builtin_amdgcn_sched_barrier(0)
__device__ __forceinline__ void cmask(f32x16&p0,f32x16&p1,int jb,int qrel,int hi){
  const float NEG=-INFINITY; int kb=64*jb+4*hi;
  #pragma unroll
  for(int r=0;r<16;++r){int kv=kb+(r&3)+8*(r>>2); if(kv>qrel)p0[r]=NEG; if(kv+32>qrel)p1[r]=NEG;}
}

__device__ __forceinline__ void lmask(f32x16&p0,f32x16&p1,int k,int qrel,int hi){
  const float NEG=-INFINITY; int kb=64*k+4*hi;
  #pragma unroll
  for(int r=0;r<16;++r){int kv=kb+(r&3)+8*(r>>2); if(kv<=qrel)p0[r]=NEG; if(kv+32<=qrel)p1[r]=NEG;}
}
constexpr int NSLOT=3, SLOTB=8192;
constexpr int LDS_K=0, LDS_V=NSLOT*SLOTB, LDS_WS=2*NSLOT*SLOTB, LDS_OST=LDS_WS+NW*64*4, LDS_BYTES=LDS_OST+NW*4096;
constexpr float C2=0.125f*1.4426950408889634f;
__device__ __forceinline__ void glds16(const void*gsrc,unsigned lds_dst){unsigned keep;
  asm volatile("s_mov_b32 %0, m0\n\ts_mov_b32 m0, %2\n\ts_nop 0\n\tglobal_load_lds_dwordx4 %1, off\n\ts_mov_b32 m0, %0":"=&s"(keep):"v"(gsrc),"s"(lds_dst):"memory");}
__device__ __forceinline__ float max3f(float a,float b,float c){float r;asm("v_max3_f32 %0, %1, %2, %3":"=v"(r):"v"(a),"v"(b),"v"(c));return r;}
__device__ __forceinline__ float max2f(float a,float b){float r;asm("v_max_f32_e32 %0, %1, %2":"=v"(r):"v"(a),"v"(b));return r;}
__device__ __forceinline__ float fadd_s(float a,float b){float r;asm("v_add_f32_e32 %0, %1, %2":"=v"(r):"v"(a),"v"(b));return r;}
__device__ __forceinline__ float fsub_s(float a,float b){float r;asm("v_sub_f32_e32 %0, %1, %2":"=v"(r):"v"(a),"v"(b));return r;}
typedef float f32x2_t __attribute__((ext_vector_type(2))); typedef __bf16 bf16x2_t __attribute__((ext_vector_type(2)));
__device__ __forceinline__ unsigned cvtpk_s(float lo,float hi){f32x2_t v={lo,hi};bf16x2_t b=__builtin_convertvector(v,bf16x2_t);return __builtin_bit_cast(unsigned,b);}
#define WAIT_BAR(N) asm volatile("s_waitcnt vmcnt(" #N ") lgkmcnt(0)\n\ts_barrier":::"memory")

__device__ __forceinline__ void qkt(f32x16&p0,f32x16&p1,const char*Kslot,const bf16x8*qr,const f32x16&negm,int r32,int hi){
  const char*kb=Kslot+hi*1024+r32*16;
  #pragma unroll
  for(int d0=0;d0<4;++d0){
    const bf16x8 b0=*reinterpret_cast<const bf16x8*>(kb+d0*2048);
    const bf16x8 b1=*reinterpret_cast<const bf16x8*>(kb+d0*2048+512);
    if(d0==0){p0=__builtin_amdgcn_mfma_f32_32x32x16_bf16(b0,qr[0],negm,0,0,0);p1=__builtin_amdgcn_mfma_f32_32x32x16_bf16(b1,qr[0],negm,0,0,0);}
    else{p0=__builtin_amdgcn_mfma_f32_32x32x16_bf16(b0,qr[d0],p0,0,0,0);p1=__builtin_amdgcn_mfma_f32_32x32x16_bf16(b1,qr[d0],p1,0,0,0);}}
}
typedef __attribute__((address_space(3))) const char* lds_cptr;
typedef short v4i16_t __attribute__((ext_vector_type(4)));
__device__ __forceinline__ void kload8(bf16x8*kf,lds_cptr kp){
  kf[0]=*(const __attribute__((address_space(3))) bf16x8*)(kp);      kf[1]=*(const __attribute__((address_space(3))) bf16x8*)(kp+512);
  kf[2]=*(const __attribute__((address_space(3))) bf16x8*)(kp+2048); kf[3]=*(const __attribute__((address_space(3))) bf16x8*)(kp+2560);
  kf[4]=*(const __attribute__((address_space(3))) bf16x8*)(kp+4096); kf[5]=*(const __attribute__((address_space(3))) bf16x8*)(kp+4608);
  kf[6]=*(const __attribute__((address_space(3))) bf16x8*)(kp+6144); kf[7]=*(const __attribute__((address_space(3))) bf16x8*)(kp+6656);
}
__device__ __forceinline__ void kload2(bf16x8*kf,lds_cptr kp,int j){ kf[2*j]=*(const __attribute__((address_space(3))) bf16x8*)(kp+j*2048); kf[2*j+1]=*(const __attribute__((address_space(3))) bf16x8*)(kp+j*2048+512); }
__device__ __forceinline__ s16x4 vtr(lds_cptr p){ return __builtin_bit_cast(s16x4,__builtin_amdgcn_ds_read_tr16_b64_v4i16((__attribute__((address_space(3))) v4i16_t*)p)); }
__device__ __forceinline__ float rowmax(const f32x16&p0,const f32x16&p1){
  float a=max3f(p0[0],p0[1],p1[0]),b=max3f(p0[2],p0[3],p1[1]);a=max3f(a,p1[2],p1[3]);
  #pragma unroll
  for(int r=4;r<16;r+=4){a=max3f(a,p0[r],p0[r+1]);b=max3f(b,p0[r+2],p0[r+3]);a=max3f(a,p1[r],p1[r+1]);b=max3f(b,p1[r+2],p1[r+3]);}
  const float m=max2f(a,b);
  auto rr=__builtin_amdgcn_permlane32_swap(__float_as_uint(m),__float_as_uint(m),false,false);
  return max2f(__uint_as_float(rr[0]),__uint_as_float(rr[1]));
}
__device__ __forceinline__ void pv(f32x16*o,int vb,bf16x8 pa0,bf16x8 pa1,bf16x8 pa2,bf16x8 pa3){
  #pragma unroll
  for(int d0=0;d0<2;++d0){s16x4 lo[4],hi[4];
    #pragma unroll
    for(int ks=0;ks<4;++ks){
      asm volatile("ds_read_b64_tr_b16 %0,%1 offset:%c2":"=&v"(lo[ks]):"v"(vb),"i"(d0*4096+ks*1024):"memory");
      asm volatile("ds_read_b64_tr_b16 %0,%1 offset:%c2":"=&v"(hi[ks]):"v"(vb),"i"(d0*4096+ks*1024+512):"memory");}
    asm volatile("s_waitcnt lgkmcnt(0)":::"memory");SBAR();
    #define PK(k) (bf16x8){lo[k][0],lo[k][1],lo[k][2],lo[k][3],hi[k][0],hi[k][1],hi[k][2],hi[k][3]}
    o[d0]=__builtin_amdgcn_mfma_f32_32x32x16_bf16(pa0,PK(0),o[d0],0,0,0);
    o[d0]=__builtin_amdgcn_mfma_f32_32x32x16_bf16(pa1,PK(1),o[d0],0,0,0);
    o[d0]=__builtin_amdgcn_mfma_f32_32x32x16_bf16(pa2,PK(2),o[d0],0,0,0);
    o[d0]=__builtin_amdgcn_mfma_f32_32x32x16_bf16(pa3,PK(3),o[d0],0,0,0);
    #undef PK
  }
}

#ifndef ATTN_STORE16
#define ATTN_STORE16(p,v) (*(u32x4*)(p)=(v))
#endif
template<int THRL,int MODE,int KVP> __device__ __forceinline__ void attn_unit(int b,int h,int qb,const bf16*Q,const bf16*__restrict__ K,const bf16*__restrict__ V,bf16*O,char*shm,const u32x4*SELM,const float*GATES){
  int tid=threadIdx.x; asm volatile("":"+v"(tid));
  const int lane=tid&63,r32=lane&31,hi=lane>>5; const int wid=__builtin_amdgcn_readfirstlane(tid>>6);
  const long rowbase=(long)b*SEQ; const int q0=qb*QB;
  const bf16*Qw=Q+(rowbase+q0+wid*QBLK)*DM+h*D;
  const int kvh=h>>2; const bool LOWER=(MODE==1)&&(qb>=2); const int T0=LOWER?4*qb-8:0;
  const bf16*Kh=K+(rowbase+(long)T0*KVBLK)*KVP+kvh*D,*Vh=V+(rowbase+(long)T0*KVBLK)*KVP+kvh*D;
  const unsigned lds0=(unsigned)(uintptr_t)shm;
  float*wsf=(float*)(shm+LDS_WS)+wid*64;
  const bf16*ksrc=Kh+(long)lane*KVP+wid*8;
  const bf16*vsrc=Vh+(long)(16*(wid&3)+(lane>>2))*KVP+(wid>>2)*32+(lane&3)*8;
  const unsigned kdst=lds0+LDS_K+wid*1024, vdst=lds0+LDS_V+wid*1024;
  #define DMA_K(t,slot) glds16(ksrc+(long)(t)*KVBLK*KVP,(unsigned)__builtin_amdgcn_readfirstlane(kdst+(slot)))
  #define DMA_V(t,slot) glds16(vsrc+(long)(t)*KVBLK*KVP,(unsigned)__builtin_amdgcn_readfirstlane(vdst+(slot)))
  const int vb0=(int)(lds0+LDS_V)+((lane>>4)&1)*32+(lane&3)*8+(4*hi+((lane&15)>>2))*64;
  const char*Kbase=shm+LDS_K; bf16x8 kf[8];
  const lds_cptr shm3=(lds_cptr)shm; const lds_cptr kp0=shm3+LDS_K+hi*1024+r32*16; const lds_cptr vp0=shm3+LDS_V+((lane>>4)&1)*32+(lane&3)*8+(4*hi+((lane&15)>>2))*64;
  const int NT=(q0+QB)/KVBLK-T0;
  DMA_K(0,0);DMA_V(0,0);DMA_K(1,SLOTB);
  bf16x8 qr[4];
  #pragma unroll
  for(int d0=0;d0<4;++d0)qr[d0]=*reinterpret_cast<const bf16x8*>(&Qw[(long)r32*DM+d0*16+hi*8]);
  float mhat=0.f,l_reg=0.f;f32x16 o[2];o[0]=f32x16{};o[1]=f32x16{};f32x16 negm=f32x16{};asm volatile("":"+v"(negm));
  const int qrel=wid*QBLK+r32;
  u32x4 sm=(u32x4){0u,0u,0u,0u}; unsigned selw=0xffffffffu; if(MODE==0){ sm=SELM[(long)(b*4+kvh)*SEQ+q0+wid*QBLK+r32]; }
  #define SELSTEP() do{ if(MODE==0){ selw=0u-(sm.x&1u); sm.x=__builtin_amdgcn_alignbit(sm.y,sm.x,1); sm.y=__builtin_amdgcn_alignbit(sm.z,sm.y,1); sm.z=__builtin_amdgcn_alignbit(sm.w,sm.z,1); sm.w>>=1; } }while(0)
  #define CMASK(P0,P1,t) do{int jb_=(t)-(NT-4); if(jb_>=0)cmask(P0,P1,jb_,qrel,hi);}while(0)
  bool resc=false;
  #define START(P0,P1) do{ const float rm=max2f(rowmax(P0,P1),-64.f); resc=false; \
    { const float dl=rm; mhat=fadd_s(mhat,dl); \
      _Pragma("unroll") for(int r=0;r<16;++r){P0[r]=fsub_s(P0[r],dl);P1[r]=fsub_s(P1[r],dl);} \
      _Pragma("unroll") for(int r=0;r<16;++r)negm[r]=-mhat; asm volatile("":"+v"(negm)); } \
    _Pragma("unroll") for(int r=0;r<16;++r)P0[r]=__builtin_amdgcn_exp2f(P0[r]); }while(0)
  #define RESC() do{ if(resc){ asm volatile("s_waitcnt lgkmcnt(0)":::"memory"); \
      _Pragma("unroll") for(int d_=0;d_<2;++d_) _Pragma("unroll") for(int r=0;r<16;++r)o[d_][r]*=wsf[crow(r,hi)]; } }while(0)
  f32x16 pA0,pA1,pB0,pB1;
  int sl_prev=0,sl_cur=0,sl_next=SLOTB;
  #define ROT() do{sl_prev=sl_cur;sl_cur=sl_next;sl_next=(sl_next==(NSLOT-1)*SLOTB)?0:sl_next+SLOTB;}while(0)
  DMA_K(2,2*SLOTB);
  WAIT_BAR(3);
  qkt(pA0,pA1,Kbase,qr,negm,r32,hi);asm volatile("s_nop 15\n\ts_nop 7":"+v"(pA0),"+v"(pA1));CMASK(pA0,pA1,0); if(LOWER)lmask(pA0,pA1,0,qrel,hi);
  START(pA0,pA1);
  _Pragma("unroll") for(int r=0;r<16;++r)pA1[r]=__builtin_amdgcn_exp2f(pA1[r]);
  WAIT_BAR(0);
  DMA_K(3,0);DMA_V(1,SLOTB);
  ROT();
  kload8(kf,kp0+sl_cur);
  WAIT_BAR(2);
  s16x4 vlo[8],vhi[8]; u32x4 pw0,pw1,pw2,pw3;
  #define PKW(P,B) (cvtpk_s(P[B],P[B+1])&selw)
  #define PAF(k) __builtin_bit_cast(bf16x8,pw##k)
  #define VFR(i) (bf16x8){vlo[i][0],vlo[i][1],vlo[i][2],vlo[i][3],vhi[i][0],vhi[i][1],vhi[i][2],vhi[i][3]}
  #define PIN(x) asm volatile("":"+v"(x))
  #define MX3(a,b,c) __builtin_fmaxf(__builtin_fmaxf((a),(b)),(c))
  #define GAPA(MF,A0,A1,A2,A3,W0,W1,PW) do{ MF; sacc+=A0; sacc+=A1; sacc+=A2; sacc+=A3; PIN(sacc); W0; W1; PIN(PW); SBAR(); }while(0)
  #define EX(v) __builtin_amdgcn_exp2f(v)
  #define GAPB(MF,X,B) do{ MF; X[B]=EX(X[B]); X[B+1]=EX(X[B+1]); X[B+2]=EX(X[B+2]); X[B+3]=EX(X[B+3]); PIN(X); SBAR(); }while(0)
  #define VRD(i) do{ vlo[i]=vtr(vp_+(((i)>>2)*4096+((i)&3)*1024)); vhi[i]=vtr(vp_+(((i)>>2)*4096+((i)&3)*1024+512)); }while(0)
  #define KRD(G,j) do{ if(G){ kload2(kf,kp0+sl_next,j); SBAR(); } }while(0)
  #define STEP(C0,C1,P0,P1,t,GK,GV,GL) do{ SELSTEP(); SBAR(); \
    const lds_cptr vp_=vp0+sl_prev; \
    VRD(0); SBAR(); float sacc=(P0[0]+P0[1]); \
    GAPA(C0=__builtin_amdgcn_mfma_f32_32x32x16_bf16(kf[0],qr[0],negm,0,0,0), P0[2],P0[3],P0[4],P0[5],     pw0[0]=PKW(P0,0), pw0[1]=PKW(P0,2), pw0); \
    VRD(4); SBAR(); GAPA(C1=__builtin_amdgcn_mfma_f32_32x32x16_bf16(kf[1],qr[0],negm,0,0,0), P0[6],P0[7],P0[8],P0[9],     pw0[2]=PKW(P0,4), pw0[3]=PKW(P0,6), pw0); \
    VRD(1); SBAR(); GAPA(C0=__builtin_amdgcn_mfma_f32_32x32x16_bf16(kf[2],qr[1],C0,0,0,0),   P0[10],P0[11],P0[12],P0[13], pw1[0]=PKW(P0,8), pw1[1]=PKW(P0,10), pw1); \
    VRD(5); SBAR(); GAPA(C1=__builtin_amdgcn_mfma_f32_32x32x16_bf16(kf[3],qr[1],C1,0,0,0),   P0[14],P0[15],P1[0],P1[1],   pw1[2]=PKW(P0,12),pw1[3]=PKW(P0,14), pw1); \
    VRD(2); SBAR(); GAPA(C0=__builtin_amdgcn_mfma_f32_32x32x16_bf16(kf[4],qr[2],C0,0,0,0),   P1[2],P1[3],P1[4],P1[5],     pw2[0]=PKW(P1,0), pw2[1]=PKW(P1,2), pw2); \
    VRD(6); SBAR(); GAPA(C1=__builtin_amdgcn_mfma_f32_32x32x16_bf16(kf[5],qr[2],C1,0,0,0),   P1[6],P1[7],P1[8],P1[9],     pw2[2]=PKW(P1,4), pw2[3]=PKW(P1,6), pw2); \
    VRD(3); SBAR(); GAPA(C0=__builtin_amdgcn_mfma_f32_32x32x16_bf16(kf[6],qr[3],C0,0,0,0),   P1[10],P1[11],P1[12],P1[13], pw3[0]=PKW(P1,8), pw3[1]=PKW(P1,10), pw3); \
    VRD(7); SBAR(); GAPA(C1=__builtin_amdgcn_mfma_f32_32x32x16_bf16(kf[7],qr[3],C1,0,0,0),   P1[14],P1[15],0.f,0.f,       pw3[2]=PKW(P1,12),pw3[3]=PKW(P1,14), pw3); \
    l_reg+=__uint_as_float(__float_as_uint(sacc)&selw); \
    if(GK){DMA_K((t)+3,sl_cur);} if(GV){DMA_V((t)+1,sl_next);} \
    CMASK(C0,C1,t); \
    { float a=MX3(C0[0],C0[1],C1[0]),b=MX3(C0[2],C0[3],C1[1]); a=MX3(a,C1[2],C1[3]); \
      _Pragma("unroll") for(int r=4;r<16;r+=4){a=MX3(a,C0[r],C0[r+1]);b=MX3(b,C0[r+2],C0[r+3]);a=MX3(a,C1[r],C1[r+1]);b=MX3(b,C1[r+2],C1[r+3]);} \
      float rm=__builtin_fmaxf(a,b); { auto rr=__builtin_amdgcn_permlane32_swap(__float_as_uint(rm),__float_as_uint(rm),false,false); rm=__builtin_fmaxf(__uint_as_float(rr[0]),__uint_as_float(rr[1])); } \
      resc=false; \
      if(__builtin_expect(__any(rm>(float)THRL),0)){ const float dl=__builtin_fmaxf(rm,0.f); mhat+=dl; \
        _Pragma("unroll") for(int r=0;r<16;++r){C0[r]-=dl;C1[r]-=dl;} \
        _Pragma("unroll") for(int r=0;r<16;++r)negm[r]=-mhat; asm volatile("":"+v"(negm)); \
        const float f=__builtin_amdgcn_exp2f(-dl); l_reg*=f; if(hi==0)wsf[r32]=f; resc=true; } } \
    SBAR(); \
    GAPB(o[0]=__builtin_amdgcn_mfma_f32_32x32x16_bf16(PAF(0),VFR(0),o[0],0,0,0), C0,0); \
    GAPB(o[1]=__builtin_amdgcn_mfma_f32_32x32x16_bf16(PAF(0),VFR(4),o[1],0,0,0), C0,4); \
    KRD(GL,0); GAPB(o[0]=__builtin_amdgcn_mfma_f32_32x32x16_bf16(PAF(1),VFR(1),o[0],0,0,0), C0,8); \
    KRD(GL,1); GAPB(o[1]=__builtin_amdgcn_mfma_f32_32x32x16_bf16(PAF(1),VFR(5),o[1],0,0,0), C0,12); \
    KRD(GL,2); GAPB(o[0]=__builtin_amdgcn_mfma_f32_32x32x16_bf16(PAF(2),VFR(2),o[0],0,0,0), C1,0); \
    KRD(GL,3); GAPB(o[1]=__builtin_amdgcn_mfma_f32_32x32x16_bf16(PAF(2),VFR(6),o[1],0,0,0), C1,4); \
    GAPB(o[0]=__builtin_amdgcn_mfma_f32_32x32x16_bf16(PAF(3),VFR(3),o[0],0,0,0), C1,8); \
    GAPB(o[1]=__builtin_amdgcn_mfma_f32_32x32x16_bf16(PAF(3),VFR(7),o[1],0,0,0), C1,12); \
    }while(0)
  int t=1;
  #undef CMASK
  #define CMASK(P0,P1,t) lmask(P0,P1,(t),qrel,hi)
  if(LOWER){ for(;t<5;t+=2){
    STEP(pB0,pB1,pA0,pA1,t,true,true,true);     WAIT_BAR(2); RESC(); ROT();
    STEP(pA0,pA1,pB0,pB1,t+1,true,true,true);   WAIT_BAR(2); RESC(); ROT();
  } }
  #undef CMASK
  #define CMASK(P0,P1,t) do{}while(0)
  for(;t+5<NT;t+=2){
    STEP(pB0,pB1,pA0,pA1,t,true,true,true);     WAIT_BAR(2); RESC(); ROT();
    STEP(pA0,pA1,pB0,pB1,t+1,true,true,true);   WAIT_BAR(2); RESC(); ROT();
  }
  #undef CMASK
  #define CMASK(P0,P1,t) do{int jb_=(t)-(NT-4); if(jb_>=0)cmask(P0,P1,jb_,qrel,hi);}while(0)
  #define ENDW(tt) do{ if((tt)+3<NT){WAIT_BAR(2);} else if((tt)+2<NT){WAIT_BAR(1);} else {WAIT_BAR(0);} }while(0)
  for(;t+1<NT;t+=2){
    STEP(pB0,pB1,pA0,pA1,t,(t+3<NT),(t+1<NT),(t+1<NT));       ENDW(t);   RESC(); ROT();
    STEP(pA0,pA1,pB0,pB1,t+1,(t+4<NT),(t+2<NT),(t+2<NT));     ENDW(t+1); RESC(); ROT();
  }
  STEP(pB0,pB1,pA0,pA1,NT-1,false,false,false); RESC();
  { SELSTEP(); float sacc=pB0[0]+pB0[1]; _Pragma("unroll") for(int r=2;r<16;++r)sacc+=pB0[r]; _Pragma("unroll") for(int r=0;r<16;++r)sacc+=pB1[r]; l_reg+=__uint_as_float(__float_as_uint(sacc)&selw);
    pw0=(u32x4){PKW(pB0,0),PKW(pB0,2),PKW(pB0,4),PKW(pB0,6)};pw1=(u32x4){PKW(pB0,8),PKW(pB0,10),PKW(pB0,12),PKW(pB0,14)};pw2=(u32x4){PKW(pB1,0),PKW(pB1,2),PKW(pB1,4),PKW(pB1,6)};pw3=(u32x4){PKW(pB1,8),PKW(pB1,10),PKW(pB1,12),PKW(pB1,14)};
    SBAR(); pv(o,vb0+sl_cur,PAF(0),PAF(1),PAF(2),PAF(3)); }
  #undef PKW
  #undef PAF
  #undef VFR
  #undef PIN
  #undef MX3
  #undef GAPA
  #undef GAPB
  #undef EX
  #undef VRD
  #undef KRD
  #undef STEP
  #undef ENDW
  {auto rr=__builtin_amdgcn_permlane32_swap(__float_as_uint(l_reg),__float_as_uint(l_reg),false,false);l_reg=__uint_as_float(rr[0])+__uint_as_float(rr[1]);}
  if(hi==0){ const float gt=GATES[(rowbase+q0+wid*QBLK+r32)*48+h*3+1+MODE]; wsf[32+r32]=gt*__builtin_amdgcn_rcpf(l_reg); } asm volatile("s_waitcnt lgkmcnt(0)":::"memory");
  float rli[16];
  #pragma unroll
  for(int r=0;r<16;++r)rli[r]=wsf[32+crow(r,hi)];
  bf16*Ow=O+(rowbase+q0+wid*QBLK)*DM+h*D;
  { bf16*stg=(bf16*)(shm+LDS_OST)+wid*2048;
    #pragma unroll
    for(int r=0;r<16;++r){const int orow=crow(r,hi);
      #pragma unroll
      for(int d0=0;d0<2;++d0)stg[orow*64+d0*32+r32]=__float2bfloat16(o[d0][r]*rli[r]);}
    asm volatile("s_waitcnt lgkmcnt(0)":::"memory");
    #pragma unroll
    for(int i=0;i<4;++i){const int row=i*8+(lane>>3),ch=lane&7; const u32x4 v=*(const u32x4*)(stg+row*64+ch*8); const u32x4 pv=*(const u32x4*)(Ow+(long)row*DM+ch*8); u32x4 o4;
      #pragma unroll
      for(int e=0;e<4;++e){ const float lo=__uint_as_float(v[e]<<16)+__uint_as_float(pv[e]<<16), hi2=__uint_as_float(v[e]&0xffff0000u)+__uint_as_float(pv[e]&0xffff0000u); o4[e]=cvtpk_s(lo,hi2); }
      ATTN_STORE16(Ow+(long)row*DM+ch*8,o4);} }
  asm volatile("s_waitcnt lgkmcnt(0)\n\ts_barrier":::"memory");
  #undef DMA_K
  #undef DMA_V
  #undef CMASK
  #undef START
  #undef RESC
  #undef ROT
  #undef SELSTEP
}
constexpr int ATTN_LDS_BYTES=LDS_BYTES;
struct AttnUnit { int bh; int qb; };
template<int THRL=8> __device__ __forceinline__ void attn_phase(char*lds,unsigned char*ws_,int vcu,int G){
  for(int i=0;;++i){ const int L=i*G+vcu; if(L>=BATCH*NHEAD*8*4) break; const int v=L%(BATCH*NHEAD*8), rnd=L/(BATCH*NHEAD*8), s=v&7; AttnUnit u; u.bh=v>>3; u.qb=(rnd==0)?s:(rnd==1)?15-s:(rnd==2)?16+s:31-s;
    __attribute__((address_space(1))) unsigned char* wg=(__attribute__((address_space(1))) unsigned char*)ws_; asm volatile("":"+s"(wg));
    unsigned char* ws=(unsigned char*)wg;
    const bf16*Q=(const bf16*)(ws+WS_QB); const bf16*KV=(const bf16*)(ws+WS_KVB); const bf16*WN=(const bf16*)(ws+WS_WINB); bf16*O=(bf16*)(ws+WS_OB); const u32x4*SELM=(const u32x4*)(ws+WS_SELM); const float*GATES=(const float*)(ws+WS_GATES);
    attn_unit<THRL,0,1024>(u.bh/NHEAD,u.bh%NHEAD,u.qb,Q,KV+512,KV+768,O,lds,SELM,GATES);
    asm volatile("s_waitcnt vmcnt(0)":::"memory");
    attn_unit<THRL,1,512>(u.bh/NHEAD,u.bh%NHEAD,u.qb,Q,WN,WN+256,O,lds,nullptr,GATES);
    asm volatile("s_waitcnt vmcnt(0)":::"memory"); }
}
#undef SBAR
#undef WAIT_BAR
}

typedef float f32x16 __attribute__((ext_vector_type(16)));
__device__ __forceinline__ int crow16(int r, int hi) { return (r & 3) + 8 * (r >> 2) + 4 * hi; }
__device__ __forceinline__ void cmpsel_phase(Ctx& F) {
    const int w = F.wave;
    const bf16* QB = (const bf16*)(F.ws + WS_QB); const float* KC = (const float*)(F.ws + WS_KC); const float* VC = (const float*)(F.ws + WS_VC); const float* GATES = (const float*)(F.ws + WS_GATES);
    bf16* OB = (bf16*)(F.ws + WS_OB); v4u* SELM = (v4u*)(F.ws + WS_SELM);
    for (int u = F.vcu; u < NBP * 4 * NBLK; u += F.G) {
        int lane = F.lane; asm volatile("" : "+v"(lane));
        const int r32 = lane & 31, hi = lane >> 5, g = r32 >> 3, ql = r32 & 7;
        const int i = u & 127, bk = u >> 7, b = bk >> 2, kvh = bk & 3;
        const int t = 64 * i + 8 * w + ql, row = b * SEQ + t, h = kvh * 4 + g;
        bf16x8 qf[4];
#pragma unroll
        for (int s = 0; s < 4; ++s) qf[s] = *(const bf16x8*)(QB + (size_t)row * D + h * 64 + 16 * s + 8 * hi);
        const float gatev = GATES[(size_t)row * 48 + h * 3];
        const int ntile = (i >> 5) + 1;
        f32x16 p[4];
#pragma unroll
        for (int kt = 0; kt < 4; ++kt) { p[kt] = (f32x16){};
            if (kt < ntile) {
#pragma unroll
                for (int s = 0; s < 4; ++s) { const float* kp = KC + ((size_t)((b * NBLK + 32 * kt + r32) * 4 + kvh)) * 64 + 16 * s + 8 * hi;
                    p[kt] = __builtin_amdgcn_mfma_f32_32x32x16_bf16(pack8(*(const f32x4*)kp, *(const f32x4*)(kp + 4)), qf[s], p[kt], 0, 0, 0); } } }
        const bool lastq = (t & 63) == 63;
        float m = -INFINITY;
#pragma unroll
        for (int kt = 0; kt < 4; ++kt)
#pragma unroll
            for (int r = 0; r < 16; ++r) { const int j = 32 * kt + crow16(r, hi); const bool valid = (j < i) || (j == i && lastq); if (!valid) p[kt][r] = -INFINITY; m = fmaxf(m, p[kt][r]); }
        m = fmaxf(m, __shfl_xor(m, 32)); m = fmaxf(m, -64.f);
        float l = 0.f;
#pragma unroll
        for (int kt = 0; kt < 4; ++kt)
#pragma unroll
            for (int r = 0; r < 16; ++r) { const float e = __builtin_amdgcn_exp2f(p[kt][r] - m); p[kt][r] = e; l += e; }
        l += __shfl_xor(l, 32);
        const float il = l > 0.f ? 1.f / l : 0.f;
#pragma unroll
        for (int kt = 0; kt < 4; ++kt) p[kt] = p[kt] * il;
        f32x16 o[2]; o[0] = (f32x16){}; o[1] = (f32x16){};
#pragma unroll
        for (int kt = 0; kt < 4; ++kt) if (kt < ntile) {
#pragma unroll
            for (int s = 0; s < 2; ++s) { v4u pw; pw.x = pg8::cvt_pk_bf16(p[kt][8 * s + 0], p[kt][8 * s + 1]); pw.y = pg8::cvt_pk_bf16(p[kt][8 * s + 2], p[kt][8 * s + 3]); pw.z = pg8::cvt_pk_bf16(p[kt][8 * s + 4], p[kt][8 * s + 5]); pw.w = pg8::cvt_pk_bf16(p[kt][8 * s + 6], p[kt][8 * s + 7]);
                const bf16x8 pa = __builtin_bit_cast(bf16x8, pw);
#pragma unroll
                for (int d0 = 0; d0 < 2; ++d0) { float vv[8];
#pragma unroll
                    for (int jj = 0; jj < 8; ++jj) vv[jj] = VC[((size_t)((b * NBLK + 32 * kt + 16 * s + 8 * (jj >> 2) + 4 * hi + (jj & 3)) * 4 + kvh)) * 64 + 32 * d0 + r32];
                    o[d0] = __builtin_amdgcn_mfma_f32_32x32x16_bf16(pa, pack8((f32x4){vv[0], vv[1], vv[2], vv[3]}, (f32x4){vv[4], vv[5], vv[6], vv[7]}), o[d0], 0, 0, 0); }
                __builtin_amdgcn_sched_barrier(0); } }
#pragma unroll
        for (int r = 0; r < 16; ++r) { const int rw = crow16(r, hi); const float gt = __shfl(gatev, rw); bf16* op = OB + (size_t)(b * SEQ + 64 * i + 8 * w + (rw & 7)) * D + (kvh * 4 + (rw >> 3)) * 64 + r32;
            op[0] = (bf16)f2bf(gt * o[0][r]); op[32] = (bf16)f2bf(gt * o[1][r]); }
#pragma unroll
        for (int kt = 0; kt < 4; ++kt)
#pragma unroll
            for (int r = 0; r < 16; ++r) { float x = p[kt][r]; x += __shfl_xor(x, 8); x += __shfl_xor(x, 16); p[kt][r] = x; }
        unsigned T = 0u;
        if (i >= 16) {
            unsigned xs[16];
#pragma unroll
            for (int kt = 0; kt < 4; ++kt)
#pragma unroll
                for (int k = 0; k < 4; ++k) { float v = p[kt][k]; v = (g == 1) ? p[kt][4 + k] : v; v = (g == 2) ? p[kt][8 + k] : v; v = (g == 3) ? p[kt][12 + k] : v;
                    const int j = 32 * kt + 8 * g + 4 * hi + k; xs[kt * 4 + k] = (j >= 1 && j <= i - 2) ? __float_as_uint(v) : 0u; }
            for (int bit = 30; bit >= 0; --bit) { const unsigned c = T | (1u << bit); int cnt = 0;
#pragma unroll
                for (int q = 0; q < 16; ++q) cnt += (xs[q] >= c) ? 1 : 0;
                cnt += __shfl_xor(cnt, 8); cnt += __shfl_xor(cnt, 16); cnt += __shfl_xor(cnt, 32);
                if (cnt >= 13) T = c; }
        }
        v4u wd;
#pragma unroll
        for (int kt = 0; kt < 4; ++kt) { unsigned wv = 0u;
#pragma unroll
            for (int r = 0; r < 16; ++r) { const int cr = crow16(r, hi), j = 32 * kt + cr; bool sel;
                if (i >= 16) sel = (j == 0) || (j == i) || (j == i - 1) || (j >= 1 && j <= i - 2 && __float_as_uint(p[kt][r]) >= T); else sel = j <= i;
                wv |= sel ? (1u << cr) : 0u; }
            wv |= (unsigned)__shfl_xor((int)wv, 32); wd[kt] = wv; }
        if (g == 0 && hi == 0) SELM[(size_t)(b * 4 + kvh) * SEQ + t] = wd;
    }
}

constexpr int NPHASES = 33;
__global__ void __launch_bounds__(512, 2) mk_fwd(Args args) {
    extern __shared__ __attribute__((aligned(16))) unsigned char lds_raw[];
    Ctx F;
    F.lds = (LAS unsigned char*)lds_raw; F.tid = threadIdx.x; F.lane = F.tid & 63; F.wave = __builtin_amdgcn_readfirstlane(F.tid >> 6);
    F.G = gridDim.x; { const int bx = blockIdx.x; F.vcu = (F.G % 8 == 0) ? (bx % 8) * (F.G / 8) + bx / 8 : bx; }
    F.gw = F.vcu * 8 + F.wave; F.NGW = F.G * 8;
    F.out = args.out; F.ws = args.ws; unsigned char* ws = args.ws;
    volatile LAS unsigned* MISC = (volatile LAS unsigned*)(F.lds + MISC_OFF);
    for (int u = F.tid; u < (LDS_BYTES - RING_BYTES) / 4; u += 512) ((LAS unsigned*)(F.lds + RING_BYTES))[u] = 0u;
    __syncthreads();
    unsigned* ctl = (unsigned*)(ws + WS_CTL);
    XcdBarrier bar; bar.bar = ctl + CW_BAR; bar.x = 0; bar.st = nullptr;
    const int lo = args.ph_lo, hi = args.ph_hi;
    if (hi - lo > 1) bar = xcd_barrier_post(ctl + CW_BAR, MISC + 8);
    int ph = 0;
    const Ctx& F0 = F;
#define PH_BEGIN if (ph >= lo && ph < hi) { Ctx F = fresh(F0); float* X = F.out + O_Y; (void)X;
#define PH_CLOSE } do { if (ph >= lo && ph + 1 < hi) { XcdBarrier b2_ = bar; asm volatile("" : "+s"(b2_.bar), "+s"(b2_.x)); xcd_barrier(b2_); } ++ph; } while (0)
#define XLO (l == 0 ? (const float*)kin(0) : (const float*)X)
#define XHI (l == 0 ? (const float*)kin(1) : (const float*)(X + (size_t)MP * D))
#define WSB(off) ((bf16*)(F.ws + (off)))
#define WSF(off) ((float*)(F.ws + (off)))
    const int bxi = (int)blockIdx.x;
    PH_BEGIN p0_prologue(F); PH_CLOSE;
    PH_BEGIN pg8::Gemm g{WSB(WS_CB), WSB(WS_ADAT), D, D, D, 0}; pg8::StaticOrder S; S.init(256, NADA, F.G, bxi); pg8::EpiF32 E{WSF(WS_MODS), NADA, 64, (const float*)kin(9), (const float*)kin(15), 8 * 3072};
        pg8::gemm_phase(F.lds, g, S, E); PH_CLOSE;
    for (int l = 0; l < 4; ++l) {
        if (l < 2) {
            PH_BEGIN pass_h(F, l, XLO, XHI); PH_CLOSE;
            PH_BEGIN pass_pool(F); PH_CLOSE;
            PH_BEGIN pg8::Gemm g{WSB(WS_XN2), WSB(WS_POOLW) + (size_t)l * 1024 * 256, D, 256, 256, 256}; pg8::StaticOrder S; S.init(MPAD, D, F.G, bxi);
                pg8::EpiRes E{XLO, XHI, X, WSF(WS_MODS), (l * 2 + 0) * 3072 + 2048, (const float*)kin(13) + l * D}; pg8::gemm_phase(F.lds, g, S, E); PH_CLOSE;
        } else {
            const int j = l - 2;
            PH_BEGIN if (l == 2) pass_norm(F, X, X + (size_t)MP * D, (const float*)kin(10) + l * D, (l * 2 + 0) * 3072, WSB(WS_XN), (const float*)kin(16), 8 * 3072, WSB(WS_XN2));
                     else pass_norm(F, X, X + (size_t)MP * D, (const float*)kin(10) + l * D, (l * 2 + 0) * 3072, WSB(WS_XN), nullptr, 0, nullptr); PH_CLOSE;
            PH_BEGIN
                if (l == 2) { pg8::Gemm g{WSB(WS_XN2), WSB(WS_WKV), D, D, D, 0}; pg8::StaticOrder S; S.init(MPAD, NKV, F.G, bxi); pg8::EpiF32 E{WSF(WS_RAWKV), NKV, MPAD, nullptr, nullptr, 0}; pg8::gemm_phase(F.lds, g, S, E); }
                { pg8::Gemm g{WSB(WS_XN), WSB(WS_WQG) + (size_t)j * NQGP * D, D, D, D, 0}; pg8::StaticOrder S; S.init(MPAD, NQGP, F.G, bxi); pg8::EpiF32 E{WSF(WS_RAWQ), NQGP, MPAD, nullptr, nullptr, 0}; pg8::gemm_phase(F.lds, g, S, E); }
            PH_CLOSE;
            PH_BEGIN if (l == 2) pass_kvpost(F); pass_qpost(F, j); PH_CLOSE;
            if (l == 2) { PH_BEGIN compress_phase(F); PH_CLOSE; }
            PH_BEGIN attn_sample_naive(F); cmpsel_phase(F); PH_CLOSE;
            PH_BEGIN attn_body::attn_phase<8>((char*)lds_raw, F.ws, F.vcu, F.G); PH_CLOSE;
            PH_BEGIN pg8::Gemm g{WSB(WS_OB), WSB(WS_WO) + (size_t)j * D * D, D, D, D, 0}; pg8::StaticOrder S; S.init(MPAD, D, F.G, bxi);
                pg8::EpiRes E{X, X + (size_t)MP * D, X, WSF(WS_MODS), (l * 2 + 0) * 3072 + 2048, nullptr}; pg8::gemm_phase(F.lds, g, S, E); PH_CLOSE;
        }
        PH_BEGIN pass_norm(F, X, X + (size_t)MP * D, (const float*)kin(11) + l * D, (l * 2 + 1) * 3072, WSB(WS_XN), nullptr, 0, nullptr); PH_CLOSE;
        PH_BEGIN pg8::Gemm g{WSB(WS_XN), WSB(WS_WGU) + (size_t)l * NGU * D, D, D, D, 0}; pg8::StaticOrder S; S.init(MPAD, NGU, F.G, bxi); pg8::EpiSwiglu E{WSB(WS_H), DFF}; pg8::gemm_phase(F.lds, g, S, E); PH_CLOSE;
        PH_BEGIN pg8::Gemm g{WSB(WS_H), WSB(WS_WDN) + (size_t)l * D * DFF, DFF, DFF, DFF, 0}; pg8::StaticOrder S; S.init(MPAD, D, F.G, bxi);
            pg8::EpiRes E{X, X + (size_t)MP * D, X, WSF(WS_MODS), (l * 2 + 1) * 3072 + 2048, nullptr}; pg8::gemm_phase(F.lds, g, S, E); PH_CLOSE;
    }
}

extern "C" void kernel_launch(void* const* d_in, const int* in_sizes, int n_in, void* d_out, int out_size, void* d_ws, size_t ws_size, hipStream_t stream) {
    static int grid = 0;
    if (grid == 0) {
        if (n_in != 27 || (size_t)out_size != O_END || ws_size < WS_END) { fprintf(stderr, "kernel_launch: unexpected shapes (n_in %d out %d ws %zu)\n", n_in, out_size, ws_size); grid = -1; return; }
        int dev = 0, cus = 0, per_cu = 0;
        if (hipGetDevice(&dev) != hipSuccess || hipDeviceGetAttribute(&cus, hipDeviceAttributeMultiprocessorCount, dev) != hipSuccess) { grid = -1; return; }
        if (hipFuncSetAttribute((const void*)mk_fwd, hipFuncAttributeMaxDynamicSharedMemorySize, LDS_BYTES) != hipSuccess) { fprintf(stderr, "kernel_launch: hipFuncSetAttribute failed\n"); grid = -1; return; }
        if (hipOccupancyMaxActiveBlocksPerMultiprocessor(&per_cu, (const void*)mk_fwd, 512, LDS_BYTES) != hipSuccess || per_cu < 1) fprintf(stderr, "kernel_launch: occupancy query reports %d\n", per_cu);
        (void)hipGetLastError();
        grid = cus;
    }
    if (grid < 0) return;
    (void)hipMemsetAsync((char*)d_ws + WS_CTL, 0, CTL_ZERO_BYTES, stream);
    Args a{};
    for (int i = 0; i < 27; ++i) a.in[i] = d_in[i];
    a.out = (float*)d_out; a.ws = (unsigned char*)d_ws;
#if MK_PER_PHASE
    for (int p = 0; p < NPHASES; ++p) { a.ph_lo = p; a.ph_hi = p + 1; hipLaunchKernelGGL(mk_fwd, dim3(grid), dim3(512), LDS_BYTES, stream, a); }
#else
    a.ph_lo = 0; a.ph_hi = NPHASES; hipLaunchKernelGGL(mk_fwd, dim3(grid), dim3(512), LDS_BYTES, stream, a);
#endif
}
```

```cpp
#include <hip/hip_runtime.h>
#include <cstdio>
#include <cstdint>
#include <hip/hip_bf16.h>
#include <cmath>

#ifndef MK_PER_PHASE
#define MK_PER_PHASE 0
#endif

constexpr int D = 1024, SEQ = 8192, NBP = 2, NBS = 32, MP = NBP * SEQ  , MR = MP + NBS  , MPAD = 16640  ;
constexpr int DFF = 2816, NGU = 2 * DFF, NKV = 1536, NQG = 1072, NQGP = 1280, NADA = 8 * 3072 + 2048  ;
constexpr int NBLK = 128, NBATCH = NBP + NBS  , NBLKT = NBATCH * NBLK  ;
constexpr float EPS = 1e-6f;
constexpr float C2 = 0.125f * 1.4426950408889634f;

constexpr size_t O_Y = 0, O_KV = (size_t)MR * 1024, O_WINP = O_KV + (size_t)MR * 1024, O_WINS = O_WINP + (size_t)2 * 512 * 512, O_POOLP = O_WINS + (size_t)32 * 512 * 512,
                 O_POOLS = O_POOLP + (size_t)2 * 2 * 15 * 1024, O_END = O_POOLS + (size_t)2 * 32 * 15 * 1024;
static_assert(O_END == 43577344, "output size");

constexpr size_t MiB = 1u << 20;
constexpr size_t WS_CTL = 0, CTL_ZERO_BYTES = 1 * MiB;
constexpr size_t WS_MODS = 1 * MiB, WS_CB = 8 * MiB, WS_ROPE = 9 * MiB, WS_BIASPE = 10 * MiB;
constexpr size_t WS_ADAT = 16 * MiB, WS_WGU = 68 * MiB, WS_WDN = 112 * MiB, WS_WKV = 134 * MiB, WS_WQG = 137 * MiB, WS_WO = 142 * MiB, WS_POOLW = 146 * MiB, WS_W1T = 147 * MiB;
constexpr size_t WS_XN = 160 * MiB, WS_XN2 = 193 * MiB, WS_H0 = 226 * MiB, WS_H = 291 * MiB, WS_RAWKV = 381 * MiB, WS_RAWQ = 479 * MiB, WS_KVB = 561 * MiB, WS_WINB = 594 * MiB,
                 WS_QB = 611 * MiB, WS_OB = 644 * MiB, WS_GATES = 677 * MiB, WS_KC = 681 * MiB, WS_VC = 686 * MiB, WS_SELM = 691 * MiB, WS_END = 700 * MiB;
constexpr int CW_BAR = 4096;

#define GAS __attribute__((address_space(1)))
#define LAS __attribute__((address_space(3)))
typedef unsigned short bf16;
typedef float f32x4 __attribute__((ext_vector_type(4)));
typedef float f32x2 __attribute__((ext_vector_type(2)));
typedef unsigned v4u __attribute__((ext_vector_type(4)));
typedef unsigned v2u __attribute__((ext_vector_type(2)));
typedef short bf16x8 __attribute__((ext_vector_type(8)));
#define RLX_AGENT __ATOMIC_RELAXED, __HIP_MEMORY_SCOPE_AGENT
#define LDS_WAIT() asm volatile("s_waitcnt lgkmcnt(0)" ::: "memory")
#define VM_WAIT() asm volatile("s_waitcnt vmcnt(0)" ::: "memory")

__device__ __forceinline__ unsigned f2bf(float f) { unsigned u = __builtin_bit_cast(unsigned, f); return (u + 0x7fffu + ((u >> 16) & 1u)) >> 16; }
__device__ __forceinline__ unsigned pk2(float lo, float hi) { return f2bf(lo) | (f2bf(hi) << 16); }
__device__ __forceinline__ float bf2f(unsigned short u) { return __builtin_bit_cast(float, (unsigned)u << 16); }
__device__ __forceinline__ float wave_sum(float v) {
#pragma unroll
    for (int o = 1; o < 64; o <<= 1) v += __shfl_xor(v, o);
    return v;
}
__device__ __forceinline__ float wave_max(float v) {
#pragma unroll
    for (int o = 1; o < 64; o <<= 1) v = fmaxf(v, __shfl_xor(v, o));
    return v;
}
__device__ __forceinline__ int bidx_of(int row) { return row < MP ? (row >> 13) : ((row - MP + 2) < NBATCH ? (row - MP + 2) : NBATCH - 1); }

namespace pg8 {
#define PG8_LAS __attribute__((address_space(3)))
typedef unsigned short bf16_t;
typedef short bf16x8 __attribute__((ext_vector_type(8)));
typedef float f32x4 __attribute__((ext_vector_type(4)));
typedef unsigned u32x4 __attribute__((ext_vector_type(4)));
constexpr int BM = 256, BK = 64, HALF = 128, HTB = HALF * BK * 2, STAGE_BYTES = 8 * HTB, NXCD = 8, WGM = 8;
__host__ __device__ __forceinline__ int lds_byte(int r, int c) { const int st = (r >> 4) * 2 + (c >> 5), rr = r & 15, cc = c & 31, ob = rr * 64 + cc * 2; return st * 1024 + (ob ^ (((ob >> 9) & 1) << 5)); }
__host__ __device__ __forceinline__ void stage_rc(int b, int& R, int& C) { const int st = b / 1024, sb = b % 1024, swz = sb ^ (((sb >> 9) & 1) << 5); R = (st >> 1) * 16 + swz / 64; C = (st & 1) * 32 + (swz % 64) / 2; }
__host__ __device__ __forceinline__ int perm32(int rho) { const int n = rho >> 4, i = rho & 15; return 8 * (i >> 2) + 4 * n + (i & 3); }
struct Unit { int pm, pn; };
struct Gemm { const bf16_t* A; const bf16_t* Bt; int lda, ldb, K, a_pn_off; };
struct StaticOrder {
    int nM, nN, nwg, G, c;
    __host__ __device__ void init(int M, int N, int G_, int c_) { nM = M / BM; nN = N / BM; nwg = nM * nN; G = G_; c = c_; }
    __host__ __device__ bool next(int i, Unit& u) const {
        const long L = (long)i * G + c; if (L >= nwg) return false;
        int wgid = (int)L; { const int q = nwg / NXCD, r = nwg % NXCD, xcd = wgid % NXCD, off = wgid / NXCD; wgid = (xcd < r ? xcd * (q + 1) : r * (q + 1) + (xcd - r) * q) + off; }
        const int nig = WGM * nN, gid = wgid / nig, fm = gid * WGM, gsz = (nM - fm) < WGM ? (nM - fm) : WGM;
        u.pm = fm + ((wgid % nig) % gsz); u.pn = (wgid % nig) / gsz; return true;
    }
};
template <class Epi>
__device__ __forceinline__ void gemm_phase(PG8_LAS unsigned char* lds, const Gemm g, const StaticOrder& S, const Epi& E) {
    int tid = threadIdx.x; asm volatile("" : "+v"(tid));
    const int wid = __builtin_amdgcn_readfirstlane(tid >> 6), lane = tid & 63, wr = wid >> 2, wc = wid & 3, fr = lane & 15, fq = lane >> 4;
    const int K = g.K, nt = K / BK;
    unsigned voffA[2], voffB[2];
#pragma unroll
    for (int i = 0; i < 2; ++i) { int R, C; stage_rc(tid * 16 + i * 8192, R, C); const int Rb = Epi::PERM ? ((R & ~31) + perm32(R & 31)) : R;
        voffA[i] = (unsigned)(R * g.lda + C) * 2u; voffB[i] = (unsigned)(Rb * g.ldb + C) * 2u; }
    const size_t kstep = (size_t)(BK * 2);
    const size_t hstepA = (size_t)HALF * g.lda * 2, hstepB = (size_t)HALF * g.ldb * 2, tstepA = 2 * hstepA, tstepB = 2 * hstepB;
    const unsigned ldsw = (unsigned)wid * 1024u;
    const int aoff = lds_byte(wr * 64 + fr, fq * 8), boff = lds_byte(wc * 32 + fr, fq * 8);
#define PG8_SA(b, h) (((b) * 2 + (h)) * HTB)
#define PG8_SB(b, h) ((4 + (b) * 2 + (h)) * HTB)
#define PG8_STAGE(bufoff, gbase, voff) do { _Pragma("unroll") for (int _i = 0; _i < 2; ++_i) \
        __builtin_amdgcn_global_load_lds((const unsigned*)((const char*)(gbase) + (voff)[_i]), (PG8_LAS unsigned*)(lds + (bufoff) + ldsw + _i * 8192), 16, 0, 0); } while (0)
#define PG8_LDA(dst, b, h) do { _Pragma("unroll") for (int m = 0; m < 4; ++m) _Pragma("unroll") for (int k = 0; k < 2; ++k) dst[m][k] = *(const PG8_LAS bf16x8*)(lds + PG8_SA(b, h) + aoff + m * 2048 + k * 1024); } while (0)
#define PG8_LDB(dst, b, h) do { _Pragma("unroll") for (int n = 0; n < 2; ++n) _Pragma("unroll") for (int k = 0; k < 2; ++k) dst[n][k] = *(const PG8_LAS bf16x8*)(lds + PG8_SB(b, h) + boff + n * 2048 + k * 1024); } while (0)
#define PG8_MMA(ai, bj, At, Bt) do { __builtin_amdgcn_s_setprio(1); _Pragma("unroll") for (int m = 0; m < 4; ++m) _Pragma("unroll") for (int n = 0; n < 2; ++n) _Pragma("unroll") for (int k = 0; k < 2; ++k) \
        acc[ai][bj][m][n] = __builtin_amdgcn_mfma_f32_16x16x32_bf16(Bt[n][k], At[m][k], acc[ai][bj][m][n], 0, 0, 0); __builtin_amdgcn_s_setprio(0); } while (0)
#define PG8_WAIT_V(n) asm volatile("s_waitcnt vmcnt(" #n ")" ::: "memory")
#define PG8_WAIT_L(n) asm volatile("s_waitcnt lgkmcnt(" #n ")" ::: "memory")
#define PG8_BAR __builtin_amdgcn_s_barrier()
#define PG8_SCHED __builtin_amdgcn_sched_barrier(0)
    Unit cur, nxt; int ui = 0;
    if (!S.next(0, cur)) return;
    f32x4 acc[2][2][4][2];
#pragma unroll
    for (int a = 0; a < 2; ++a)
#pragma unroll
        for (int b = 0; b < 2; ++b)
#pragma unroll
            for (int m = 0; m < 4; ++m)
#pragma unroll
                for (int n = 0; n < 2; ++n) acc[a][b][m][n] = (f32x4){0.f, 0.f, 0.f, 0.f};
    bf16x8 At[4][2], B0[2][2], B1[2][2];
    const char* cA = (const char*)g.A + (size_t)cur.pm * tstepA + (size_t)cur.pn * g.a_pn_off * 2; const char* cB = (const char*)g.Bt + (size_t)cur.pn * tstepB;
    PG8_STAGE(PG8_SB(0, 0), cB, voffB); PG8_STAGE(PG8_SB(0, 1), cB + hstepB, voffB); PG8_STAGE(PG8_SA(0, 0), cA, voffA); PG8_STAGE(PG8_SA(0, 1), cA + hstepA, voffA);
    if (wr == 1) PG8_BAR;
    PG8_WAIT_V(2); PG8_BAR;
    PG8_STAGE(PG8_SB(1, 0), cB + kstep, voffB); PG8_STAGE(PG8_SA(1, 0), cA + kstep, voffA); PG8_STAGE(PG8_SB(1, 1), cB + hstepB + kstep, voffB);
    PG8_WAIT_V(6); PG8_BAR;
    for (;;) {
        const bool has_next = S.next(ui + 1, nxt);
        const char* nA = has_next ? (const char*)g.A + (size_t)nxt.pm * tstepA + (size_t)nxt.pn * g.a_pn_off * 2 : cA; const char* nB = has_next ? (const char*)g.Bt + (size_t)nxt.pn * tstepB : cB;
        for (int t = 0; t < nt; t += 2) {
            const bool last = (t == nt - 2);
            const char* a1 = cA + (size_t)(t + 1) * kstep;
            const char* a2 = last ? nA : cA + (size_t)(t + 2) * kstep; const char* b2 = last ? nB : cB + (size_t)(t + 2) * kstep;
            const char* a3 = a2 + kstep; const char* b3 = b2 + kstep;
            PG8_LDB(B0, 0, 0); PG8_LDB(B1, 0, 1); PG8_SCHED; PG8_LDA(At, 0, 0); PG8_STAGE(PG8_SA(1, 1), a1 + hstepA, voffA);
            PG8_WAIT_V(8); PG8_WAIT_L(0); PG8_BAR; PG8_MMA(0, 0, At, B0); PG8_MMA(0, 1, At, B1); PG8_BAR; PG8_SCHED;
            PG8_LDA(At, 0, 1); PG8_STAGE(PG8_SB(0, 0), b2, voffB); PG8_STAGE(PG8_SB(0, 1), b2 + hstepB, voffB); PG8_STAGE(PG8_SA(0, 0), a2, voffA);
            PG8_WAIT_V(8); PG8_WAIT_L(0); PG8_BAR; PG8_MMA(1, 0, At, B0); PG8_MMA(1, 1, At, B1); PG8_BAR; PG8_SCHED;
            PG8_LDB(B0, 1, 0); PG8_LDB(B1, 1, 1); PG8_SCHED; PG8_LDA(At, 1, 0); PG8_STAGE(PG8_SA(0, 1), a2 + hstepA, voffA);
            PG8_WAIT_V(8); PG8_WAIT_L(0); PG8_BAR; PG8_MMA(0, 0, At, B0); PG8_MMA(0, 1, At, B1); PG8_BAR; PG8_SCHED;
            PG8_LDA(At, 1, 1); PG8_STAGE(PG8_SB(1, 0), b3, voffB); PG8_STAGE(PG8_SB(1, 1), b3 + hstepB, voffB); PG8_STAGE(PG8_SA(1, 0), a3, voffA);
            PG8_WAIT_V(8); PG8_WAIT_L(0); PG8_BAR; PG8_MMA(1, 0, At, B0); PG8_MMA(1, 1, At, B1); PG8_BAR; PG8_SCHED;
        }
        if (wr == 0) PG8_BAR;
        E(acc, cur, wr, wc, fr, fq);
        if (!has_next) break;
#pragma unroll
        for (int a = 0; a < 2; ++a)
#pragma unroll
            for (int b = 0; b < 2; ++b)
#pragma unroll
                for (int m = 0; m < 4; ++m)
#pragma unroll
                    for (int n = 0; n < 2; ++n) acc[a][b][m][n] = (f32x4){0.f, 0.f, 0.f, 0.f};
        cur = nxt; cA = nA; cB = nB; ++ui;
        if (wr == 1) PG8_BAR;
    }
    PG8_WAIT_V(0);
    PG8_BAR;
#undef PG8_SA
#undef PG8_SB
#undef PG8_STAGE
#undef PG8_LDA
#undef PG8_LDB
#undef PG8_MMA
#undef PG8_WAIT_V
#undef PG8_WAIT_L
#undef PG8_BAR
#undef PG8_SCHED
}

__device__ __forceinline__ unsigned cvt_pk_bf16(float lo, float hi) { unsigned r; asm volatile("v_cvt_pk_bf16_f32 %0, %1, %2" : "=v"(r) : "v"(lo), "v"(hi)); return r; }
struct EpiF32 {
    static constexpr bool PERM = false;
    float* out; int ldc; int rows_valid; const float* bias_a; const float* bias_b; int bias_split;
    __device__ __forceinline__ void operator()(const f32x4 (&acc)[2][2][4][2], const Unit& u, int wr, int wc, int fr, int fq) const {
#pragma unroll
        for (int ai = 0; ai < 2; ++ai)
#pragma unroll
            for (int m = 0; m < 4; ++m) { const int row = u.pm * BM + ai * HALF + wr * 64 + m * 16 + fr;
                if (row < rows_valid) {
#pragma unroll
                    for (int bj = 0; bj < 2; ++bj)
#pragma unroll
                        for (int n = 0; n < 2; ++n) { const int col = u.pn * BM + bj * HALF + wc * 32 + n * 16 + 4 * fq; f32x4 v = acc[ai][bj][m][n];
                            if (bias_a) { const f32x4 b = (col < bias_split) ? *(const f32x4*)(bias_a + col) : *(const f32x4*)(bias_b + (col - bias_split)); v += b; }
                            *(f32x4*)(out + (size_t)row * ldc + col) = v; } } }
    }
};
struct EpiRes {
    static constexpr bool PERM = false;
    const float* in_lo; const float* in_hi; float* out; const float* mods; int gate_off; const float* cscale;
    __device__ __forceinline__ void operator()(const f32x4 (&acc)[2][2][4][2], const Unit& u, int wr, int wc, int fr, int fq) const {
#pragma unroll
        for (int ai = 0; ai < 2; ++ai)
#pragma unroll
            for (int m = 0; m < 4; ++m) { const int row = u.pm * BM + ai * HALF + wr * 64 + m * 16 + fr;
                if (row < MR) { const float* gp = mods + (size_t)bidx_of(row) * NADA + gate_off; const float* ip = row < MP ? in_lo + (size_t)row * D : in_hi + (size_t)(row - MP) * D; float* op = out + (size_t)row * D;
#pragma unroll
                    for (int bj = 0; bj < 2; ++bj)
#pragma unroll
                        for (int n = 0; n < 2; ++n) { const int col = u.pn * BM + bj * HALF + wc * 32 + n * 16 + 4 * fq; f32x4 gt = *(const f32x4*)(gp + col);
                            if (cscale) gt *= *(const f32x4*)(cscale + col);
                            const f32x4 x = *(const f32x4*)(ip + col); *(f32x4*)(op + col) = x + gt * acc[ai][bj][m][n]; } } }
    }
};
__device__ __forceinline__ float silu_f(float x) { return x * __builtin_amdgcn_rcpf(1.f + __builtin_amdgcn_exp2f(-1.4426950408889634f * x)); }
struct EpiSwiglu {
    static constexpr bool PERM = true;
    bf16_t* H; int ldh;
    __device__ __forceinline__ void operator()(const f32x4 (&acc)[2][2][4][2], const Unit& u, int wr, int wc, int fr, int fq) const {
        const int row0 = u.pm * BM + wr * 64 + fr, col0 = u.pn * HALF + wc * 32 + 8 * fq;
#pragma unroll
        for (int ai = 0; ai < 2; ++ai)
#pragma unroll
            for (int m = 0; m < 4; ++m) { bf16_t* rowp = H + (size_t)(row0 + ai * HALF + m * 16) * ldh + col0;
                const f32x4 g0 = acc[ai][0][m][0], g1 = acc[ai][0][m][1], u0 = acc[ai][1][m][0], u1 = acc[ai][1][m][1];
                u32x4 w; w.x = cvt_pk_bf16(silu_f(g0[0]) * u0[0], silu_f(g0[1]) * u0[1]); w.y = cvt_pk_bf16(silu_f(g0[2]) * u0[2], silu_f(g0[3]) * u0[3]);
                w.z = cvt_pk_bf16(silu_f(g1[0]) * u1[0], silu_f(g1[1]) * u1[1]); w.w = cvt_pk_bf16(silu_f(g1[2]) * u1[2], silu_f(g1[3]) * u1[3]);
                *(u32x4*)rowp = w; }
    }
};
}

#define XB_TMO      128
#define XB_XCNT(j)  (256  + 64 * (j))
#define XB_XSUB(j)  (1280 + 64 * (j))
#define XB_XGEN(j)  (2304 + 64 * (j))
#define XB_TOP      3328
#define XB_TOPGEN   3392
#define XCD_BAR_WORDS 3456
#define XB_SPIN_CAP (1u << 18)
__device__ __forceinline__ unsigned xb_ld(unsigned* p)              { return __hip_atomic_load(p, __ATOMIC_RELAXED, __HIP_MEMORY_SCOPE_AGENT); }
__device__ __forceinline__ unsigned xb_add(unsigned* p, unsigned v) { return __hip_atomic_fetch_add(p, v, __ATOMIC_RELAXED, __HIP_MEMORY_SCOPE_AGENT); }
__device__ __forceinline__ unsigned xb_xcc_id() { return (unsigned)__builtin_amdgcn_s_getreg((3 << 11) | 20) & 0xFu; }
#define XB_SPIN(cond, bar) do { unsigned _sp = 0; while (cond) { __builtin_amdgcn_s_sleep(1); \
    if ((++_sp & 255u) == 0u) { if (xb_ld(&(bar)[XB_TMO])) break; if (_sp > XB_SPIN_CAP) { atomicAdd(&(bar)[XB_TMO], 1u); break; } } } } while (0)
struct XcdBarrier { unsigned* bar; unsigned x; volatile LAS unsigned* st; };
__device__ __forceinline__ XcdBarrier xcd_barrier_post(unsigned* bar, volatile LAS unsigned* st) {
    XcdBarrier b; b.bar = bar; b.x = xb_xcc_id(); b.st = st;
    if (threadIdx.x == 0) (void)xb_add(&bar[XB_XCNT(b.x)], 1u);
    return b;
}
__device__ __forceinline__ void xcd_barrier_complete(unsigned* bar, unsigned x, unsigned& nloc, unsigned& nx) {
    const unsigned G = gridDim.x * gridDim.y * gridDim.z;
    unsigned sum, cnt, mine, sp = 0u;
    for (;;) {
        sum = 0u; cnt = 0u; mine = 0u;
#pragma unroll
        for (unsigned j = 0; j < 16; ++j) { const unsigned c = xb_ld(&bar[XB_XCNT(j)]); sum += c; cnt += (c > 0u) ? 1u : 0u; mine = (j == x) ? c : mine; }
        if (sum == G) break;
        __builtin_amdgcn_s_sleep(1);
        if ((++sp & 255u) == 0u) { if (xb_ld(&bar[XB_TMO])) break; if (sp > XB_SPIN_CAP) { atomicAdd(&bar[XB_TMO], 1u); break; } }
    }
    nloc = mine > 0u ? mine : 1u; nx = cnt > 0u ? cnt : 1u;
}
__device__ __forceinline__ void xcd_barrier(const XcdBarrier& b) {
    asm volatile("s_waitcnt vmcnt(0)" ::: "memory");
    __syncthreads();
    if (threadIdx.x == 0) {
        unsigned* bar = b.bar;
        __builtin_amdgcn_s_waitcnt(0);
        unsigned nloc = b.st[0], nx = b.st[1];
        if (nloc == 0u) { xcd_barrier_complete(bar, b.x, nloc, nx); b.st[0] = nloc; b.st[1] = nx; }
        const unsigned old = xb_add(&bar[XB_XSUB(b.x)], 1u);
        const unsigned gen = old / nloc;
        if (old + 1u == (gen + 1u) * nloc) {
            __builtin_amdgcn_fence(__ATOMIC_RELEASE, "agent");
            asm volatile("s_waitcnt vmcnt(0)" ::: "memory");
            const unsigned og = xb_add(&bar[XB_TOP], 1u);
            const unsigned tg = og / nx;
            if (og + 1u == (tg + 1u) * nx) xb_add(&bar[XB_TOPGEN], 1u);
            else XB_SPIN(xb_ld(&bar[XB_TOPGEN]) == tg, bar);
            __builtin_amdgcn_fence(__ATOMIC_ACQUIRE, "agent");
            xb_add(&bar[XB_XGEN(b.x)], 1u);
            asm volatile("s_waitcnt vmcnt(0)" ::: "memory");
        } else {
            XB_SPIN(xb_ld(&bar[XB_XGEN(b.x)]) == gen, bar);
            __builtin_amdgcn_fence(__ATOMIC_ACQUIRE, "agent");
            asm volatile("s_waitcnt vmcnt(0)" ::: "memory");
        }
    }
    __syncthreads();
}

constexpr int RING_BYTES = 131072, MISC_OFF = RING_BYTES + 320, LDS_BYTES = 147456;
struct Args { const void* in[27]; float* out; unsigned char* ws; int ph_lo, ph_hi; };
struct Ctx {
    LAS unsigned char* lds; int tid, lane, wave, vcu, G, gw, NGW;
    float* out; unsigned char* ws;
};

__device__ __forceinline__ Ctx fresh(const Ctx& F) { Ctx C = F; GAS float* go = (GAS float*)F.out; GAS unsigned char* gw_ = (GAS unsigned char*)F.ws;
    asm volatile("" : "+v"(C.tid), "+s"(C.wave), "+s"(C.vcu), "+s"(C.G), "+s"(go), "+s"(gw_)); C.lane = C.tid & 63; C.gw = C.vcu * 8 + C.wave; C.NGW = C.G * 8;
    C.out = (float*)go; C.ws = (unsigned char*)gw_;
    return C; }
__device__ __forceinline__ unsigned char* uni_ptr(const void* p) { const unsigned long long v = (unsigned long long)p; unsigned lo = __builtin_amdgcn_readfirstlane((unsigned)v), hi = __builtin_amdgcn_readfirstlane((unsigned)(v >> 32));
    asm volatile("" : "+s"(lo), "+s"(hi)); return (unsigned char*)(GAS unsigned char*)(((unsigned long long)hi << 32) | lo); }
__device__ __forceinline__ const void* kin(int i) { const char __attribute__((address_space(4)))* kp = (const char __attribute__((address_space(4)))*)__builtin_amdgcn_kernarg_segment_ptr(); asm volatile("" : "+s"(kp));
    const GAS void* p = *(const GAS void* const __attribute__((address_space(4)))*)(kp + 8 * i); return (const void*)p; }
__device__ __forceinline__ void tr_item(const float* W, int N, int K, bf16* WT, int kb, int n0, int drow0, LAS float* scr, int lane) {
    const int k0 = 64 * kb, nn = n0 + (lane & 31); const bool ok = nn < N;
#pragma unroll 8
    for (int i = 0; i < 32; ++i) { const int kk = 2 * i + (lane >> 5); scr[kk * 33 + (lane & 31)] = ok ? W[(size_t)(k0 + kk) * N + nn] : 0.f; }
    LDS_WAIT(); asm volatile("" ::: "memory");
    const int c = lane & 7;
#pragma unroll
    for (int j = 0; j < 4; ++j) { const int n = (lane >> 3) + 8 * j; const LAS float* s = scr + (8 * c) * 33 + n;
        v4u o; o.x = pk2(s[0 * 33], s[1 * 33]); o.y = pk2(s[2 * 33], s[3 * 33]); o.z = pk2(s[4 * 33], s[5 * 33]); o.w = pk2(s[6 * 33], s[7 * 33]);
        *(GAS v4u*)(WT + (size_t)(drow0 + n) * K + k0 + 8 * c) = o; }
    LDS_WAIT(); asm volatile("" ::: "memory");
}
__device__ __forceinline__ void tr_job(const float* W, int N, int K, bf16* WT, int it, int mode, LAS float* scr, int lane) {
    const int nblk = (N + 31) / 32, kb = it / nblk, n0 = 32 * (it % nblk);
    int drow0 = n0;
    if (mode == 1) drow0 = (n0 < DFF) ? 256 * (n0 / 128) + (n0 % 128) : 256 * ((n0 - DFF) / 128) + 128 + ((n0 - DFF) % 128);
    tr_item(W, N, K, WT, kb, n0, drow0, scr, lane);
}
__device__ __forceinline__ void p0_prologue(Ctx& F) {
    LAS float* scr = (LAS float*)(F.lds + F.wave * 16384);
    constexpr int I_ADA = 16 * 96, I_ADAKV = 16 * 64, I_GU = 16 * 176, I_DN = 44 * 32, I_KV = 16 * 48, I_QG = 16 * 34, I_WO = 16 * 32, I_PW = 4 * 8, I_W1 = 64 * 4;
    constexpr int NIT = 8 * I_ADA + I_ADAKV + 4 * I_GU + 4 * I_DN + I_KV + 2 * I_QG + 2 * I_WO + 8 * I_PW + 2 * I_W1;
    for (int it = F.gw; it < NIT; it += F.NGW) {
        int r = it;
        if (r < 8 * I_ADA) { const int s = r / I_ADA; tr_job(((const float*)kin(8)) + (size_t)s * 1024 * 3072, 3072, 1024, ((bf16*)(F.ws + WS_ADAT)) + (size_t)s * 3072 * 1024, r % I_ADA, 0, scr, F.lane); continue; } r -= 8 * I_ADA;
        if (r < I_ADAKV) { tr_job(((const float*)kin(14)), 2048, 1024, ((bf16*)(F.ws + WS_ADAT)) + (size_t)24576 * 1024, r, 0, scr, F.lane); continue; } r -= I_ADAKV;
        if (r < 4 * I_GU) { const int s = r / I_GU; tr_job(((const float*)kin(25)) + (size_t)s * 1024 * NGU, NGU, 1024, ((bf16*)(F.ws + WS_WGU)) + (size_t)s * NGU * 1024, r % I_GU, 1, scr, F.lane); continue; } r -= 4 * I_GU;
        if (r < 4 * I_DN) { const int s = r / I_DN; tr_job(((const float*)kin(26)) + (size_t)s * DFF * 1024, 1024, DFF, ((bf16*)(F.ws + WS_WDN)) + (size_t)s * 1024 * DFF, r % I_DN, 0, scr, F.lane); continue; } r -= 4 * I_DN;
        if (r < I_KV) { tr_job(((const float*)kin(17)), NKV, 1024, ((bf16*)(F.ws + WS_WKV)), r, 0, scr, F.lane); continue; } r -= I_KV;
        if (r < 2 * I_QG) { const int s = r / I_QG; tr_job(((const float*)kin(22)) + (size_t)s * 1024 * NQG, NQG, 1024, ((bf16*)(F.ws + WS_WQG)) + (size_t)s * NQGP * 1024, r % I_QG, 0, scr, F.lane); continue; } r -= 2 * I_QG;
        if (r < 2 * I_WO) { const int s = r / I_WO; tr_job(((const float*)kin(24)) + (size_t)s * 1024 * 1024, 1024, 1024, ((bf16*)(F.ws + WS_WO)) + (size_t)s * 1024 * 1024, r % I_WO, 0, scr, F.lane); continue; } r -= 2 * I_WO;
        if (r < 8 * I_PW) { const int s = r / I_PW; tr_job(((const float*)kin(12)) + (size_t)s * 256 * 256, 256, 256, ((bf16*)(F.ws + WS_POOLW)) + (size_t)s * 256 * 256, r % I_PW, 0, scr, F.lane); continue; } r -= 8 * I_PW;
        { const int s = r / I_W1; tr_job(((const float*)kin(20)) + (size_t)s * 4096 * 128, 128, 4096, ((bf16*)(F.ws + WS_W1T)) + (size_t)s * 128 * 4096, r % I_W1, 0, scr, F.lane); }
    }
    for (int r = F.gw; r < 256; r += F.NGW) {
        const float* src = r < 2 ? ((const float*)kin(6)) + (size_t)r * D : (r < NBATCH ? ((const float*)kin(7)) + (size_t)(r - 2) * D : nullptr);
        unsigned long long* o8 = (unsigned long long*)(((bf16*)(F.ws + WS_CB)) + (size_t)r * D) + F.lane;
#pragma unroll
        for (int j = 0; j < 4; ++j) { f32x4 v = src ? ((const f32x4*)src)[F.lane + 64 * j] : (f32x4){0.f, 0.f, 0.f, 0.f}; o8[64 * j] = (unsigned long long)pk2(v.x, v.y) | ((unsigned long long)pk2(v.z, v.w) << 32); }
    }
    for (int r = F.gw; r < 2 * (NQGP - 1088); r += F.NGW) { const int s = r / (NQGP - 1088), rr = 1088 + r % (NQGP - 1088);
        unsigned long long* o8 = (unsigned long long*)(((bf16*)(F.ws + WS_WQG)) + ((size_t)s * NQGP + rr) * D) + F.lane;
#pragma unroll
        for (int j = 0; j < 4; ++j) o8[64 * j] = 0ull; }
    const int gt = F.gw * 64 + F.lane, NGT = F.NGW * 64;
    for (int e = gt; e < 8193 * 8; e += NGT) { const int pos = e >> 3, i = e & 7;
        const float invs[8] = {1.0f, 0.1939227432012558f, 0.03760603070259094f, 0.007292664609849453f, 0.0014142135623842478f, 0.00027424818836152554f, 5.318296098266728e-05f, 1.0313386155758053e-05f};
        float inv = invs[0];
#pragma unroll
        for (int q = 1; q < 8; ++q) inv = (i == q) ? invs[q] : inv;
        const float ang = (float)pos * inv; const double rev = (double)ang * 0.15915494309189535; const float fr = (float)(rev - floor(rev));
        ((f32x2*)((float*)(F.ws + WS_ROPE)))[e] = (f32x2){__builtin_amdgcn_cosf(fr), __builtin_amdgcn_sinf(fr)}; }
    for (int o = F.gw; o < 256; o += F.NGW) { const int slot = o >> 7, hid = o & 127; float s = 0.f;
        for (int k = F.lane; k < 4096; k += 64) s += ((const float*)kin(19))[slot * 4096 + k] * ((const float*)kin(20))[((size_t)slot * 4096 + k) * 128 + hid];
        s = wave_sum(s); if (F.lane == 0) ((float*)(F.ws + WS_BIASPE))[o] = s; }
    for (int e = gt; e < 32 * 511 * 128; e += NGT) { const int s = e / (511 * 128), r = e % (511 * 128), i = r >> 7, c = r & 127;
        ((f32x4*)(F.out + O_WINS))[((size_t)s * 512 + i) * 128 + c] = ((const f32x4*)((const float*)kin(3)))[((size_t)s * 512 + i + 1) * 128 + c]; }
}

__device__ __forceinline__ const float* xrow(const float* lo, const float* hi, int row) { return row < MP ? lo + (size_t)row * D : hi + (size_t)(row - MP) * D; }
__device__ __forceinline__ void load_row(const float* p, int lane, f32x4 (&v)[4]) {
#pragma unroll
    for (int j = 0; j < 4; ++j) v[j] = ((const f32x4*)p)[lane + 64 * j];
}
__device__ __forceinline__ float row_rstd(const f32x4 (&v)[4]) { float s = 0.f;
#pragma unroll
    for (int j = 0; j < 4; ++j) s += (v[j].x * v[j].x + v[j].y * v[j].y) + (v[j].z * v[j].z + v[j].w * v[j].w);
    return rsqrtf(wave_sum(s) * (1.f / D) + EPS); }
__device__ __forceinline__ void load_mod(const float* mods, int bi, int off, const float* gain, int lane, f32x4 (&A)[4], f32x4 (&S)[4]) {
    const float* mp = mods + (size_t)bi * NADA + off;
#pragma unroll
    for (int j = 0; j < 4; ++j) { const f32x4 g = ((const f32x4*)gain)[lane + 64 * j], sc = ((const f32x4*)(mp + 1024))[lane + 64 * j]; A[j] = g * (sc + 1.f); S[j] = ((const f32x4*)mp)[lane + 64 * j]; }
}
__device__ __forceinline__ void store_row_bf16(bf16* p, int lane, const f32x4 (&v)[4]) {
    unsigned long long* o8 = (unsigned long long*)p + lane;
#pragma unroll
    for (int j = 0; j < 4; ++j) o8[64 * j] = (unsigned long long)pk2(v[j].x, v[j].y) | ((unsigned long long)pk2(v[j].z, v[j].w) << 32);
}
__device__ __forceinline__ void pass_h(Ctx& F, int l, const float* xlo, const float* xhi) {
    const int off = (l * 2 + 0) * 3072; const float* gain = ((const float*)kin(10)) + l * D;
    for (int ch = F.gw; ch < MP / 8; ch += F.NGW) {
        const int b = ch >> 10; f32x4 A[4], S[4]; load_mod(((float*)(F.ws + WS_MODS)), b, off, gain, F.lane, A, S);
        for (int r = 0; r < 8; ++r) { const int row = ch * 8 + r, t = row & (SEQ - 1); f32x4 v[4]; load_row(xrow(xlo, xhi, row), F.lane, v); const float rs = row_rstd(v);
#pragma unroll
            for (int j = 0; j < 4; ++j) { v[j] = v[j] * rs * A[j] + S[j]; ((f32x4*)(((float*)(F.ws + WS_H0)) + (size_t)row * D))[F.lane + 64 * j] = v[j]; }
            if (t >= SEQ - 15) { float* po = F.out + O_POOLP + ((size_t)(l * 2 + b) * 15 + (t - (SEQ - 15))) * D;
#pragma unroll
                for (int j = 0; j < 4; ++j) ((f32x4*)po)[F.lane + 64 * j] = v[j]; } }
    }
    for (int s = F.gw; s < NBS; s += F.NGW) {
        const int row = MP + s; f32x4 A[4], S[4], v[4]; load_mod(((float*)(F.ws + WS_MODS)), 2 + s, off, gain, F.lane, A, S); load_row(xrow(xlo, xhi, row), F.lane, v); const float rs = row_rstd(v);
        const float* sp = ((const float*)kin(4)) + ((size_t)(l * 32 + s) * 15) * D; float* po = F.out + O_POOLS + ((size_t)(l * 32 + s) * 15) * D; f32x4 pl[4];
#pragma unroll
        for (int j = 0; j < 4; ++j) { v[j] = v[j] * rs * A[j] + S[j]; const int w = 2 << j; f32x4 sum = v[j];
            for (int k = 1; k < w; ++k) sum += ((const f32x4*)(sp + (size_t)(15 - k) * D))[F.lane + 64 * j];
            pl[j] = sum * (1.f / (float)w) - v[j]; ((f32x4*)(po + (size_t)14 * D))[F.lane + 64 * j] = v[j]; }
        store_row_bf16(((bf16*)(F.ws + WS_XN2)) + (size_t)row * D, F.lane, pl);
        for (int i = 0; i < 14; ++i)
#pragma unroll
            for (int j = 0; j < 4; ++j) ((f32x4*)(po + (size_t)i * D))[F.lane + 64 * j] = ((const f32x4*)(sp + (size_t)(i + 1) * D))[F.lane + 64 * j];
    }
}
__device__ __forceinline__ void pass_pool(Ctx& F) {
    for (int ch = F.gw; ch < MP / 8; ch += F.NGW) {
        const int row0 = ch * 8, t0 = row0 & (SEQ - 1); f32x4 Sw[4];
#pragma unroll
        for (int j = 0; j < 4; ++j) { const int w = 2 << j; Sw[j] = (f32x4){0.f, 0.f, 0.f, 0.f};
            for (int k = 1; k < w; ++k) if (t0 - k >= 0) Sw[j] += ((const f32x4*)(((float*)(F.ws + WS_H0)) + (size_t)(row0 - k) * D))[F.lane + 64 * j]; }
        for (int r = 0; r < 8; ++r) { const int row = row0 + r, t = t0 + r; f32x4 h[4], pl[4]; load_row(((float*)(F.ws + WS_H0)) + (size_t)row * D, F.lane, h);
#pragma unroll
            for (int j = 0; j < 4; ++j) { const int w = 2 << j; Sw[j] += h[j]; const int cnt = (t + 1) < w ? (t + 1) : w; pl[j] = Sw[j] * (1.f / (float)cnt) - h[j];
                if (t - w + 1 >= 0) Sw[j] -= ((const f32x4*)(((float*)(F.ws + WS_H0)) + (size_t)(row - w + 1) * D))[F.lane + 64 * j]; }
            store_row_bf16(((bf16*)(F.ws + WS_XN2)) + (size_t)row * D, F.lane, pl); }
    }
}
__device__ __forceinline__ void pass_norm(Ctx& F, const float* xlo, const float* xhi, const float* gain1, int off1, bf16* out1, const float* gain2, int off2, bf16* out2) {
    for (int ch = F.gw; ch < (MR + 7) / 8; ch += F.NGW) {
        const int row0 = ch * 8; const bool uni = row0 < MP; f32x4 A1[4], S1[4], A2[4], S2[4];
        if (uni) { load_mod(((float*)(F.ws + WS_MODS)), row0 >> 13, off1, gain1, F.lane, A1, S1); if (out2) load_mod(((float*)(F.ws + WS_MODS)), row0 >> 13, off2, gain2, F.lane, A2, S2); }
        for (int r = 0; r < 8; ++r) { const int row = row0 + r; if (row >= MR) break;
            if (!uni) { load_mod(((float*)(F.ws + WS_MODS)), bidx_of(row), off1, gain1, F.lane, A1, S1); if (out2) load_mod(((float*)(F.ws + WS_MODS)), bidx_of(row), off2, gain2, F.lane, A2, S2); }
            f32x4 v[4], o[4]; load_row(xrow(xlo, xhi, row), F.lane, v); const float rs = row_rstd(v);
#pragma unroll
            for (int j = 0; j < 4; ++j) o[j] = v[j] * rs * A1[j] + S1[j];
            store_row_bf16(out1 + (size_t)row * D, F.lane, o);
            if (out2) {
#pragma unroll
                for (int j = 0; j < 4; ++j) o[j] = v[j] * rs * A2[j] + S2[j];
                store_row_bf16(out2 + (size_t)row * D, F.lane, o); } }
    }
}
__device__ __forceinline__ float rope_lane(float v, int lane, const float* ropep  ) {
    const float other = __shfl_xor(v, 8);
    if (lane < 16) { const f32x2 cs = ((const f32x2*)ropep)[lane & 7]; v = (lane < 8) ? v * cs.x - other * cs.y : v * cs.x + other * cs.y; }
    return v;
}
__device__ __forceinline__ void pass_kvpost(Ctx& F) {
    const int lane = F.lane; const float kn1 = ((const float*)kin(18))[64 + lane], kn2 = ((const float*)kin(18))[128 + lane];
    for (int row = F.gw; row < MR; row += F.NGW) {
        const int pos = row < MP ? (row & (SEQ - 1)) : SEQ; const float* rp = ((float*)(F.ws + WS_ROPE)) + (size_t)pos * 16; const float* raw = ((float*)(F.ws + WS_RAWKV)) + (size_t)row * NKV;
        float* kvo = F.out + O_KV + (size_t)row * 1024; bf16* kvb = ((bf16*)(F.ws + WS_KVB)) + (size_t)row * 1024; bf16* wb = ((bf16*)(F.ws + WS_WINB)) + (size_t)row * 512;
        float* wo = nullptr;
        if (row < MP) { if (pos >= SEQ - 512) wo = F.out + O_WINP + ((size_t)(row >> 13) * 512 + (pos - (SEQ - 512))) * 512; } else wo = F.out + O_WINS + ((size_t)(row - MP) * 512 + 511) * 512;
#pragma unroll 4
        for (int hh = 0; hh < 24; ++hh) { const int slot = hh >> 2, kvh = hh & 3; float v = raw[hh * 64 + lane];
            if (slot == 2 || slot == 4) { const float ss = wave_sum(v * v); v = v * rsqrtf(ss * (1.f / 64.f) + EPS) * (slot == 2 ? kn1 : kn2); v = rope_lane(v, lane, rp); }
            if (slot < 4) { kvo[slot * 256 + kvh * 64 + lane] = v; kvb[slot * 256 + kvh * 64 + lane] = (bf16)f2bf(v); }
            else { wb[(slot - 4) * 256 + kvh * 64 + lane] = (bf16)f2bf(v); if (wo) wo[(slot - 4) * 256 + kvh * 64 + lane] = v; } }
    }
}
__device__ __forceinline__ void pass_qpost(Ctx& F, int j) {
    const int lane = F.lane; const float qn = ((const float*)kin(23))[j * 64 + lane];
    for (int row = F.gw; row < MR; row += F.NGW) {
        const int pos = row < MP ? (row & (SEQ - 1)) : SEQ; const float* rp = ((float*)(F.ws + WS_ROPE)) + (size_t)pos * 16; const float* raw = ((float*)(F.ws + WS_RAWQ)) + (size_t)row * NQGP; bf16* qb = ((bf16*)(F.ws + WS_QB)) + (size_t)row * D;
#pragma unroll 4
        for (int h = 0; h < 16; ++h) { float v = raw[h * 64 + lane]; const float ss = wave_sum(v * v); v = v * rsqrtf(ss * (1.f / 64.f) + EPS) * qn; v = rope_lane(v, lane, rp); qb[h * 64 + lane] = (bf16)f2bf(v * C2); }
        if (lane < 48) { const float g = raw[1024 + lane]; ((float*)(F.ws + WS_GATES))[(size_t)row * 48 + lane] = __builtin_amdgcn_rcpf(1.f + __builtin_amdgcn_exp2f(-1.4426950408889634f * g)); }
    }
}


__device__ __forceinline__ void skinny_res(Ctx& F, const bf16* As, int lda, int a_grp_off, const bf16* Bt, int ldb, int K, const float* in_hi, float* out_hi, const float* mods, int gate_off, const float* cscale) {
    if (F.vcu >= 64) return;
    const int lane = F.lane, w = F.wave, n = lane & 15, kq = lane >> 4, c0 = 16 * F.vcu;
    const bf16* ap = As + (size_t)n * lda + (c0 >> 8) * a_grp_off + 8 * kq; const bf16* bp = Bt + (size_t)(c0 + n) * ldb + 8 * kq;
    const int kper = K >> 3; f32x4 acc0 = {0.f, 0.f, 0.f, 0.f}, acc1 = {0.f, 0.f, 0.f, 0.f};
    for (int k = w * kper; k < (w + 1) * kper; k += 32) {
        const bf16x8 a0 = *(const bf16x8*)(ap + k), a1 = *(const bf16x8*)(ap + (size_t)16 * lda + k), bb = *(const bf16x8*)(bp + k);
        acc0 = __builtin_amdgcn_mfma_f32_16x16x32_bf16(a0, bb, acc0, 0, 0, 0); acc1 = __builtin_amdgcn_mfma_f32_16x16x32_bf16(a1, bb, acc1, 0, 0, 0); }
    LAS f32x4* red = (LAS f32x4*)F.lds;
    red[(w * 2 + 0) * 64 + lane] = acc0; red[(w * 2 + 1) * 64 + lane] = acc1;
    __syncthreads();
    if (w < 2) { f32x4 a = red[w * 64 + lane];
#pragma unroll
        for (int ww = 1; ww < 8; ++ww) a += red[(ww * 2 + w) * 64 + lane];
        const int col = c0 + n; const float cs = cscale ? cscale[col] : 1.f;
#pragma unroll
        for (int i = 0; i < 4; ++i) { const int srow = 16 * w + 4 * kq + i; const float gt = mods[(size_t)(2 + srow) * NADA + gate_off + col] * cs;
            out_hi[(size_t)srow * D + col] = in_hi[(size_t)srow * D + col] + gt * a[i]; } }
    __syncthreads();
}

__device__ __forceinline__ float gelu_tanh(float x) { const float u = 0.7978845608028654f * (x + 0.044715f * x * x * x); return x * __builtin_amdgcn_rcpf(1.f + __builtin_amdgcn_exp2f(-2.f * 1.4426950408889634f * u)); }
__device__ __forceinline__ bf16x8 pack8(const f32x4 a, const f32x4 b) { v4u w; w.x = pk2(a.x, a.y); w.y = pk2(a.z, a.w); w.z = pk2(b.x, b.y); w.w = pk2(b.z, b.w); return __builtin_bit_cast(bf16x8, w); }
__device__ __forceinline__ void compress_phase(Ctx& F) {
    const int lane = F.lane, wid = F.wave, tid = F.tid, n = lane & 15, kq = lane >> 4;
    const int nper = (NBLKT + F.G - 1) / F.G, c0 = F.vcu * nper; int n_cu = NBLKT - c0; n_cu = n_cu < 0 ? 0 : (n_cu > nper ? nper : n_cu);
    if (nper > 32) return;
    const int nbw = (nper + 7) / 8, bw0 = wid * nbw; int nb_w = n_cu - bw0; nb_w = nb_w < 0 ? 0 : (nb_w > nbw ? nbw : nb_w);
    const int bl = n >> 2, kvh = n & 3; const bool vcol = bl < nb_w;
    int gblk = c0 + bw0 + (vcol ? bl : 0); gblk = gblk < NBLKT ? gblk : NBLKT - 1;
    const int bb = gblk >> 7, blk = gblk & 127;
    const float* base = bb < 2 ? F.out + O_KV + ((size_t)(bb * SEQ + blk * 64)) * 1024 : ((const float*)kin(2)) + ((size_t)((const int*)kin(5))[(bb - 2) * 64 + (blk >> 1)] * 128 + (blk & 1) * 64) * 1024;
    const float* lp = base + kvh * 64 + 8 * kq;
    unsigned soff[2];
#pragma unroll
    for (int i = 0; i < 2; ++i) { int R, C; pg8::stage_rc(tid * 16 + i * 8192, R, C); soff[i] = (unsigned)(R * 4096 + C) * 2u; }
    const int foff = pg8::lds_byte(n, kq * 8);
    LAS unsigned char* lds = F.lds;
#define CSTAGE(buf, s) do { _Pragma("unroll") for (int sl = 0; sl < 2; ++sl) _Pragma("unroll") for (int _i = 0; _i < 2; ++_i) \
        __builtin_amdgcn_global_load_lds((const unsigned*)((const char*)(((bf16*)(F.ws + WS_W1T)) + (size_t)sl * 128 * 4096 + (size_t)(s) * 64) + soff[_i]), (LAS unsigned*)(lds + ((buf) * 2 + sl) * 16384 + wid * 1024 + _i * 8192), 16, 0, 0); } while (0)
    f32x4 acc[2][8];
#pragma unroll
    for (int sl = 0; sl < 2; ++sl)
#pragma unroll
        for (int mt = 0; mt < 8; ++mt) acc[sl][mt] = (f32x4){0.f, 0.f, 0.f, 0.f};
    f32x4 raw[2][2][2];
#define CLOAD(s) do { _Pragma("unroll") for (int sl = 0; sl < 2; ++sl) _Pragma("unroll") for (int e = 0; e < 2; ++e) { const float* p_ = lp + (size_t)(s) * 1024 + sl * 256 + 32 * e; raw[sl][e][0] = *(const f32x4*)p_; raw[sl][e][1] = *(const f32x4*)(p_ + 4); } } while (0)
    __syncthreads();
    CSTAGE(0, 0); CLOAD(0);
    VM_WAIT(); __syncthreads();
    for (int s = 0; s < 64; ++s) {
        const int buf = s & 1; bf16x8 bfr[2][2];
#pragma unroll
        for (int sl = 0; sl < 2; ++sl)
#pragma unroll
            for (int e = 0; e < 2; ++e) bfr[sl][e] = pack8(raw[sl][e][0], raw[sl][e][1]);
        if (s + 1 < 64) { CSTAGE(buf ^ 1, s + 1); CLOAD(s + 1); }
#pragma unroll
        for (int sl = 0; sl < 2; ++sl)
#pragma unroll
            for (int e = 0; e < 2; ++e) { bf16x8 af[8];
#pragma unroll
                for (int mt = 0; mt < 8; ++mt) af[mt] = *(const LAS bf16x8*)(lds + (buf * 2 + sl) * 16384 + foff + mt * 2048 + e * 1024);
#pragma unroll
                for (int mt = 0; mt < 8; ++mt) acc[sl][mt] = __builtin_amdgcn_mfma_f32_16x16x32_bf16(af[mt], bfr[sl][e], acc[sl][mt], 0, 0, 0);
                __builtin_amdgcn_sched_barrier(0); }
        VM_WAIT(); __syncthreads();
    }
#undef CSTAGE
#undef CLOAD
#pragma unroll
    for (int sl = 0; sl < 2; ++sl) {
        bf16x8 hb[4];
#pragma unroll
        for (int e2 = 0; e2 < 4; ++e2) { f32x4 a = acc[sl][2 * e2] + *(const f32x4*)(((float*)(F.ws + WS_BIASPE)) + sl * 128 + 32 * e2 + 4 * kq), b = acc[sl][2 * e2 + 1] + *(const f32x4*)(((float*)(F.ws + WS_BIASPE)) + sl * 128 + 32 * e2 + 16 + 4 * kq);
            a = (f32x4){gelu_tanh(a.x), gelu_tanh(a.y), gelu_tanh(a.z), gelu_tanh(a.w)}; b = (f32x4){gelu_tanh(b.x), gelu_tanh(b.y), gelu_tanh(b.z), gelu_tanh(b.w)}; hb[e2] = pack8(a, b); }
        f32x4 o[4];
        const float* w2b = ((const float*)kin(21)) + (size_t)sl * 128 * 64 + n;
#pragma unroll
        for (int mt2 = 0; mt2 < 4; ++mt2) { o[mt2] = (f32x4){0.f, 0.f, 0.f, 0.f};
#pragma unroll
            for (int e2 = 0; e2 < 4; ++e2) { const float* w2 = w2b + 16 * mt2; float wv[8];
#pragma unroll
                for (int jj = 0; jj < 8; ++jj) wv[jj] = w2[(size_t)(32 * e2 + 16 * (jj >> 2) + 4 * kq + (jj & 3)) * 64];
                const bf16x8 a = pack8((f32x4){wv[0], wv[1], wv[2], wv[3]}, (f32x4){wv[4], wv[5], wv[6], wv[7]});
                o[mt2] = __builtin_amdgcn_mfma_f32_16x16x32_bf16(a, hb[e2], o[mt2], 0, 0, 0); __builtin_amdgcn_sched_barrier(0); } }
        if (sl == 0) {
            float ss = 0.f;
#pragma unroll
            for (int mt2 = 0; mt2 < 4; ++mt2) ss += (o[mt2].x * o[mt2].x + o[mt2].y * o[mt2].y) + (o[mt2].z * o[mt2].z + o[mt2].w * o[mt2].w);
            ss += __shfl_xor(ss, 16); ss += __shfl_xor(ss, 32);
            const float rs = rsqrtf(ss * (1.f / 64.f) + EPS);
#pragma unroll
            for (int mt2 = 0; mt2 < 4; ++mt2) o[mt2] = o[mt2] * rs * *(const f32x4*)(((const float*)kin(18)) + 16 * mt2 + 4 * kq);
            const int pos = (blk + 1) * 64 - 1; const float* rp = ((float*)(F.ws + WS_ROPE)) + (size_t)pos * 16 + (4 * (kq & 1)) * 2;
            f32x4 other; other.x = __shfl_xor(o[0].x, 32); other.y = __shfl_xor(o[0].y, 32); other.z = __shfl_xor(o[0].z, 32); other.w = __shfl_xor(o[0].w, 32);
            const f32x4 cs0 = *(const f32x4*)rp, cs1 = *(const f32x4*)(rp + 4); const f32x4 cv = {cs0.x, cs0.z, cs1.x, cs1.z}, sv = {cs0.y, cs0.w, cs1.y, cs1.w};
            o[0] = (kq < 2) ? o[0] * cv - other * sv : o[0] * cv + other * sv;
        }
        if (vcol) { float* dst = (sl == 0 ? ((float*)(F.ws + WS_KC)) : ((float*)(F.ws + WS_VC))) + ((size_t)(bb * NBLK + blk) * 4 + kvh) * 64 + 4 * kq;
#pragma unroll
            for (int mt2 = 0; mt2 < 4; ++mt2) *(f32x4*)(dst + 16 * mt2) = o[mt2]; }
    }
    __syncthreads();
}

struct Soft { float m[4], l[4], o[4]; };
__device__ __forceinline__ void soft_init(Soft& s) {
#pragma unroll
    for (int g = 0; g < 4; ++g) { s.m[g] = -1e30f; s.l[g] = 0.f; s.o[g] = 0.f; } }
template <class KF, class VF>
__device__ __forceinline__ void attn_block64(LAS float* qs, LAS float* ps, bool valid, KF kf, VF vf, Soft& st, float (&sc)[4], int lane) {
#pragma unroll
    for (int g = 0; g < 4; ++g) sc[g] = 0.f;
#pragma unroll
    for (int d8 = 0; d8 < 8; ++d8) { float kv[8]; kf(d8, kv);
#pragma unroll
        for (int g = 0; g < 4; ++g) { const f32x4 q0 = *(const LAS f32x4*)(qs + g * 64 + d8 * 8), q1 = *(const LAS f32x4*)(qs + g * 64 + d8 * 8 + 4);
            sc[g] += (q0.x * kv[0] + q0.y * kv[1]) + (q0.z * kv[2] + q0.w * kv[3]) + (q1.x * kv[4] + q1.y * kv[5]) + (q1.z * kv[6] + q1.w * kv[7]); } }
    f32x4 pv;
#pragma unroll
    for (int g = 0; g < 4; ++g) { const float sg = valid ? sc[g] : -1e30f; const float mn = fmaxf(st.m[g], wave_max(sg));
        const float p = valid ? __builtin_amdgcn_exp2f(sg - mn) : 0.f; const float corr = __builtin_amdgcn_exp2f(st.m[g] - mn);
        st.l[g] = st.l[g] * corr + wave_sum(p); st.o[g] *= corr; st.m[g] = mn; pv[g] = p; }
    *(LAS f32x4*)(ps + lane * 4) = pv;
    LDS_WAIT(); asm volatile("" ::: "memory");
#pragma unroll 16
    for (int key = 0; key < 64; ++key) { const f32x4 pp = *(const LAS f32x4*)(ps + key * 4); const float v = vf(key);
        st.o[0] += pp.x * v; st.o[1] += pp.y * v; st.o[2] += pp.z * v; st.o[3] += pp.w * v; }
    LDS_WAIT(); asm volatile("" ::: "memory");
}
__device__ __forceinline__ void ld8_bf16(const bf16* p, float (&kv)[8]) { const v4u w = *(const v4u*)p;
    kv[0] = __builtin_bit_cast(float, w.x << 16); kv[1] = __builtin_bit_cast(float, w.x & 0xffff0000u); kv[2] = __builtin_bit_cast(float, w.y << 16); kv[3] = __builtin_bit_cast(float, w.y & 0xffff0000u);
    kv[4] = __builtin_bit_cast(float, w.z << 16); kv[5] = __builtin_bit_cast(float, w.z & 0xffff0000u); kv[6] = __builtin_bit_cast(float, w.w << 16); kv[7] = __builtin_bit_cast(float, w.w & 0xffff0000u); }
__device__ __forceinline__ void ld8_f32(const float* p, float (&kv)[8]) { const f32x4 a = *(const f32x4*)p, b = *(const f32x4*)(p + 4); kv[0] = a.x; kv[1] = a.y; kv[2] = a.z; kv[3] = a.w; kv[4] = b.x; kv[5] = b.y; kv[6] = b.z; kv[7] = b.w; }

__device__ __forceinline__ void cmp_and_select(Ctx& F, LAS float* qs, LAS float* ps, int bb, int kvh, int t, float (&oc)[4], unsigned long long& msk0, unsigned long long& msk1) {
    const int lane = F.lane, cur = t >> 6; Soft st; soft_init(st); float sc0[4], sc1[4];
    const float* kcb = ((float*)(F.ws + WS_KC)) + ((size_t)bb * NBLK * 4 + kvh) * 64; const float* vcb = ((float*)(F.ws + WS_VC)) + ((size_t)bb * NBLK * 4 + kvh) * 64;
    const bool v0 = (lane + 1) * 64 - 1 <= t, v1 = (lane + 65) * 64 - 1 <= t;
    attn_block64(qs, ps, v0, [&](int d8, float (&kv)[8]) { ld8_f32(kcb + (size_t)lane * 256 + d8 * 8, kv); }, [&](int key) { return vcb[(size_t)key * 256 + lane]; }, st, sc0, lane);
    attn_block64(qs, ps, v1, [&](int d8, float (&kv)[8]) { ld8_f32(kcb + (size_t)(64 + lane) * 256 + d8 * 8, kv); }, [&](int key) { return vcb[(size_t)(64 + key) * 256 + lane]; }, st, sc1, lane);
    float imp0 = 0.f, imp1 = 0.f;
#pragma unroll
    for (int g = 0; g < 4; ++g) { const float il = st.l[g] > 0.f ? 1.f / st.l[g] : 0.f; oc[g] = st.o[g] * il;
        imp0 += v0 ? __builtin_amdgcn_exp2f(sc0[g] - st.m[g]) * il : 0.f; imp1 += v1 ? __builtin_amdgcn_exp2f(sc1[g] - st.m[g]) * il : 0.f; }
    bool s0, s1;
    if (cur <= 15) { s0 = lane <= cur; s1 = false; }
    else {
        const int b0 = lane, b1 = lane + 64; const bool c0 = b0 >= 1 && b0 <= cur - 2, c1 = b1 >= 1 && b1 <= cur - 2;
        const float x0 = c0 ? imp0 : -1.f, x1 = c1 ? imp1 : -1.f; int r0 = 0, r1 = 0;
        for (int k = 0; k < 64; ++k) { const float y0 = __shfl(x0, k), y1 = __shfl(x1, k);
            r0 += (y0 > x0 || (y0 == x0 && k < b0)) ? 1 : 0; r0 += (y1 > x0 || (y1 == x0 && (k + 64) < b0)) ? 1 : 0;
            r1 += (y0 > x1 || (y0 == x1 && k < b1)) ? 1 : 0; r1 += (y1 > x1 || (y1 == x1 && (k + 64) < b1)) ? 1 : 0; }
        s0 = (b0 == 0) || (b0 == cur) || (b0 == cur - 1) || (c0 && r0 < 13); s1 = (b1 == cur) || (b1 == cur - 1) || (c1 && r1 < 13);
    }
    msk0 = __ballot(s0); msk1 = __ballot(s1);
}
__device__ __forceinline__ void attn_sample_wg(Ctx& F) {
    const int lane = F.lane, w = F.wave;
    LAS float* qs = (LAS float*)F.lds;
    LAS float* ps = (LAS float*)(F.lds + 1024 + w * 1024);
    LAS unsigned* msk = (LAS unsigned*)(F.lds + 16384);
    LAS float* ocs = (LAS float*)(F.lds + 16384 + 64);
    LAS float* part = (LAS float*)(F.lds + 20480);
    const float* cache = (const float*)kin(2); const int* ptab = (const int*)kin(5);
    for (int task = F.vcu; task < NBS * 4; task += F.G) {
        const int s = task >> 2, kvh = task & 3, row = MP + s, t = SEQ;
        if (w == 0) {
#pragma unroll
            for (int g = 0; g < 4; ++g) qs[g * 64 + lane] = bf2f(((const bf16*)(F.ws + WS_QB))[(size_t)row * D + (kvh * 4 + g) * 64 + lane]);
        }
        __syncthreads();
        if (w == 0) { float oc[4]; unsigned long long m0, m1; cmp_and_select(F, qs, ps, 2 + s, kvh, t, oc, m0, m1);
#pragma unroll
            for (int g = 0; g < 4; ++g) ocs[g * 64 + lane] = oc[g];
            if (lane == 0) { msk[0] = (unsigned)m0; msk[1] = (unsigned)(m0 >> 32); msk[2] = (unsigned)m1; msk[3] = (unsigned)(m1 >> 32); } }
        __syncthreads();
        Soft ss, sw; soft_init(ss); soft_init(sw); float scd[4];
        { int cnt = 0;
            for (int wd = 0; wd < 4; ++wd) { unsigned mm = (unsigned)__builtin_amdgcn_readfirstlane((int)msk[wd]);
                while (mm) { const int j = __builtin_ctz(mm) + 32 * wd; mm &= mm - 1; const bool mine = (cnt & 7) == w; ++cnt; if (!mine) continue;
                    const float* pg = cache + ((size_t)ptab[s * 64 + (j >> 1)] * 128 + (j & 1) * 64) * 1024;
                    const float* kb = pg + (size_t)lane * 1024 + 512 + kvh * 64; const float* vb = pg + 768 + kvh * 64 + lane;
                    attn_block64(qs, ps, true, [&](int d8, float (&kv)[8]) { ld8_f32(kb + d8 * 8, kv); }, [&](int key) { return vb[(size_t)key * 1024]; }, ss, scd, lane); } }
            if ((cnt & 7) == w) { const float* nr = F.out + O_KV + (size_t)row * 1024;
                attn_block64(qs, ps, lane == 0, [&](int d8, float (&kv)[8]) { ld8_f32(nr + 512 + kvh * 64 + d8 * 8, kv); }, [&](int) { return nr[768 + kvh * 64 + lane]; }, ss, scd, lane); }
            ++cnt;
            const float* wb = F.out + O_WINS + (size_t)s * 512 * 512;
            for (int c = 0; c < 8; ++c, ++cnt) if ((cnt & 7) == w) { const float* kb = wb + (size_t)(64 * c + lane) * 512 + kvh * 64; const float* vb = wb + (size_t)(64 * c) * 512 + 256 + kvh * 64 + lane;
                attn_block64(qs, ps, true, [&](int d8, float (&kv)[8]) { ld8_f32(kb + d8 * 8, kv); }, [&](int key) { return vb[(size_t)key * 512]; }, sw, scd, lane); } }
#pragma unroll
        for (int g = 0; g < 4; ++g) { LAS float* p0 = part + ((w * 2 + 0) * 4 + g) * 66; LAS float* p1 = part + ((w * 2 + 1) * 4 + g) * 66;
            if (lane == 0) { p0[0] = ss.m[g]; p0[1] = ss.l[g]; p1[0] = sw.m[g]; p1[1] = sw.l[g]; } p0[2 + lane] = ss.o[g]; p1[2 + lane] = sw.o[g]; }
        __syncthreads();
        if (w < 4) { const int g = w; float res[2];
#pragma unroll
            for (int kd = 0; kd < 2; ++kd) { float M = -1e30f;
#pragma unroll
                for (int ww = 0; ww < 8; ++ww) M = fmaxf(M, part[((ww * 2 + kd) * 4 + g) * 66]);
                float L = 0.f, O = 0.f;
#pragma unroll
                for (int ww = 0; ww < 8; ++ww) { const LAS float* pp = part + ((ww * 2 + kd) * 4 + g) * 66; const float f = __builtin_amdgcn_exp2f(pp[0] - M); L += pp[1] * f; O += pp[2 + lane] * f; }
                res[kd] = L > 0.f ? O / L : 0.f; }
            const float* gt = (const float*)(F.ws + WS_GATES) + (size_t)row * 48 + (kvh * 4 + g) * 3;
            ((bf16*)(F.ws + WS_OB))[(size_t)row * D + (kvh * 4 + g) * 64 + lane] = (bf16)f2bf(gt[0] * ocs[g * 64 + lane] + gt[1] * res[0] + gt[2] * res[1]); }
        __syncthreads();
    }
}

namespace attn_body {
using bf16=__hip_bfloat16;
using bf16x8=__attribute__((ext_vector_type(8)))short;
using s16x4=__attribute__((ext_vector_type(4)))short;
using f32x16=__attribute__((ext_vector_type(16)))float;
using u32x4=__attribute__((ext_vector_type(4)))unsigned;
constexpr int BATCH=2,NHEAD=16,SEQ=8192,D=64,DM=NHEAD*D;
constexpr int NW=8,QBLK=32,QB=QBLK*NW,KVBLK=64,NQB=SEQ/QB;
constexpr int ATTN_PITCH=DM, ATTN_UNIT_ROWS=QB;
__device__ __forceinline__ int crow(int r,int hi){return (r&3)+8*(r>>2)+4*hi;}
#define SBAR() __builtin_amdgcn_sched_barrier(0)
__device__ __forceinline__ void cmask(f32x16&p0,f32x16&p1,int jb,int qrel,int hi){
  const float NEG=-INFINITY; int kb=64*jb+4*hi;
  #pragma unroll
  for(int r=0;r<16;++r){int kv=kb+(r&3)+8*(r>>2); if(kv>qrel)p0[r]=NEG; if(kv+32>qrel)p1[r]=NEG;}
}

__device__ __forceinline__ void lmask(f32x16&p0,f32x16&p1,int k,int qrel,int hi){
  const float NEG=-INFINITY; int kb=64*k+4*hi;
  #pragma unroll
  for(int r=0;r<16;++r){int kv=kb+(r&3)+8*(r>>2); if(kv<=qrel)p0[r]=NEG; if(kv+32<=qrel)p1[r]=NEG;}
}
constexpr int NSLOT=3, SLOTB=8192;
constexpr int LDS_K=0, LDS_V=NSLOT*SLOTB, LDS_WS=2*NSLOT*SLOTB, LDS_OST=LDS_WS+NW*64*4, LDS_BYTES=LDS_OST+NW*4096;
constexpr float C2=0.125f*1.4426950408889634f;
__device__ __forceinline__ void glds16(const void*gsrc,unsigned lds_dst){unsigned keep;
  asm volatile("s_mov_b32 %0, m0\n\ts_mov_b32 m0, %2\n\ts_nop 0\n\tglobal_load_lds_dwordx4 %1, off\n\ts_mov_b32 m0, %0":"=&s"(keep):"v"(gsrc),"s"(lds_dst):"memory");}
__device__ __forceinline__ float max3f(float a,float b,float c){float r;asm("v_max3_f32 %0, %1, %2, %3":"=v"(r):"v"(a),"v"(b),"v"(c));return r;}
__device__ __forceinline__ float max2f(float a,float b){float r;asm("v_max_f32_e32 %0, %1, %2":"=v"(r):"v"(a),"v"(b));return r;}
__device__ __forceinline__ float fadd_s(float a,float b){float r;asm("v_add_f32_e32 %0, %1, %2":"=v"(r):"v"(a),"v"(b));return r;}
__device__ __forceinline__ float fsub_s(float a,float b){float r;asm("v_sub_f32_e32 %0, %1, %2":"=v"(r):"v"(a),"v"(b));return r;}
typedef float f32x2_t __attribute__((ext_vector_type(2))); typedef __bf16 bf16x2_t __attribute__((ext_vector_type(2)));
__device__ __forceinline__ unsigned cvtpk_s(float lo,float hi){f32x2_t v={lo,hi};bf16x2_t b=__builtin_convertvector(v,bf16x2_t);return __builtin_bit_cast(unsigned,b);}
#define WAIT_BAR(N) asm volatile("s_waitcnt vmcnt(" #N ") lgkmcnt(0)\n\ts_barrier":::"memory")

__device__ __forceinline__ void qkt(f32x16&p0,f32x16&p1,const char*Kslot,const bf16x8*qr,const f32x16&negm,int r32,int hi){
  const char*kb=Kslot+hi*1024+r32*16;
  #pragma unroll
  for(int d0=0;d0<4;++d0){
    const bf16x8 b0=*reinterpret_cast<const bf16x8*>(kb+d0*2048);
    const bf16x8 b1=*reinterpret_cast<const bf16x8*>(kb+d0*2048+512);
    if(d0==0){p0=__builtin_amdgcn_mfma_f32_32x32x16_bf16(b0,qr[0],negm,0,0,0);p1=__builtin_amdgcn_mfma_f32_32x32x16_bf16(b1,qr[0],negm,0,0,0);}
    else{p0=__builtin_amdgcn_mfma_f32_32x32x16_bf16(b0,qr[d0],p0,0,0,0);p1=__builtin_amdgcn_mfma_f32_32x32x16_bf16(b1,qr[d0],p1,0,0,0);}}
}
typedef __attribute__((address_space(3))) const char* lds_cptr;
typedef short v4i16_t __attribute__((ext_vector_type(4)));
__device__ __forceinline__ void kload8(bf16x8*kf,lds_cptr kp){
  kf[0]=*(const __attribute__((address_space(3))) bf16x8*)(kp);      kf[1]=*(const __attribute__((address_space(3))) bf16x8*)(kp+512);
  kf[2]=*(const __attribute__((address_space(3))) bf16x8*)(kp+2048); kf[3]=*(const __attribute__((address_space(3))) bf16x8*)(kp+2560);
  kf[4]=*(const __attribute__((address_space(3))) bf16x8*)(kp+4096); kf[5]=*(const __attribute__((address_space(3))) bf16x8*)(kp+4608);
  kf[6]=*(const __attribute__((address_space(3))) bf16x8*)(kp+6144); kf[7]=*(const __attribute__((address_space(3))) bf16x8*)(kp+6656);
}
__device__ __forceinline__ void kload2(bf16x8*kf,lds_cptr kp,int j){ kf[2*j]=*(const __attribute__((address_space(3))) bf16x8*)(kp+j*2048); kf[2*j+1]=*(const __attribute__((address_space(3))) bf16x8*)(kp+j*2048+512); }
__device__ __forceinline__ s16x4 vtr(lds_cptr p){ return __builtin_bit_cast(s16x4,__builtin_amdgcn_ds_read_tr16_b64_v4i16((__attribute__((address_space(3))) v4i16_t*)p)); }
__device__ __forceinline__ float rowmax(const f32x16&p0,const f32x16&p1){
  float a=max3f(p0[0],p0[1],p1[0]),b=max3f(p0[2],p0[3],p1[1]);a=max3f(a,p1[2],p1[3]);
  #pragma unroll
  for(int r=4;r<16;r+=4){a=max3f(a,p0[r],p0[r+1]);b=max3f(b,p0[r+2],p0[r+3]);a=max3f(a,p1[r],p1[r+1]);b=max3f(b,p1[r+2],p1[r+3]);}
  const float m=max2f(a,b);
  auto rr=__builtin_amdgcn_permlane32_swap(__float_as_uint(m),__float_as_uint(m),false,false);
  return max2f(__uint_as_float(rr[0]),__uint_as_float(rr[1]));
}
__device__ __forceinline__ void pv(f32x16*o,int vb,bf16x8 pa0,bf16x8 pa1,bf16x8 pa2,bf16x8 pa3){
  #pragma unroll
  for(int d0=0;d0<2;++d0){s16x4 lo[4],hi[4];
    #pragma unroll
    for(int ks=0;ks<4;++ks){
      asm volatile("ds_read_b64_tr_b16 %0,%1 offset:%c2":"=&v"(lo[ks]):"v"(vb),"i"(d0*4096+ks*1024):"memory");
      asm volatile("ds_read_b64_tr_b16 %0,%1 offset:%c2":"=&v"(hi[ks]):"v"(vb),"i"(d0*4096+ks*1024+512):"memory");}
    asm volatile("s_waitcnt lgkmcnt(0)":::"memory");SBAR();
    #define PK(k) (bf16x8){lo[k][0],lo[k][1],lo[k][2],lo[k][3],hi[k][0],hi[k][1],hi[k][2],hi[k][3]}
    o[d0]=__builtin_amdgcn_mfma_f32_32x32x16_bf16(pa0,PK(0),o[d0],0,0,0);
    o[d0]=__builtin_amdgcn_mfma_f32_32x32x16_bf16(pa1,PK(1),o[d0],0,0,0);
    o[d0]=__builtin_amdgcn_mfma_f32_32x32x16_bf16(pa2,PK(2),o[d0],0,0,0);
    o[d0]=__builtin_amdgcn_mfma_f32_32x32x16_bf16(pa3,PK(3),o[d0],0,0,0);
    #undef PK
  }
}

#ifndef ATTN_STORE16
#define ATTN_STORE16(p,v) (*(u32x4*)(p)=(v))
#endif
template<int THRL,int MODE,int KVP> __device__ __forceinline__ void attn_unit(int b,int h,int qb,const bf16*Q,const bf16*__restrict__ K,const bf16*__restrict__ V,bf16*O,char*shm,const u32x4*SELM,const float*GATES){
  int tid=threadIdx.x; asm volatile("":"+v"(tid));
  const int lane=tid&63,r32=lane&31,hi=lane>>5; const int wid=__builtin_amdgcn_readfirstlane(tid>>6);
  const long rowbase=(long)b*SEQ; const int q0=qb*QB;
  const bf16*Qw=Q+(rowbase+q0+wid*QBLK)*DM+h*D;
  const int kvh=h>>2; const bool LOWER=(MODE==1)&&(qb>=2); const int T0=LOWER?4*qb-8:0;
  const bf16*Kh=K+(rowbase+(long)T0*KVBLK)*KVP+kvh*D,*Vh=V+(rowbase+(long)T0*KVBLK)*KVP+kvh*D;
  const unsigned lds0=(unsigned)(uintptr_t)shm;
  float*wsf=(float*)(shm+LDS_WS)+wid*64;
  const bf16*ksrc=Kh+(long)lane*KVP+wid*8;
  const bf16*vsrc=Vh+(long)(16*(wid&3)+(lane>>2))*KVP+(wid>>2)*32+(lane&3)*8;
  const unsigned kdst=lds0+LDS_K+wid*1024, vdst=lds0+LDS_V+wid*1024;
  #define DMA_K(t,slot) glds16(ksrc+(long)(t)*KVBLK*KVP,(unsigned)__builtin_amdgcn_readfirstlane(kdst+(slot)))
  #define DMA_V(t,slot) glds16(vsrc+(long)(t)*KVBLK*KVP,(unsigned)__builtin_amdgcn_readfirstlane(vdst+(slot)))
  const int vb0=(int)(lds0+LDS_V)+((lane>>4)&1)*32+(lane&3)*8+(4*hi+((lane&15)>>2))*64;
  const char*Kbase=shm+LDS_K; bf16x8 kf[8];
  const lds_cptr shm3=(lds_cptr)shm; const lds_cptr kp0=shm3+LDS_K+hi*1024+r32*16; const lds_cptr vp0=shm3+LDS_V+((lane>>4)&1)*32+(lane&3)*8+(4*hi+((lane&15)>>2))*64;
  const int NT=(q0+QB)/KVBLK-T0;
  DMA_K(0,0);DMA_V(0,0);DMA_K(1,SLOTB);
  bf16x8 qr[4];
  #pragma unroll
  for(int d0=0;d0<4;++d0)qr[d0]=*reinterpret_cast<const bf16x8*>(&Qw[(long)r32*DM+d0*16+hi*8]);
  float zf_=0.f; asm volatile("":"+v"(zf_));
  float mhat=0.f,l_reg=0.f;f32x16 o[2],negm;
  #pragma unroll
  for(int r=0;r<16;++r){o[0][r]=zf_;o[1][r]=zf_;negm[r]=zf_;}
  asm volatile("":"+v"(negm));
  const int qrel=wid*QBLK+r32;
  u32x4 sm=(u32x4){0u,0u,0u,0u}; unsigned selw=0xffffffffu; if(MODE==0){ sm=SELM[(long)(b*4+kvh)*SEQ+q0+wid*QBLK+r32]; }
  #define SELSTEP() do{ if(MODE==0){ selw=0u-(sm.x&1u); sm.x=__builtin_amdgcn_alignbit(sm.y,sm.x,1); sm.y=__builtin_amdgcn_alignbit(sm.z,sm.y,1); sm.z=__builtin_amdgcn_alignbit(sm.w,sm.z,1); sm.w>>=1; } }while(0)
  #define CMASK(P0,P1,t) do{int jb_=(t)-(NT-4); if(jb_>=0)cmask(P0,P1,jb_,qrel,hi);}while(0)
  bool resc=false;
  #define START(P0,P1) do{ const float rm=max2f(rowmax(P0,P1),-64.f); resc=false; \
    { const float dl=rm; mhat=fadd_s(mhat,dl); \
      _Pragma("unroll") for(int r=0;r<16;++r){P0[r]=fsub_s(P0[r],dl);P1[r]=fsub_s(P1[r],dl);} \
      _Pragma("unroll") for(int r=0;r<16;++r)negm[r]=-mhat; asm volatile("":"+v"(negm)); } \
    _Pragma("unroll") for(int r=0;r<16;++r)P0[r]=__builtin_amdgcn_exp2f(P0[r]); }while(0)
  #define RESC() do{ if(resc){ asm volatile("s_waitcnt lgkmcnt(0)":::"memory"); \
      _Pragma("unroll") for(int d_=0;d_<2;++d_) _Pragma("unroll") for(int r=0;r<16;++r)o[d_][r]*=wsf[crow(r,hi)]; } }while(0)
  f32x16 pA0,pA1,pB0,pB1;
  int sl_prev=0,sl_cur=0,sl_next=SLOTB;
  #define ROT() do{sl_prev=sl_cur;sl_cur=sl_next;sl_next=(sl_next==(NSLOT-1)*SLOTB)?0:sl_next+SLOTB;}while(0)
  DMA_K(2,2*SLOTB);
  WAIT_BAR(3);
  qkt(pA0,pA1,Kbase,qr,negm,r32,hi);asm volatile("s_nop 15\n\ts_nop 7":"+v"(pA0),"+v"(pA1));CMASK(pA0,pA1,0); if(LOWER)lmask(pA0,pA1,0,qrel,hi);
  START(pA0,pA1);
  _Pragma("unroll") for(int r=0;r<16;++r)pA1[r]=__builtin_amdgcn_exp2f(pA1[r]);
  WAIT_BAR(0);
  DMA_K(3,0);DMA_V(1,SLOTB);
  ROT();
  kload8(kf,kp0+sl_cur);
  WAIT_BAR(2);
  s16x4 vlo[8],vhi[8]; u32x4 pw0,pw1,pw2,pw3;
  #define PKW(P,B) (cvtpk_s(P[B],P[B+1])&selw)
  #define PAF(k) __builtin_bit_cast(bf16x8,pw##k)
  #define VFR(i) (bf16x8){vlo[i][0],vlo[i][1],vlo[i][2],vlo[i][3],vhi[i][0],vhi[i][1],vhi[i][2],vhi[i][3]}
  #define PIN(x) asm volatile("":"+v"(x))
  #define MX3(a,b,c) __builtin_fmaxf(__builtin_fmaxf((a),(b)),(c))
  #define GAPA(MF,A0,A1,A2,A3,W0,W1,PW) do{ MF; sacc+=A0; sacc+=A1; sacc+=A2; sacc+=A3; PIN(sacc); W0; W1; PIN(PW); SBAR(); }while(0)
  #define EX(v) __builtin_amdgcn_exp2f(v)
  #define GAPB(MF,X,B) do{ MF; X[B]=EX(X[B]); X[B+1]=EX(X[B+1]); X[B+2]=EX(X[B+2]); X[B+3]=EX(X[B+3]); PIN(X); SBAR(); }while(0)
  #define VRD(i) do{ vlo[i]=vtr(vp_+(((i)>>2)*4096+((i)&3)*1024)); vhi[i]=vtr(vp_+(((i)>>2)*4096+((i)&3)*1024+512)); }while(0)
  #define KRD(G,j) do{ if(G){ kload2(kf,kp0+sl_next,j); SBAR(); } }while(0)
  #define STEP(C0,C1,P0,P1,t,GK,GV,GL) do{ SELSTEP(); SBAR(); \
    const lds_cptr vp_=vp0+sl_prev; \
    VRD(0); SBAR(); float sacc=(P0[0]+P0[1]); \
    GAPA(C0=__builtin_amdgcn_mfma_f32_32x32x16_bf16(kf[0],qr[0],negm,0,0,0), P0[2],P0[3],P0[4],P0[5],     pw0[0]=PKW(P0,0), pw0[1]=PKW(P0,2), pw0); \
    VRD(4); SBAR(); GAPA(C1=__builtin_amdgcn_mfma_f32_32x32x16_bf16(kf[1],qr[0],negm,0,0,0), P0[6],P0[7],P0[8],P0[9],     pw0[2]=PKW(P0,4), pw0[3]=PKW(P0,6), pw0); \
    VRD(1); SBAR(); GAPA(C0=__builtin_amdgcn_mfma_f32_32x32x16_bf16(kf[2],qr[1],C0,0,0,0),   P0[10],P0[11],P0[12],P0[13], pw1[0]=PKW(P0,8), pw1[1]=PKW(P0,10), pw1); \
    VRD(5); SBAR(); GAPA(C1=__builtin_amdgcn_mfma_f32_32x32x16_bf16(kf[3],qr[1],C1,0,0,0),   P0[14],P0[15],P1[0],P1[1],   pw1[2]=PKW(P0,12),pw1[3]=PKW(P0,14), pw1); \
    VRD(2); SBAR(); GAPA(C0=__builtin_amdgcn_mfma_f32_32x32x16_bf16(kf[4],qr[2],C0,0,0,0),   P1[2],P1[3],P1[4],P1[5],     pw2[0]=PKW(P1,0), pw2[1]=PKW(P1,2), pw2); \
    VRD(6); SBAR(); GAPA(C1=__builtin_amdgcn_mfma_f32_32x32x16_bf16(kf[5],qr[2],C1,0,0,0),   P1[6],P1[7],P1[8],P1[9],     pw2[2]=PKW(P1,4), pw2[3]=PKW(P1,6), pw2); \
    VRD(3); SBAR(); GAPA(C0=__builtin_amdgcn_mfma_f32_32x32x16_bf16(kf[6],qr[3],C0,0,0,0),   P1[10],P1[11],P1[12],P1[13], pw3[0]=PKW(P1,8), pw3[1]=PKW(P1,10), pw3); \
    VRD(7); SBAR(); GAPA(C1=__builtin_amdgcn_mfma_f32_32x32x16_bf16(kf[7],qr[3],C1,0,0,0),   P1[14],P1[15],0.f,0.f,       pw3[2]=PKW(P1,12),pw3[3]=PKW(P1,14), pw3); \
    l_reg+=__uint_as_float(__float_as_uint(sacc)&selw); \
    if(GK){DMA_K((t)+3,sl_cur);} if(GV){DMA_V((t)+1,sl_next);} \
    CMASK(C0,C1,t); \
    { float a=MX3(C0[0],C0[1],C1[0]),b=MX3(C0[2],C0[3],C1[1]); a=MX3(a,C1[2],C1[3]); \
      _Pragma("unroll") for(int r=4;r<16;r+=4){a=MX3(a,C0[r],C0[r+1]);b=MX3(b,C0[r+2],C0[r+3]);a=MX3(a,C1[r],C1[r+1]);b=MX3(b,C1[r+2],C1[r+3]);} \
      float rm=__builtin_fmaxf(a,b); { auto rr=__builtin_amdgcn_permlane32_swap(__float_as_uint(rm),__float_as_uint(rm),false,false); rm=__builtin_fmaxf(__uint_as_float(rr[0]),__uint_as_float(rr[1])); } \
      resc=false; \
      if(__builtin_expect(__any(rm>(float)THRL),0)){ const float dl=__builtin_fmaxf(rm,0.f); mhat+=dl; \
        _Pragma("unroll") for(int r=0;r<16;++r){C0[r]-=dl;C1[r]-=dl;} \
        _Pragma("unroll") for(int r=0;r<16;++r)negm[r]=-mhat; asm volatile("":"+v"(negm)); \
        const float f=__builtin_amdgcn_exp2f(-dl); l_reg*=f; if(hi==0)wsf[r32]=f; resc=true; } } \
    SBAR(); \
    GAPB(o[0]=__builtin_amdgcn_mfma_f32_32x32x16_bf16(PAF(0),VFR(0),o[0],0,0,0), C0,0); \
    GAPB(o[1]=__builtin_amdgcn_mfma_f32_32x32x16_bf16(PAF(0),VFR(4),o[1],0,0,0), C0,4); \
    KRD(GL,0); GAPB(o[0]=__builtin_amdgcn_mfma_f32_32x32x16_bf16(PAF(1),VFR(1),o[0],0,0,0), C0,8); \
    KRD(GL,1); GAPB(o[1]=__builtin_amdgcn_mfma_f32_32x32x16_bf16(PAF(1),VFR(5),o[1],0,0,0), C0,12); \
    KRD(GL,2); GAPB(o[0]=__builtin_amdgcn_mfma_f32_32x32x16_bf16(PAF(2),VFR(2),o[0],0,0,0), C1,0); \
    KRD(GL,3); GAPB(o[1]=__builtin_amdgcn_mfma_f32_32x32x16_bf16(PAF(2),VFR(6),o[1],0,0,0), C1,4); \
    GAPB(o[0]=__builtin_amdgcn_mfma_f32_32x32x16_bf16(PAF(3),VFR(3),o[0],0,0,0), C1,8); \
    GAPB(o[1]=__builtin_amdgcn_mfma_f32_32x32x16_bf16(PAF(3),VFR(7),o[1],0,0,0), C1,12); \
    }while(0)
  int t=1;
  #undef CMASK
  #define CMASK(P0,P1,t) lmask(P0,P1,(t),qrel,hi)
  if(LOWER){ for(;t<5;t+=2){
    STEP(pB0,pB1,pA0,pA1,t,true,true,true);     WAIT_BAR(2); RESC(); ROT();
    STEP(pA0,pA1,pB0,pB1,t+1,true,true,true);   WAIT_BAR(2); RESC(); ROT();
  } }
  #undef CMASK
  #define CMASK(P0,P1,t) do{}while(0)
  for(;t+5<NT;t+=2){
    STEP(pB0,pB1,pA0,pA1,t,true,true,true);     WAIT_BAR(2); RESC(); ROT();
    STEP(pA0,pA1,pB0,pB1,t+1,true,true,true);   WAIT_BAR(2); RESC(); ROT();
  }
  #undef CMASK
  #define CMASK(P0,P1,t) do{int jb_=(t)-(NT-4); if(jb_>=0)cmask(P0,P1,jb_,qrel,hi);}while(0)
  #define ENDW(tt) do{ if((tt)+3<NT){WAIT_BAR(2);} else if((tt)+2<NT){WAIT_BAR(1);} else {WAIT_BAR(0);} }while(0)
  for(;t+1<NT;t+=2){
    STEP(pB0,pB1,pA0,pA1,t,(t+3<NT),(t+1<NT),(t+1<NT));       ENDW(t);   RESC(); ROT();
    STEP(pA0,pA1,pB0,pB1,t+1,(t+4<NT),(t+2<NT),(t+2<NT));     ENDW(t+1); RESC(); ROT();
  }
  STEP(pB0,pB1,pA0,pA1,NT-1,false,false,false); RESC();
  { SELSTEP(); float sacc=pB0[0]+pB0[1]; _Pragma("unroll") for(int r=2;r<16;++r)sacc+=pB0[r]; _Pragma("unroll") for(int r=0;r<16;++r)sacc+=pB1[r]; l_reg+=__uint_as_float(__float_as_uint(sacc)&selw);
    pw0=(u32x4){PKW(pB0,0),PKW(pB0,2),PKW(pB0,4),PKW(pB0,6)};pw1=(u32x4){PKW(pB0,8),PKW(pB0,10),PKW(pB0,12),PKW(pB0,14)};pw2=(u32x4){PKW(pB1,0),PKW(pB1,2),PKW(pB1,4),PKW(pB1,6)};pw3=(u32x4){PKW(pB1,8),PKW(pB1,10),PKW(pB1,12),PKW(pB1,14)};
    SBAR(); pv(o,vb0+sl_cur,PAF(0),PAF(1),PAF(2),PAF(3)); }
  #undef PKW
  #undef PAF
  #undef VFR
  #undef PIN
  #undef MX3
  #undef GAPA
  #undef GAPB
  #undef EX
  #undef VRD
  #undef KRD
  #undef STEP
  #undef ENDW
  {auto rr=__builtin_amdgcn_permlane32_swap(__float_as_uint(l_reg),__float_as_uint(l_reg),false,false);l_reg=__uint_as_float(rr[0])+__uint_as_float(rr[1]);}
  if(hi==0){ const float gt=GATES[(rowbase+q0+wid*QBLK+r32)*48+h*3+1+MODE]; wsf[32+r32]=gt*__builtin_amdgcn_rcpf(l_reg); } asm volatile("s_waitcnt lgkmcnt(0)":::"memory");
  float rli[16];
  #pragma unroll
  for(int r=0;r<16;++r)rli[r]=wsf[32+crow(r,hi)];
  bf16*Ow=O+(rowbase+q0+wid*QBLK)*DM+h*D;
  { bf16*stg=(bf16*)(shm+LDS_OST)+wid*2048;
    #pragma unroll
    for(int r=0;r<16;++r){const int orow=crow(r,hi);
      #pragma unroll
      for(int d0=0;d0<2;++d0)stg[orow*64+d0*32+r32]=__float2bfloat16(o[d0][r]*rli[r]);}
    asm volatile("s_waitcnt lgkmcnt(0)":::"memory");
    #pragma unroll
    for(int i=0;i<4;++i){const int row=i*8+(lane>>3),ch=lane&7; const u32x4 v=*(const u32x4*)(stg+row*64+ch*8); const u32x4 pv=*(const u32x4*)(Ow+(long)row*DM+ch*8); u32x4 o4;
      #pragma unroll
      for(int e=0;e<4;++e){ const float lo=__uint_as_float(v[e]<<16)+__uint_as_float(pv[e]<<16), hi2=__uint_as_float(v[e]&0xffff0000u)+__uint_as_float(pv[e]&0xffff0000u); o4[e]=cvtpk_s(lo,hi2); }
      ATTN_STORE16(Ow+(long)row*DM+ch*8,o4);} }
  asm volatile("s_waitcnt lgkmcnt(0)\n\ts_barrier":::"memory");
  #undef DMA_K
  #undef DMA_V
  #undef CMASK
  #undef START
  #undef RESC
  #undef ROT
  #undef SELSTEP
}
constexpr int ATTN_LDS_BYTES=LDS_BYTES;
struct AttnUnit { int bh; int qb; };
template<int THRL=8> __device__ __forceinline__ void attn_phase(char*lds,unsigned char*ws_,int vcu,int G){
  for(int i=0;;++i){ const int L=i*G+vcu; if(L>=BATCH*NHEAD*8*4) break; const int v=L%(BATCH*NHEAD*8), rnd=L/(BATCH*NHEAD*8), s=v&7; AttnUnit u; u.bh=v>>3; u.qb=(rnd==0)?s:(rnd==1)?15-s:(rnd==2)?16+s:31-s;
    unsigned char* ws=uni_ptr(ws_);
    const bf16*Q=(const bf16*)(ws+WS_QB); const bf16*KV=(const bf16*)(ws+WS_KVB); const bf16*WN=(const bf16*)(ws+WS_WINB); bf16*O=(bf16*)(ws+WS_OB); const u32x4*SELM=(const u32x4*)(ws+WS_SELM); const float*GATES=(const float*)(ws+WS_GATES);
    attn_unit<THRL,0,1024>(u.bh/NHEAD,u.bh%NHEAD,u.qb,Q,KV+512,KV+768,O,lds,SELM,GATES);
    asm volatile("s_waitcnt vmcnt(0)":::"memory");
    attn_unit<THRL,1,512>(u.bh/NHEAD,u.bh%NHEAD,u.qb,Q,WN,WN+256,O,lds,nullptr,GATES);
    asm volatile("s_waitcnt vmcnt(0)":::"memory"); }
}
#undef SBAR
#undef WAIT_BAR
}

typedef float f32x16 __attribute__((ext_vector_type(16)));
__device__ __forceinline__ int crow16(int r, int hi) { return (r & 3) + 8 * (r >> 2) + 4 * hi; }
__device__ __forceinline__ void cmpsel_phase(Ctx& F) {
    const int w = F.wave;
    for (int u = F.vcu; u < NBP * 4 * NBLK; u += F.G) {
        unsigned char* ws = uni_ptr(F.ws);
        const bf16* QB = (const bf16*)(ws + WS_QB); const float* KC = (const float*)(ws + WS_KC); const float* VC = (const float*)(ws + WS_VC); const float* GATES = (const float*)(ws + WS_GATES);
        bf16* OB = (bf16*)(ws + WS_OB); v4u* SELM = (v4u*)(ws + WS_SELM);
        int lane = F.lane; asm volatile("" : "+v"(lane));
        const int r32 = lane & 31, hi = lane >> 5, g = r32 >> 3, ql = r32 & 7;
        const int i = u & 127, bk = u >> 7, b = bk >> 2, kvh = bk & 3;
        const int t = 64 * i + 8 * w + ql, row = b * SEQ + t, h = kvh * 4 + g;
        bf16x8 qf[4];
#pragma unroll
        for (int s = 0; s < 4; ++s) qf[s] = *(const bf16x8*)(QB + (size_t)row * D + h * 64 + 16 * s + 8 * hi);
        const float gatev = GATES[(size_t)row * 48 + h * 3];
        const int ntile = (i >> 5) + 1;
        f32x16 p[4];
#pragma unroll
        for (int kt = 0; kt < 4; ++kt) { p[kt] = (f32x16){};
            if (kt < ntile) {
#pragma unroll
                for (int s = 0; s < 4; ++s) { const float* kp = KC + ((size_t)((b * NBLK + 32 * kt + r32) * 4 + kvh)) * 64 + 16 * s + 8 * hi;
                    p[kt] = __builtin_amdgcn_mfma_f32_32x32x16_bf16(pack8(*(const f32x4*)kp, *(const f32x4*)(kp + 4)), qf[s], p[kt], 0, 0, 0); } } }
        const bool lastq = (t & 63) == 63;
        float m = -INFINITY;
#pragma unroll
        for (int kt = 0; kt < 4; ++kt)
#pragma unroll
            for (int r = 0; r < 16; ++r) { const int j = 32 * kt + crow16(r, hi); const bool valid = (j < i) || (j == i && lastq); if (!valid) p[kt][r] = -INFINITY; m = fmaxf(m, p[kt][r]); }
        m = fmaxf(m, __shfl_xor(m, 32)); m = fmaxf(m, -64.f);
        float l = 0.f;
#pragma unroll
        for (int kt = 0; kt < 4; ++kt)
#pragma unroll
            for (int r = 0; r < 16; ++r) { const float e = __builtin_amdgcn_exp2f(p[kt][r] - m); p[kt][r] = e; l += e; }
        l += __shfl_xor(l, 32);
        const float il = l > 0.f ? 1.f / l : 0.f;
#pragma unroll
        for (int kt = 0; kt < 4; ++kt) p[kt] = p[kt] * il;
        f32x16 o[2]; o[0] = (f32x16){}; o[1] = (f32x16){};
#pragma unroll
        for (int kt = 0; kt < 4; ++kt) if (kt < ntile) {
#pragma unroll
            for (int s = 0; s < 2; ++s) { v4u pw; pw.x = pg8::cvt_pk_bf16(p[kt][8 * s + 0], p[kt][8 * s + 1]); pw.y = pg8::cvt_pk_bf16(p[kt][8 * s + 2], p[kt][8 * s + 3]); pw.z = pg8::cvt_pk_bf16(p[kt][8 * s + 4], p[kt][8 * s + 5]); pw.w = pg8::cvt_pk_bf16(p[kt][8 * s + 6], p[kt][8 * s + 7]);
                const bf16x8 pa = __builtin_bit_cast(bf16x8, pw);
#pragma unroll
                for (int d0 = 0; d0 < 2; ++d0) { float vv[8];
#pragma unroll
                    for (int jj = 0; jj < 8; ++jj) vv[jj] = VC[((size_t)((b * NBLK + 32 * kt + 16 * s + 8 * (jj >> 2) + 4 * hi + (jj & 3)) * 4 + kvh)) * 64 + 32 * d0 + r32];
                    o[d0] = __builtin_amdgcn_mfma_f32_32x32x16_bf16(pa, pack8((f32x4){vv[0], vv[1], vv[2], vv[3]}, (f32x4){vv[4], vv[5], vv[6], vv[7]}), o[d0], 0, 0, 0); }
                __builtin_amdgcn_sched_barrier(0); } }
#pragma unroll
        for (int r = 0; r < 16; ++r) { const int rw = crow16(r, hi); const float gt = __shfl(gatev, rw); bf16* op = OB + (size_t)(b * SEQ + 64 * i + 8 * w + (rw & 7)) * D + (kvh * 4 + (rw >> 3)) * 64 + r32;
            op[0] = (bf16)f2bf(gt * o[0][r]); op[32] = (bf16)f2bf(gt * o[1][r]); }
#pragma unroll
        for (int kt = 0; kt < 4; ++kt)
#pragma unroll
            for (int r = 0; r < 16; ++r) { float x = p[kt][r]; x += __shfl_xor(x, 8); x += __shfl_xor(x, 16); p[kt][r] = x; }
        unsigned T = 0u;
        if (i >= 16) {
            unsigned xs[16];
#pragma unroll
            for (int kt = 0; kt < 4; ++kt)
#pragma unroll
                for (int k = 0; k < 4; ++k) { float v = p[kt][k]; v = (g == 1) ? p[kt][4 + k] : v; v = (g == 2) ? p[kt][8 + k] : v; v = (g == 3) ? p[kt][12 + k] : v;
                    const int j = 32 * kt + 8 * g + 4 * hi + k; xs[kt * 4 + k] = (j >= 1 && j <= i - 2) ? __float_as_uint(v) : 0u; }
            for (int bit = 30; bit >= 0; --bit) { const unsigned c = T | (1u << bit); int cnt = 0;
#pragma unroll
                for (int q = 0; q < 16; ++q) cnt += (xs[q] >= c) ? 1 : 0;
                cnt += __shfl_xor(cnt, 8); cnt += __shfl_xor(cnt, 16); cnt += __shfl_xor(cnt, 32);
                if (cnt >= 13) T = c; }
        }
        v4u wd;
#pragma unroll
        for (int kt = 0; kt < 4; ++kt) { unsigned wv = 0u;
#pragma unroll
            for (int r = 0; r < 16; ++r) { const int cr = crow16(r, hi), j = 32 * kt + cr; bool sel;
                if (i >= 16) sel = (j == 0) || (j == i) || (j == i - 1) || (j >= 1 && j <= i - 2 && __float_as_uint(p[kt][r]) >= T); else sel = j <= i;
                wv |= sel ? (1u << cr) : 0u; }
            wv |= (unsigned)__shfl_xor((int)wv, 32); wd[kt] = wv; }
        if (g == 0 && hi == 0) SELM[(size_t)(b * 4 + kvh) * SEQ + t] = wd;
    }
}

constexpr int NPHASES = 33;
__global__ void __launch_bounds__(512, 2) mk_fwd(Args args) {
    extern __shared__ __attribute__((aligned(16))) unsigned char lds_raw[];
    Ctx F;
    F.lds = (LAS unsigned char*)lds_raw; F.tid = threadIdx.x; F.lane = F.tid & 63; F.wave = __builtin_amdgcn_readfirstlane(F.tid >> 6);
    F.G = gridDim.x; { const int bx = blockIdx.x; F.vcu = (F.G % 8 == 0) ? (bx % 8) * (F.G / 8) + bx / 8 : bx; }
    F.gw = F.vcu * 8 + F.wave; F.NGW = F.G * 8;
    F.out = args.out; F.ws = args.ws; unsigned char* ws = args.ws;
    volatile LAS unsigned* MISC = (volatile LAS unsigned*)(F.lds + MISC_OFF);
    for (int u = F.tid; u < (LDS_BYTES - RING_BYTES) / 4; u += 512) ((LAS unsigned*)(F.lds + RING_BYTES))[u] = 0u;
    __syncthreads();
    unsigned* ctl = (unsigned*)(ws + WS_CTL);
    XcdBarrier bar; bar.bar = ctl + CW_BAR; bar.x = 0; bar.st = nullptr;
    const int lo = args.ph_lo, hi = args.ph_hi;
    if (hi - lo > 1) bar = xcd_barrier_post(ctl + CW_BAR, MISC + 8);
    int ph = 0;
    const Ctx& F0 = F;
#define PH_BEGIN if (ph >= lo && ph < hi) { Ctx F = fresh(F0); float* X = F.out + O_Y; (void)X;
#define PH_CLOSE } do { if (ph >= lo && ph + 1 < hi) { XcdBarrier b2_ = bar; asm volatile("" : "+s"(b2_.bar), "+s"(b2_.x)); xcd_barrier(b2_); } ++ph; } while (0)
#define XLO (l == 0 ? (const float*)kin(0) : (const float*)X)
#define XHI (l == 0 ? (const float*)kin(1) : (const float*)(X + (size_t)MP * D))
#define WSB(off) ((bf16*)(F.ws + (off)))
#define WSF(off) ((float*)(F.ws + (off)))
    const int bxi = (int)blockIdx.x;
    PH_BEGIN p0_prologue(F); PH_CLOSE;
    PH_BEGIN pg8::Gemm g{WSB(WS_CB), WSB(WS_ADAT), D, D, D, 0}; pg8::StaticOrder S; S.init(256, NADA, F.G, bxi); pg8::EpiF32 E{WSF(WS_MODS), NADA, 64, (const float*)kin(9), (const float*)kin(15), 8 * 3072};
        pg8::gemm_phase(F.lds, g, S, E); PH_CLOSE;
    for (int l = 0; l < 4; ++l) {
        if (l < 2) {
            PH_BEGIN pass_h(F, l, XLO, XHI); PH_CLOSE;
            PH_BEGIN pass_pool(F); PH_CLOSE;
            PH_BEGIN pg8::Gemm g{WSB(WS_XN2), WSB(WS_POOLW) + (size_t)l * 1024 * 256, D, 256, 256, 256}; pg8::StaticOrder S; S.init(MP, D, F.G, bxi);
                pg8::EpiRes E{XLO, XHI, X, WSF(WS_MODS), (l * 2 + 0) * 3072 + 2048, (const float*)kin(13) + l * D}; pg8::gemm_phase(F.lds, g, S, E);
                skinny_res(F, WSB(WS_XN2) + (size_t)MP * D, D, 256, WSB(WS_POOLW) + (size_t)l * 1024 * 256, 256, 256, XHI, X + (size_t)MP * D, WSF(WS_MODS), (l * 2 + 0) * 3072 + 2048, (const float*)kin(13) + l * D); PH_CLOSE;
        } else {
            const int j = l - 2;
            PH_BEGIN if (l == 2) pass_norm(F, X, X + (size_t)MP * D, (const float*)kin(10) + l * D, (l * 2 + 0) * 3072, WSB(WS_XN), (const float*)kin(16), 8 * 3072, WSB(WS_XN2));
                     else pass_norm(F, X, X + (size_t)MP * D, (const float*)kin(10) + l * D, (l * 2 + 0) * 3072, WSB(WS_XN), nullptr, 0, nullptr); PH_CLOSE;
            PH_BEGIN
                if (l == 2) { pg8::Gemm g{WSB(WS_XN2), WSB(WS_WKV), D, D, D, 0}; pg8::StaticOrder S; S.init(MPAD, NKV, F.G, bxi); pg8::EpiF32 E{WSF(WS_RAWKV), NKV, MPAD, nullptr, nullptr, 0}; pg8::gemm_phase(F.lds, g, S, E); }
                { pg8::Gemm g{WSB(WS_XN), WSB(WS_WQG) + (size_t)j * NQGP * D, D, D, D, 0}; pg8::StaticOrder S; S.init(MPAD, NQGP, F.G, bxi); pg8::EpiF32 E{WSF(WS_RAWQ), NQGP, MPAD, nullptr, nullptr, 0}; pg8::gemm_phase(F.lds, g, S, E); }
            PH_CLOSE;
            PH_BEGIN if (l == 2) pass_kvpost(F); pass_qpost(F, j); PH_CLOSE;
            if (l == 2) { PH_BEGIN compress_phase(F); PH_CLOSE; }
            PH_BEGIN attn_sample_wg(F); cmpsel_phase(F); PH_CLOSE;
            PH_BEGIN attn_body::attn_phase<8>((char*)lds_raw, F.ws, F.vcu, F.G); PH_CLOSE;
            PH_BEGIN pg8::Gemm g{WSB(WS_OB), WSB(WS_WO) + (size_t)j * D * D, D, D, D, 0}; pg8::StaticOrder S; S.init(MP, D, F.G, bxi);
                pg8::EpiRes E{X, X + (size_t)MP * D, X, WSF(WS_MODS), (l * 2 + 0) * 3072 + 2048, nullptr}; pg8::gemm_phase(F.lds, g, S, E);
                skinny_res(F, WSB(WS_OB) + (size_t)MP * D, D, 0, WSB(WS_WO) + (size_t)j * D * D, D, D, X + (size_t)MP * D, X + (size_t)MP * D, WSF(WS_MODS), (l * 2 + 0) * 3072 + 2048, nullptr); PH_CLOSE;
        }
        PH_BEGIN pass_norm(F, X, X + (size_t)MP * D, (const float*)kin(11) + l * D, (l * 2 + 1) * 3072, WSB(WS_XN), nullptr, 0, nullptr); PH_CLOSE;
        PH_BEGIN pg8::Gemm g{WSB(WS_XN), WSB(WS_WGU) + (size_t)l * NGU * D, D, D, D, 0}; pg8::StaticOrder S; S.init(MPAD, NGU, F.G, bxi); pg8::EpiSwiglu E{WSB(WS_H), DFF}; pg8::gemm_phase(F.lds, g, S, E); PH_CLOSE;
        PH_BEGIN pg8::Gemm g{WSB(WS_H), WSB(WS_WDN) + (size_t)l * D * DFF, DFF, DFF, DFF, 0}; pg8::StaticOrder S; S.init(MP, D, F.G, bxi);
            pg8::EpiRes E{X, X + (size_t)MP * D, X, WSF(WS_MODS), (l * 2 + 1) * 3072 + 2048, nullptr}; pg8::gemm_phase(F.lds, g, S, E);
            skinny_res(F, WSB(WS_H) + (size_t)MP * DFF, DFF, 0, WSB(WS_WDN) + (size_t)l * D * DFF, DFF, DFF, X + (size_t)MP * D, X + (size_t)MP * D, WSF(WS_MODS), (l * 2 + 1) * 3072 + 2048, nullptr); PH_CLOSE;
    }
}

extern "C" void kernel_launch(void* const* d_in, const int* in_sizes, int n_in, void* d_out, int out_size, void* d_ws, size_t ws_size, hipStream_t stream) {
    static int grid = 0;
    if (grid == 0) {
        if (n_in != 27 || (size_t)out_size != O_END || ws_size < WS_END) { fprintf(stderr, "kernel_launch: unexpected shapes (n_in %d out %d ws %zu)\n", n_in, out_size, ws_size); grid = -1; return; }
        int dev = 0, cus = 0, per_cu = 0;
        if (hipGetDevice(&dev) != hipSuccess || hipDeviceGetAttribute(&cus, hipDeviceAttributeMultiprocessorCount, dev) != hipSuccess) { grid = -1; return; }
        if (hipFuncSetAttribute((const void*)mk_fwd, hipFuncAttributeMaxDynamicSharedMemorySize, LDS_BYTES) != hipSuccess) { fprintf(stderr, "kernel_launch: hipFuncSetAttribute failed\n"); grid = -1; return; }
        if (hipOccupancyMaxActiveBlocksPerMultiprocessor(&per_cu, (const void*)mk_fwd, 512, LDS_BYTES) != hipSuccess || per_cu < 1) fprintf(stderr, "kernel_launch: occupancy query reports %d\n", per_cu);
        (void)hipGetLastError();
        grid = cus;
    }
    if (grid < 0) return;
    (void)hipMemsetAsync((char*)d_ws + WS_CTL, 0, CTL_ZERO_BYTES, stream);
    Args a{};
    for (int i = 0; i < 27; ++i) a.in[i] = d_in[i];
    a.out = (float*)d_out; a.ws = (unsigned char*)d_ws;
#if MK_PER_PHASE
    for (int p = 0; p < NPHASES; ++p) { a.ph_lo = p; a.ph_hi = p + 1; hipLaunchKernelGGL(mk_fwd, dim3(grid), dim3(512), LDS_BYTES, stream, a); }
#else
    a.ph_lo = 0; a.ph_hi = NPHASES; hipLaunchKernelGGL(mk_fwd, dim3(grid), dim3(512), LDS_BYTES, stream, a);
#endif
}
```

```cpp
#include <hip/hip_runtime.h>
#include <cstdio>
#include <cstdint>
#include <hip/hip_bf16.h>
#include <cmath>

#ifndef MK_PER_PHASE
#define MK_PER_PHASE 0
#endif

constexpr int D = 1024, SEQ = 8192, NBP = 2, NBS = 32, MP = NBP * SEQ  , MR = MP + NBS  , MPAD = 16640  ;
constexpr int DFF = 2816, NGU = 2 * DFF, NKV = 1536, NQG = 1072, NQGP = 1280, NADA = 8 * 3072 + 2048  ;
constexpr int NBLK = 128, NBATCH = NBP + NBS  , NBLKT = NBATCH * NBLK  ;
constexpr float EPS = 1e-6f;
constexpr float C2 = 0.125f * 1.4426950408889634f;

constexpr size_t O_Y = 0, O_KV = (size_t)MR * 1024, O_WINP = O_KV + (size_t)MR * 1024, O_WINS = O_WINP + (size_t)2 * 512 * 512, O_POOLP = O_WINS + (size_t)32 * 512 * 512,
                 O_POOLS = O_POOLP + (size_t)2 * 2 * 15 * 1024, O_END = O_POOLS + (size_t)2 * 32 * 15 * 1024;
static_assert(O_END == 43577344, "output size");

constexpr size_t MiB = 1u << 20;
constexpr size_t WS_CTL = 0, CTL_ZERO_BYTES = 1 * MiB;
constexpr size_t WS_MODS = 1 * MiB, WS_CB = 8 * MiB, WS_ROPE = 9 * MiB, WS_BIASPE = 10 * MiB;
constexpr size_t WS_ADAT = 16 * MiB, WS_WGU = 68 * MiB, WS_WDN = 112 * MiB, WS_WKV = 134 * MiB, WS_WQG = 137 * MiB, WS_WO = 142 * MiB, WS_POOLW = 146 * MiB, WS_W1T = 147 * MiB;
constexpr size_t WS_XN = 160 * MiB, WS_XN2 = 193 * MiB, WS_H0 = 226 * MiB, WS_H = 291 * MiB, WS_RAWKV = 381 * MiB, WS_RAWQ = 479 * MiB, WS_KVB = 561 * MiB, WS_WINB = 594 * MiB,
                 WS_QB = 611 * MiB, WS_OB = 644 * MiB, WS_GATES = 677 * MiB, WS_KC = 681 * MiB, WS_VC = 686 * MiB, WS_SELM = 691 * MiB, WS_END = 700 * MiB;
constexpr int CW_BAR = 4096;

#define GAS __attribute__((address_space(1)))
#define LAS __attribute__((address_space(3)))
typedef unsigned short bf16;
typedef float f32x4 __attribute__((ext_vector_type(4)));
typedef float f32x2 __attribute__((ext_vector_type(2)));
typedef unsigned v4u __attribute__((ext_vector_type(4)));
typedef unsigned v2u __attribute__((ext_vector_type(2)));
typedef short bf16x8 __attribute__((ext_vector_type(8)));
#define RLX_AGENT __ATOMIC_RELAXED, __HIP_MEMORY_SCOPE_AGENT
#define LDS_WAIT() asm volatile("s_waitcnt lgkmcnt(0)" ::: "memory")
#define VM_WAIT() asm volatile("s_waitcnt vmcnt(0)" ::: "memory")

__device__ __forceinline__ unsigned f2bf(float f) { unsigned u = __builtin_bit_cast(unsigned, f); return (u + 0x7fffu + ((u >> 16) & 1u)) >> 16; }
__device__ __forceinline__ unsigned pk2(float lo, float hi) { return f2bf(lo) | (f2bf(hi) << 16); }
__device__ __forceinline__ float bf2f(unsigned short u) { return __builtin_bit_cast(float, (unsigned)u << 16); }
__device__ __forceinline__ float wave_sum(float v) {
#pragma unroll
    for (int o = 1; o < 64; o <<= 1) v += __shfl_xor(v, o);
    return v;
}
__device__ __forceinline__ float wave_max(float v) {
#pragma unroll
    for (int o = 1; o < 64; o <<= 1) v = fmaxf(v, __shfl_xor(v, o));
    return v;
}
__device__ __forceinline__ int bidx_of(int row) { return row < MP ? (row >> 13) : ((row - MP + 2) < NBATCH ? (row - MP + 2) : NBATCH - 1); }

namespace pg8 {
#define PG8_LAS __attribute__((address_space(3)))
typedef unsigned short bf16_t;
typedef short bf16x8 __attribute__((ext_vector_type(8)));
typedef float f32x4 __attribute__((ext_vector_type(4)));
typedef unsigned u32x4 __attribute__((ext_vector_type(4)));
constexpr int BM = 256, BK = 64, HALF = 128, HTB = HALF * BK * 2, STAGE_BYTES = 8 * HTB, NXCD = 8, WGM = 8;
__host__ __device__ __forceinline__ int lds_byte(int r, int c) { const int st = (r >> 4) * 2 + (c >> 5), rr = r & 15, cc = c & 31, ob = rr * 64 + cc * 2; return st * 1024 + (ob ^ (((ob >> 9) & 1) << 5)); }
__host__ __device__ __forceinline__ void stage_rc(int b, int& R, int& C) { const int st = b / 1024, sb = b % 1024, swz = sb ^ (((sb >> 9) & 1) << 5); R = (st >> 1) * 16 + swz / 64; C = (st & 1) * 32 + (swz % 64) / 2; }
__host__ __device__ __forceinline__ int perm32(int rho) { const int n = rho >> 4, i = rho & 15; return 8 * (i >> 2) + 4 * n + (i & 3); }
struct Unit { int pm, pn; };
struct Gemm { const bf16_t* A; const bf16_t* Bt; int lda, ldb, K, a_pn_off; };
struct StaticOrder {
    int nM, nN, nwg, G, c;
    __host__ __device__ void init(int M, int N, int G_, int c_) { nM = M / BM; nN = N / BM; nwg = nM * nN; G = G_; c = c_; }
    __host__ __device__ bool next(int i, Unit& u) const {
        const long L = (long)i * G + c; if (L >= nwg) return false;
        int wgid = (int)L; { const int q = nwg / NXCD, r = nwg % NXCD, xcd = wgid % NXCD, off = wgid / NXCD; wgid = (xcd < r ? xcd * (q + 1) : r * (q + 1) + (xcd - r) * q) + off; }
        const int nig = WGM * nN, gid = wgid / nig, fm = gid * WGM, gsz = (nM - fm) < WGM ? (nM - fm) : WGM;
        u.pm = fm + ((wgid % nig) % gsz); u.pn = (wgid % nig) / gsz; return true;
    }
};
template <class Epi>
__device__ __forceinline__ void gemm_phase(PG8_LAS unsigned char* lds, const Gemm g, const StaticOrder& S, const Epi& E) {
    int tid = threadIdx.x; asm volatile("" : "+v"(tid));
    const int wid = __builtin_amdgcn_readfirstlane(tid >> 6), lane = tid & 63, wr = wid >> 2, wc = wid & 3, fr = lane & 15, fq = lane >> 4;
    const int K = g.K, nt = K / BK;
    unsigned voffA[2], voffB[2];
#pragma unroll
    for (int i = 0; i < 2; ++i) { int R, C; stage_rc(tid * 16 + i * 8192, R, C); const int Rb = Epi::PERM ? ((R & ~31) + perm32(R & 31)) : R;
        voffA[i] = (unsigned)(R * g.lda + C) * 2u; voffB[i] = (unsigned)(Rb * g.ldb + C) * 2u; }
    const size_t kstep = (size_t)(BK * 2);
    const size_t hstepA = (size_t)HALF * g.lda * 2, hstepB = (size_t)HALF * g.ldb * 2, tstepA = 2 * hstepA, tstepB = 2 * hstepB;
    const unsigned ldsw = (unsigned)wid * 1024u;
    const int aoff = lds_byte(wr * 64 + fr, fq * 8), boff = lds_byte(wc * 32 + fr, fq * 8);
#define PG8_SA(b, h) (((b) * 2 + (h)) * HTB)
#define PG8_SB(b, h) ((4 + (b) * 2 + (h)) * HTB)
#define PG8_STAGE(bufoff, gbase, voff) do { _Pragma("unroll") for (int _i = 0; _i < 2; ++_i) \
        __builtin_amdgcn_global_load_lds((const unsigned*)((const char*)(gbase) + (voff)[_i]), (PG8_LAS unsigned*)(lds + (bufoff) + ldsw + _i * 8192), 16, 0, 0); } while (0)
#define PG8_LDA(dst, b, h) do { _Pragma("unroll") for (int m = 0; m < 4; ++m) _Pragma("unroll") for (int k = 0; k < 2; ++k) dst[m][k] = *(const PG8_LAS bf16x8*)(lds + PG8_SA(b, h) + aoff + m * 2048 + k * 1024); } while (0)
#define PG8_LDB(dst, b, h) do { _Pragma("unroll") for (int n = 0; n < 2; ++n) _Pragma("unroll") for (int k = 0; k < 2; ++k) dst[n][k] = *(const PG8_LAS bf16x8*)(lds + PG8_SB(b, h) + boff + n * 2048 + k * 1024); } while (0)
#define PG8_MMA(ai, bj, At, Bt) do { __builtin_amdgcn_s_setprio(1); _Pragma("unroll") for (int m = 0; m < 4; ++m) _Pragma("unroll") for (int n = 0; n < 2; ++n) _Pragma("unroll") for (int k = 0; k < 2; ++k) \
        acc[ai][bj][m][n] = __builtin_amdgcn_mfma_f32_16x16x32_bf16(Bt[n][k], At[m][k], acc[ai][bj][m][n], 0, 0, 0); __builtin_amdgcn_s_setprio(0); } while (0)
#define PG8_WAIT_V(n) asm volatile("s_waitcnt vmcnt(" #n ")" ::: "memory")
#define PG8_WAIT_L(n) asm volatile("s_waitcnt lgkmcnt(" #n ")" ::: "memory")
#define PG8_BAR __builtin_amdgcn_s_barrier()
#define PG8_SCHED __builtin_amdgcn_sched_barrier(0)
    Unit cur, nxt; int ui = 0;
    if (!S.next(0, cur)) return;
    f32x4 acc[2][2][4][2];
#pragma unroll
    for (int a = 0; a < 2; ++a)
#pragma unroll
        for (int b = 0; b < 2; ++b)
#pragma unroll
            for (int m = 0; m < 4; ++m)
#pragma unroll
                for (int n = 0; n < 2; ++n) acc[a][b][m][n] = (f32x4){0.f, 0.f, 0.f, 0.f};
    bf16x8 At[4][2], B0[2][2], B1[2][2];
    const char* cA = (const char*)g.A + (size_t)cur.pm * tstepA + (size_t)cur.pn * g.a_pn_off * 2; const char* cB = (const char*)g.Bt + (size_t)cur.pn * tstepB;
    PG8_STAGE(PG8_SB(0, 0), cB, voffB); PG8_STAGE(PG8_SB(0, 1), cB + hstepB, voffB); PG8_STAGE(PG8_SA(0, 0), cA, voffA); PG8_STAGE(PG8_SA(0, 1), cA + hstepA, voffA);
    if (wr == 1) PG8_BAR;
    PG8_WAIT_V(2); PG8_BAR;
    PG8_STAGE(PG8_SB(1, 0), cB + kstep, voffB); PG8_STAGE(PG8_SA(1, 0), cA + kstep, voffA); PG8_STAGE(PG8_SB(1, 1), cB + hstepB + kstep, voffB);
    PG8_WAIT_V(6); PG8_BAR;
    for (;;) {
        const bool has_next = S.next(ui + 1, nxt);
        const char* nA = has_next ? (const char*)g.A + (size_t)nxt.pm * tstepA + (size_t)nxt.pn * g.a_pn_off * 2 : cA; const char* nB = has_next ? (const char*)g.Bt + (size_t)nxt.pn * tstepB : cB;
        for (int t = 0; t < nt; t += 2) {
            const bool last = (t == nt - 2);
            const char* a1 = cA + (size_t)(t + 1) * kstep;
            const char* a2 = last ? nA : cA + (size_t)(t + 2) * kstep; const char* b2 = last ? nB : cB + (size_t)(t + 2) * kstep;
            const char* a3 = a2 + kstep; const char* b3 = b2 + kstep;
            PG8_LDB(B0, 0, 0); PG8_LDB(B1, 0, 1); PG8_SCHED; PG8_LDA(At, 0, 0); PG8_STAGE(PG8_SA(1, 1), a1 + hstepA, voffA);
            PG8_WAIT_V(8); PG8_WAIT_L(0); PG8_BAR; PG8_MMA(0, 0, At, B0); PG8_MMA(0, 1, At, B1); PG8_BAR; PG8_SCHED;
            PG8_LDA(At, 0, 1); PG8_STAGE(PG8_SB(0, 0), b2, voffB); PG8_STAGE(PG8_SB(0, 1), b2 + hstepB, voffB); PG8_STAGE(PG8_SA(0, 0), a2, voffA);
            PG8_WAIT_V(8); PG8_WAIT_L(0); PG8_BAR; PG8_MMA(1, 0, At, B0); PG8_MMA(1, 1, At, B1); PG8_BAR; PG8_SCHED;
            PG8_LDB(B0, 1, 0); PG8_LDB(B1, 1, 1); PG8_SCHED; PG8_LDA(At, 1, 0); PG8_STAGE(PG8_SA(0, 1), a2 + hstepA, voffA);
            PG8_WAIT_V(8); PG8_WAIT_L(0); PG8_BAR; PG8_MMA(0, 0, At, B0); PG8_MMA(0, 1, At, B1); PG8_BAR; PG8_SCHED;
            PG8_LDA(At, 1, 1); PG8_STAGE(PG8_SB(1, 0), b3, voffB); PG8_STAGE(PG8_SB(1, 1), b3 + hstepB, voffB); PG8_STAGE(PG8_SA(1, 0), a3, voffA);
            PG8_WAIT_V(8); PG8_WAIT_L(0); PG8_BAR; PG8_MMA(1, 0, At, B0); PG8_MMA(1, 1, At, B1); PG8_BAR; PG8_SCHED;
        }
        if (wr == 0) PG8_BAR;
        E(acc, cur, wr, wc, fr, fq);
        if (!has_next) break;
#pragma unroll
        for (int a = 0; a < 2; ++a)
#pragma unroll
            for (int b = 0; b < 2; ++b)
#pragma unroll
                for (int m = 0; m < 4; ++m)
#pragma unroll
                    for (int n = 0; n < 2; ++n) acc[a][b][m][n] = (f32x4){0.f, 0.f, 0.f, 0.f};
        cur = nxt; cA = nA; cB = nB; ++ui;
        if (wr == 1) PG8_BAR;
    }
    PG8_WAIT_V(0);
    PG8_BAR;
#undef PG8_SA
#undef PG8_SB
#undef PG8_STAGE
#undef PG8_LDA
#undef PG8_LDB
#undef PG8_MMA
#undef PG8_WAIT_V
#undef PG8_WAIT_L
#undef PG8_BAR
#undef PG8_SCHED
}

__device__ __forceinline__ unsigned cvt_pk_bf16(float lo, float hi) { unsigned r; asm volatile("v_cvt_pk_bf16_f32 %0, %1, %2" : "=v"(r) : "v"(lo), "v"(hi)); return r; }
struct EpiF32 {
    static constexpr bool PERM = false;
    float* out; int ldc; int rows_valid; const float* bias_a; const float* bias_b; int bias_split;
    __device__ __forceinline__ void operator()(const f32x4 (&acc)[2][2][4][2], const Unit& u, int wr, int wc, int fr, int fq) const {
#pragma unroll
        for (int ai = 0; ai < 2; ++ai)
#pragma unroll
            for (int m = 0; m < 4; ++m) { const int row = u.pm * BM + ai * HALF + wr * 64 + m * 16 + fr;
                if (row < rows_valid) {
#pragma unroll
                    for (int bj = 0; bj < 2; ++bj)
#pragma unroll
                        for (int n = 0; n < 2; ++n) { const int col = u.pn * BM + bj * HALF + wc * 32 + n * 16 + 4 * fq; f32x4 v = acc[ai][bj][m][n];
                            if (bias_a) { const f32x4 b = (col < bias_split) ? *(const f32x4*)(bias_a + col) : *(const f32x4*)(bias_b + (col - bias_split)); v += b; }
                            *(f32x4*)(out + (size_t)row * ldc + col) = v; } } }
    }
};
struct EpiRes {
    static constexpr bool PERM = false;
    const float* in_lo; const float* in_hi; float* out; const float* mods; int gate_off; const float* cscale;
    __device__ __forceinline__ void operator()(const f32x4 (&acc)[2][2][4][2], const Unit& u, int wr, int wc, int fr, int fq) const {
#pragma unroll
        for (int ai = 0; ai < 2; ++ai)
#pragma unroll
            for (int m = 0; m < 4; ++m) { const int row = u.pm * BM + ai * HALF + wr * 64 + m * 16 + fr;
                if (row < MR) { const float* gp = mods + (size_t)bidx_of(row) * NADA + gate_off; const float* ip = row < MP ? in_lo + (size_t)row * D : in_hi + (size_t)(row - MP) * D; float* op = out + (size_t)row * D;
#pragma unroll
                    for (int bj = 0; bj < 2; ++bj)
#pragma unroll
                        for (int n = 0; n < 2; ++n) { const int col = u.pn * BM + bj * HALF + wc * 32 + n * 16 + 4 * fq; f32x4 gt = *(const f32x4*)(gp + col);
                            if (cscale) gt *= *(const f32x4*)(cscale + col);
                            const f32x4 x = *(const f32x4*)(ip + col); *(f32x4*)(op + col) = x + gt * acc[ai][bj][m][n]; } } }
    }
};
__device__ __forceinline__ float silu_f(float x) { return x * __builtin_amdgcn_rcpf(1.f + __builtin_amdgcn_exp2f(-1.4426950408889634f * x)); }
struct EpiSwiglu {
    static constexpr bool PERM = true;
    bf16_t* H; int ldh;
    __device__ __forceinline__ void operator()(const f32x4 (&acc)[2][2][4][2], const Unit& u, int wr, int wc, int fr, int fq) const {
        const int row0 = u.pm * BM + wr * 64 + fr, col0 = u.pn * HALF + wc * 32 + 8 * fq;
#pragma unroll
        for (int ai = 0; ai < 2; ++ai)
#pragma unroll
            for (int m = 0; m < 4; ++m) { bf16_t* rowp = H + (size_t)(row0 + ai * HALF + m * 16) * ldh + col0;
                const f32x4 g0 = acc[ai][0][m][0], g1 = acc[ai][0][m][1], u0 = acc[ai][1][m][0], u1 = acc[ai][1][m][1];
                u32x4 w; w.x = cvt_pk_bf16(silu_f(g0[0]) * u0[0], silu_f(g0[1]) * u0[1]); w.y = cvt_pk_bf16(silu_f(g0[2]) * u0[2], silu_f(g0[3]) * u0[3]);
                w.z = cvt_pk_bf16(silu_f(g1[0]) * u1[0], silu_f(g1[1]) * u1[1]); w.w = cvt_pk_bf16(silu_f(g1[2]) * u1[2], silu_f(g1[3]) * u1[3]);
                *(u32x4*)rowp = w; }
    }
};

__device__ __forceinline__ void head_post(f32x4 (&v)[2][2], const float* gain, const float* ropep, int fq) {
    float ss = 0.f;
#pragma unroll
    for (int bj = 0; bj < 2; ++bj)
#pragma unroll
        for (int n = 0; n < 2; ++n) ss += (v[bj][n].x * v[bj][n].x + v[bj][n].y * v[bj][n].y) + (v[bj][n].z * v[bj][n].z + v[bj][n].w * v[bj][n].w);
    ss += __shfl_xor(ss, 16); ss += __shfl_xor(ss, 32);
    const float rs = rsqrtf(ss * (1.f / 64.f) + EPS);
#pragma unroll
    for (int bj = 0; bj < 2; ++bj)
#pragma unroll
        for (int n = 0; n < 2; ++n) v[bj][n] = v[bj][n] * rs * *(const f32x4*)(gain + 32 * bj + 16 * n + 4 * fq);
    f32x4 o; o.x = __shfl_xor(v[0][0].x, 32); o.y = __shfl_xor(v[0][0].y, 32); o.z = __shfl_xor(v[0][0].z, 32); o.w = __shfl_xor(v[0][0].w, 32);
    const f32x4 c0 = *(const f32x4*)(ropep + 8 * (fq & 1)), c1 = *(const f32x4*)(ropep + 8 * (fq & 1) + 4); const f32x4 cv = {c0.x, c0.z, c1.x, c1.z}, sv = {c0.y, c0.w, c1.y, c1.w};
    v[0][0] = (fq < 2) ? v[0][0] * cv - o * sv : v[0][0] * cv + o * sv;
}
__device__ __forceinline__ unsigned long long pk4e(f32x4 v) { return (unsigned long long)cvt_pk_bf16(v.x, v.y) | ((unsigned long long)cvt_pk_bf16(v.z, v.w) << 32); }
struct EpiKV {
    static constexpr bool PERM = false;
    float* kvo; bf16_t* kvb; bf16_t* winb; float* winp; float* wins; const float* knorm; const float* rope;
    __device__ __forceinline__ void operator()(const f32x4 (&acc)[2][2][4][2], const Unit& u, int wr, int wc, int fr, int fq) const {
        const int slot = u.pn;
#pragma unroll
        for (int ai = 0; ai < 2; ++ai)
#pragma unroll
            for (int m = 0; m < 4; ++m) { const int row = u.pm * BM + ai * HALF + wr * 64 + m * 16 + fr;
                if (row < MR) { const int pos = row < MP ? (row & (SEQ - 1)) : SEQ; f32x4 v[2][2];
#pragma unroll
                    for (int bj = 0; bj < 2; ++bj)
#pragma unroll
                        for (int n = 0; n < 2; ++n) v[bj][n] = acc[ai][bj][m][n];
                    if (slot == 2 || slot == 4) head_post(v, knorm + (slot == 2 ? 64 : 128), rope + (size_t)pos * 16, fq);
                    if (slot < 4) { float* fo = kvo + (size_t)row * 1024 + slot * 256 + wc * 64 + 4 * fq; bf16_t* bo = kvb + (size_t)row * 1024 + slot * 256 + wc * 64 + 4 * fq;
#pragma unroll
                        for (int bj = 0; bj < 2; ++bj)
#pragma unroll
                            for (int n = 0; n < 2; ++n) { *(f32x4*)(fo + 32 * bj + 16 * n) = v[bj][n]; *(unsigned long long*)(bo + 32 * bj + 16 * n) = pk4e(v[bj][n]); } }
                    else { bf16_t* bo = winb + (size_t)row * 512 + (slot - 4) * 256 + wc * 64 + 4 * fq; float* fo = nullptr;
                        if (row < MP) { if (pos >= SEQ - 512) fo = winp + ((size_t)(row >> 13) * 512 + (pos - (SEQ - 512))) * 512; } else fo = wins + ((size_t)(row - MP) * 512 + 511) * 512;
                        if (fo) fo += (slot - 4) * 256 + wc * 64 + 4 * fq;
#pragma unroll
                        for (int bj = 0; bj < 2; ++bj)
#pragma unroll
                            for (int n = 0; n < 2; ++n) { *(unsigned long long*)(bo + 32 * bj + 16 * n) = pk4e(v[bj][n]); if (fo) *(f32x4*)(fo + 32 * bj + 16 * n) = v[bj][n]; } } } }
    }
};
struct EpiQG {
    static constexpr bool PERM = false;
    bf16_t* qb; float* gates; const float* qnorm; const float* rope;
    __device__ __forceinline__ void operator()(const f32x4 (&acc)[2][2][4][2], const Unit& u, int wr, int wc, int fr, int fq) const {
#pragma unroll
        for (int ai = 0; ai < 2; ++ai)
#pragma unroll
            for (int m = 0; m < 4; ++m) { const int row = u.pm * BM + ai * HALF + wr * 64 + m * 16 + fr;
                if (row < MR) {
                    if (u.pn < 4) { const int pos = row < MP ? (row & (SEQ - 1)) : SEQ; f32x4 v[2][2];
#pragma unroll
                        for (int bj = 0; bj < 2; ++bj)
#pragma unroll
                            for (int n = 0; n < 2; ++n) v[bj][n] = acc[ai][bj][m][n];
                        head_post(v, qnorm, rope + (size_t)pos * 16, fq);
                        bf16_t* bo = qb + (size_t)row * D + (4 * u.pn + wc) * 64 + 4 * fq;
#pragma unroll
                        for (int bj = 0; bj < 2; ++bj)
#pragma unroll
                            for (int n = 0; n < 2; ++n) *(unsigned long long*)(bo + 32 * bj + 16 * n) = pk4e(v[bj][n] * C2); }
                    else if (wc < 2) {
#pragma unroll
                        for (int n = 0; n < 2; ++n) if (wc == 0 || n == 0) { const f32x4 a = acc[ai][0][m][n]; f32x4 g;
                            g.x = __builtin_amdgcn_rcpf(1.f + __builtin_amdgcn_exp2f(-1.4426950408889634f * a.x)); g.y = __builtin_amdgcn_rcpf(1.f + __builtin_amdgcn_exp2f(-1.4426950408889634f * a.y));
                            g.z = __builtin_amdgcn_rcpf(1.f + __builtin_amdgcn_exp2f(-1.4426950408889634f * a.z)); g.w = __builtin_amdgcn_rcpf(1.f + __builtin_amdgcn_exp2f(-1.4426950408889634f * a.w));
                            *(f32x4*)(gates + (size_t)row * 48 + 32 * wc + 16 * n + 4 * fq) = g; } } } }
    }
};
}

#define XB_TMO      128
#define XB_XCNT(j)  (256  + 64 * (j))
#define XB_XSUB(j)  (1280 + 64 * (j))
#define XB_XGEN(j)  (2304 + 64 * (j))
#define XB_TOP      3328
#define XB_TOPGEN   3392
#define XCD_BAR_WORDS 3456
#define XB_SPIN_CAP (1u << 18)
__device__ __forceinline__ unsigned xb_ld(unsigned* p)              { return __hip_atomic_load(p, __ATOMIC_RELAXED, __HIP_MEMORY_SCOPE_AGENT); }
__device__ __forceinline__ unsigned xb_add(unsigned* p, unsigned v) { return __hip_atomic_fetch_add(p, v, __ATOMIC_RELAXED, __HIP_MEMORY_SCOPE_AGENT); }
__device__ __forceinline__ unsigned xb_xcc_id() { return (unsigned)__builtin_amdgcn_s_getreg((3 << 11) | 20) & 0xFu; }
#define XB_SPIN(cond, bar) do { unsigned _sp = 0; while (cond) { __builtin_amdgcn_s_sleep(1); \
    if ((++_sp & 255u) == 0u) { if (xb_ld(&(bar)[XB_TMO])) break; if (_sp > XB_SPIN_CAP) { atomicAdd(&(bar)[XB_TMO], 1u); break; } } } } while (0)
struct XcdBarrier { unsigned* bar; unsigned x; volatile LAS unsigned* st; };
__device__ __forceinline__ XcdBarrier xcd_barrier_post(unsigned* bar, volatile LAS unsigned* st) {
    XcdBarrier b; b.bar = bar; b.x = xb_xcc_id(); b.st = st;
    if (threadIdx.x == 0) (void)xb_add(&bar[XB_XCNT(b.x)], 1u);
    return b;
}
__device__ __forceinline__ void xcd_barrier_complete(unsigned* bar, unsigned x, unsigned& nloc, unsigned& nx) {
    const unsigned G = gridDim.x * gridDim.y * gridDim.z;
    unsigned sum, cnt, mine, sp = 0u;
    for (;;) {
        sum = 0u; cnt = 0u; mine = 0u;
#pragma unroll
        for (unsigned j = 0; j < 16; ++j) { const unsigned c = xb_ld(&bar[XB_XCNT(j)]); sum += c; cnt += (c > 0u) ? 1u : 0u; mine = (j == x) ? c : mine; }
        if (sum == G) break;
        __builtin_amdgcn_s_sleep(1);
        if ((++sp & 255u) == 0u) { if (xb_ld(&bar[XB_TMO])) break; if (sp > XB_SPIN_CAP) { atomicAdd(&bar[XB_TMO], 1u); break; } }
    }
    nloc = mine > 0u ? mine : 1u; nx = cnt > 0u ? cnt : 1u;
}
__device__ __forceinline__ void xcd_barrier(const XcdBarrier& b) {
    asm volatile("s_waitcnt vmcnt(0)" ::: "memory");
    __syncthreads();
    if (threadIdx.x == 0) {
        unsigned* bar = b.bar;
        __builtin_amdgcn_s_waitcnt(0);
        unsigned nloc = b.st[0], nx = b.st[1];
        if (nloc == 0u) { xcd_barrier_complete(bar, b.x, nloc, nx); b.st[0] = nloc; b.st[1] = nx; }
        const unsigned old = xb_add(&bar[XB_XSUB(b.x)], 1u);
        const unsigned gen = old / nloc;
        if (old + 1u == (gen + 1u) * nloc) {
            __builtin_amdgcn_fence(__ATOMIC_RELEASE, "agent");
            asm volatile("s_waitcnt vmcnt(0)" ::: "memory");
            const unsigned og = xb_add(&bar[XB_TOP], 1u);
            const unsigned tg = og / nx;
            if (og + 1u == (tg + 1u) * nx) xb_add(&bar[XB_TOPGEN], 1u);
            else XB_SPIN(xb_ld(&bar[XB_TOPGEN]) == tg, bar);
            __builtin_amdgcn_fence(__ATOMIC_ACQUIRE, "agent");
            xb_add(&bar[XB_XGEN(b.x)], 1u);
            asm volatile("s_waitcnt vmcnt(0)" ::: "memory");
        } else {
            XB_SPIN(xb_ld(&bar[XB_XGEN(b.x)]) == gen, bar);
            __builtin_amdgcn_fence(__ATOMIC_ACQUIRE, "agent");
            asm volatile("s_waitcnt vmcnt(0)" ::: "memory");
        }
    }
    __syncthreads();
}

constexpr int RING_BYTES = 131072, MISC_OFF = RING_BYTES + 320, LDS_BYTES = 147456;
struct Args { const void* in[27]; float* out; unsigned char* ws; int ph_lo, ph_hi; };
struct Ctx {
    LAS unsigned char* lds; int tid, lane, wave, vcu, G, gw, NGW;
    float* out; unsigned char* ws;
};

__device__ __forceinline__ Ctx fresh(const Ctx& F) { Ctx C = F; GAS float* go = (GAS float*)F.out; GAS unsigned char* gw_ = (GAS unsigned char*)F.ws;
    asm volatile("" : "+v"(C.tid), "+s"(C.wave), "+s"(C.vcu), "+s"(C.G), "+s"(go), "+s"(gw_)); C.lane = C.tid & 63; C.gw = C.vcu * 8 + C.wave; C.NGW = C.G * 8;
    C.out = (float*)go; C.ws = (unsigned char*)gw_;
    return C; }
__device__ __forceinline__ unsigned char* uni_ptr(const void* p) { const unsigned long long v = (unsigned long long)p; unsigned lo = __builtin_amdgcn_readfirstlane((unsigned)v), hi = __builtin_amdgcn_readfirstlane((unsigned)(v >> 32));
    asm volatile("" : "+s"(lo), "+s"(hi)); return (unsigned char*)(GAS unsigned char*)(((unsigned long long)hi << 32) | lo); }
__device__ __forceinline__ const void* kin(int i) { const char __attribute__((address_space(4)))* kp = (const char __attribute__((address_space(4)))*)__builtin_amdgcn_kernarg_segment_ptr(); asm volatile("" : "+s"(kp));
    const GAS void* p = *(const GAS void* const __attribute__((address_space(4)))*)(kp + 8 * i); return (const void*)p; }
__device__ __forceinline__ void tr_item(const float* W, int N, int K, bf16* WT, int kb, int n0, int drow0, LAS float* scr, int lane) {
    const int k0 = 64 * kb, nn = n0 + (lane & 31); const bool ok = nn < N;
    float tv[32];
#pragma unroll
    for (int i = 0; i < 32; ++i) tv[i] = ok ? W[(size_t)(k0 + 2 * i + (lane >> 5)) * N + nn] : 0.f;
#pragma unroll
    for (int i = 0; i < 32; ++i) scr[(2 * i + (lane >> 5)) * 33 + (lane & 31)] = tv[i];
    LDS_WAIT(); asm volatile("" ::: "memory");
    const int c = lane & 7;
#pragma unroll
    for (int j = 0; j < 4; ++j) { const int n = (lane >> 3) + 8 * j; const LAS float* s = scr + (8 * c) * 33 + n;
        v4u o; o.x = pk2(s[0 * 33], s[1 * 33]); o.y = pk2(s[2 * 33], s[3 * 33]); o.z = pk2(s[4 * 33], s[5 * 33]); o.w = pk2(s[6 * 33], s[7 * 33]);
        *(GAS v4u*)(WT + (size_t)(drow0 + n) * K + k0 + 8 * c) = o; }
    LDS_WAIT(); asm volatile("" ::: "memory");
}
__device__ __forceinline__ void tr_job(const float* W, int N, int K, bf16* WT, int it, int mode, LAS float* scr, int lane) {
    const int nblk = (N + 31) / 32, kb = it / nblk, n0 = 32 * (it % nblk);
    int drow0 = n0;
    if (mode == 1) drow0 = (n0 < DFF) ? 256 * (n0 / 128) + (n0 % 128) : 256 * ((n0 - DFF) / 128) + 128 + ((n0 - DFF) % 128);
    if (mode == 2 && n0 < 6144) drow0 = 256 * (n0 / 256) + 128 * ((n0 % 64) / 32) + 32 * ((n0 % 256) / 64);
    if (mode == 3 && n0 < 1024) drow0 = 256 * (n0 / 256) + 128 * ((n0 % 64) / 32) + 32 * ((n0 % 256) / 64);
    tr_item(W, N, K, WT, kb, n0, drow0, scr, lane);
}
__device__ __forceinline__ void p0_prologue(Ctx& F) {
    LAS float* scr = (LAS float*)(F.lds + F.wave * 16384);
    constexpr int I_ADA = 16 * 96, I_ADAKV = 16 * 64, I_GU = 16 * 176, I_DN = 44 * 32, I_KV = 16 * 48, I_QG = 16 * 34, I_WO = 16 * 32, I_PW = 4 * 8, I_W1 = 64 * 4;
    constexpr int NIT = 8 * I_ADA + I_ADAKV + 4 * I_GU + 4 * I_DN + I_KV + 2 * I_QG + 2 * I_WO + 8 * I_PW + 2 * I_W1;
    for (int it = F.gw; it < NIT; it += F.NGW) {
        int r = it;
        if (r < 8 * I_ADA) { const int s = r / I_ADA; tr_job(((const float*)kin(8)) + (size_t)s * 1024 * 3072, 3072, 1024, ((bf16*)(F.ws + WS_ADAT)) + (size_t)s * 3072 * 1024, r % I_ADA, 0, scr, F.lane); continue; } r -= 8 * I_ADA;
        if (r < I_ADAKV) { tr_job(((const float*)kin(14)), 2048, 1024, ((bf16*)(F.ws + WS_ADAT)) + (size_t)24576 * 1024, r, 0, scr, F.lane); continue; } r -= I_ADAKV;
        if (r < 4 * I_GU) { const int s = r / I_GU; tr_job(((const float*)kin(25)) + (size_t)s * 1024 * NGU, NGU, 1024, ((bf16*)(F.ws + WS_WGU)) + (size_t)s * NGU * 1024, r % I_GU, 1, scr, F.lane); continue; } r -= 4 * I_GU;
        if (r < 4 * I_DN) { const int s = r / I_DN; tr_job(((const float*)kin(26)) + (size_t)s * DFF * 1024, 1024, DFF, ((bf16*)(F.ws + WS_WDN)) + (size_t)s * 1024 * DFF, r % I_DN, 0, scr, F.lane); continue; } r -= 4 * I_DN;
        if (r < I_KV) { tr_job(((const float*)kin(17)), NKV, 1024, ((bf16*)(F.ws + WS_WKV)), r, 2, scr, F.lane); continue; } r -= I_KV;
        if (r < 2 * I_QG) { const int s = r / I_QG; tr_job(((const float*)kin(22)) + (size_t)s * 1024 * NQG, NQG, 1024, ((bf16*)(F.ws + WS_WQG)) + (size_t)s * NQGP * 1024, r % I_QG, 3, scr, F.lane); continue; } r -= 2 * I_QG;
        if (r < 2 * I_WO) { const int s = r / I_WO; tr_job(((const float*)kin(24)) + (size_t)s * 1024 * 1024, 1024, 1024, ((bf16*)(F.ws + WS_WO)) + (size_t)s * 1024 * 1024, r % I_WO, 0, scr, F.lane); continue; } r -= 2 * I_WO;
        if (r < 8 * I_PW) { const int s = r / I_PW; tr_job(((const float*)kin(12)) + (size_t)s * 256 * 256, 256, 256, ((bf16*)(F.ws + WS_POOLW)) + (size_t)s * 256 * 256, r % I_PW, 0, scr, F.lane); continue; } r -= 8 * I_PW;
        { const int s = r / I_W1; tr_job(((const float*)kin(20)) + (size_t)s * 4096 * 128, 128, 4096, ((bf16*)(F.ws + WS_W1T)) + (size_t)s * 128 * 4096, r % I_W1, 0, scr, F.lane); }
    }
    for (int r = F.gw; r < 256; r += F.NGW) {
        const float* src = r < 2 ? ((const float*)kin(6)) + (size_t)r * D : (r < NBATCH ? ((const float*)kin(7)) + (size_t)(r - 2) * D : nullptr);
        unsigned long long* o8 = (unsigned long long*)(((bf16*)(F.ws + WS_CB)) + (size_t)r * D) + F.lane;
#pragma unroll
        for (int j = 0; j < 4; ++j) { f32x4 v = src ? ((const f32x4*)src)[F.lane + 64 * j] : (f32x4){0.f, 0.f, 0.f, 0.f}; o8[64 * j] = (unsigned long long)pk2(v.x, v.y) | ((unsigned long long)pk2(v.z, v.w) << 32); }
    }
    for (int r = F.gw; r < 2 * (NQGP - 1088); r += F.NGW) { const int s = r / (NQGP - 1088), rr = 1088 + r % (NQGP - 1088);
        unsigned long long* o8 = (unsigned long long*)(((bf16*)(F.ws + WS_WQG)) + ((size_t)s * NQGP + rr) * D) + F.lane;
#pragma unroll
        for (int j = 0; j < 4; ++j) o8[64 * j] = 0ull; }
    const int gt = F.gw * 64 + F.lane, NGT = F.NGW * 64;
    for (int e = gt; e < 8193 * 8; e += NGT) { const int pos = e >> 3, i = e & 7;
        const float invs[8] = {1.0f, 0.1939227432012558f, 0.03760603070259094f, 0.007292664609849453f, 0.0014142135623842478f, 0.00027424818836152554f, 5.318296098266728e-05f, 1.0313386155758053e-05f};
        float inv = invs[0];
#pragma unroll
        for (int q = 1; q < 8; ++q) inv = (i == q) ? invs[q] : inv;
        const float ang = (float)pos * inv; const double rev = (double)ang * 0.15915494309189535; const float fr = (float)(rev - floor(rev));
        ((f32x2*)((float*)(F.ws + WS_ROPE)))[e] = (f32x2){__builtin_amdgcn_cosf(fr), __builtin_amdgcn_sinf(fr)}; }
    for (int o = F.gw; o < 256; o += F.NGW) { const int slot = o >> 7, hid = o & 127; float s = 0.f;
        for (int k = F.lane; k < 4096; k += 64) s += ((const float*)kin(19))[slot * 4096 + k] * ((const float*)kin(20))[((size_t)slot * 4096 + k) * 128 + hid];
        s = wave_sum(s); if (F.lane == 0) ((float*)(F.ws + WS_BIASPE))[o] = s; }
    for (int e = gt; e < 32 * 511 * 128; e += NGT) { const int s = e / (511 * 128), r = e % (511 * 128), i = r >> 7, c = r & 127;
        ((f32x4*)(F.out + O_WINS))[((size_t)s * 512 + i) * 128 + c] = ((const f32x4*)((const float*)kin(3)))[((size_t)s * 512 + i + 1) * 128 + c]; }
}

__device__ __forceinline__ const float* xrow(const float* lo, const float* hi, int row) { return row < MP ? lo + (size_t)row * D : hi + (size_t)(row - MP) * D; }
__device__ __forceinline__ void load_row(const float* p, int lane, f32x4 (&v)[4]) {
#pragma unroll
    for (int j = 0; j < 4; ++j) v[j] = ((const f32x4*)p)[lane + 64 * j];
}
__device__ __forceinline__ float row_rstd(const f32x4 (&v)[4]) { float s = 0.f;
#pragma unroll
    for (int j = 0; j < 4; ++j) s += (v[j].x * v[j].x + v[j].y * v[j].y) + (v[j].z * v[j].z + v[j].w * v[j].w);
    return rsqrtf(wave_sum(s) * (1.f / D) + EPS); }
__device__ __forceinline__ void load_mod(const float* mods, int bi, int off, const float* gain, int lane, f32x4 (&A)[4], f32x4 (&S)[4]) {
    const float* mp = mods + (size_t)bi * NADA + off;
#pragma unroll
    for (int j = 0; j < 4; ++j) { const f32x4 g = ((const f32x4*)gain)[lane + 64 * j], sc = ((const f32x4*)(mp + 1024))[lane + 64 * j]; A[j] = g * (sc + 1.f); S[j] = ((const f32x4*)mp)[lane + 64 * j]; }
}
__device__ __forceinline__ void store_row_bf16(bf16* p, int lane, const f32x4 (&v)[4]) {
    unsigned long long* o8 = (unsigned long long*)p + lane;
#pragma unroll
    for (int j = 0; j < 4; ++j) o8[64 * j] = (unsigned long long)pk2(v[j].x, v[j].y) | ((unsigned long long)pk2(v[j].z, v[j].w) << 32);
}
__device__ __forceinline__ void pass_h(Ctx& F, int l, const float* xlo, const float* xhi) {
    const int off = (l * 2 + 0) * 3072; const float* gain = ((const float*)kin(10)) + l * D;
    for (int ch = F.gw; ch < MP / 8; ch += F.NGW) {
        const int b = ch >> 10; f32x4 A[4], S[4]; load_mod(((float*)(F.ws + WS_MODS)), b, off, gain, F.lane, A, S);
        for (int rb = 0; rb < 8; rb += 4) {
            f32x4 v[4][4];
#pragma unroll
            for (int r = 0; r < 4; ++r) load_row(xrow(xlo, xhi, ch * 8 + rb + r), F.lane, v[r]);
#pragma unroll
            for (int r = 0; r < 4; ++r) { const int row = ch * 8 + rb + r, t = row & (SEQ - 1); const float rs = row_rstd(v[r]);
#pragma unroll
                for (int j = 0; j < 4; ++j) { v[r][j] = v[r][j] * rs * A[j] + S[j]; ((f32x4*)(((float*)(F.ws + WS_H0)) + (size_t)row * D))[F.lane + 64 * j] = v[r][j]; }
                if (t >= SEQ - 15) { float* po = F.out + O_POOLP + ((size_t)(l * 2 + b) * 15 + (t - (SEQ - 15))) * D;
#pragma unroll
                    for (int j = 0; j < 4; ++j) ((f32x4*)po)[F.lane + 64 * j] = v[r][j]; } } }
    }
    for (int s = F.gw; s < NBS; s += F.NGW) {
        const int row = MP + s; f32x4 A[4], S[4], v[4]; load_mod(((float*)(F.ws + WS_MODS)), 2 + s, off, gain, F.lane, A, S); load_row(xrow(xlo, xhi, row), F.lane, v); const float rs = row_rstd(v);
        const float* sp = ((const float*)kin(4)) + ((size_t)(l * 32 + s) * 15) * D; float* po = F.out + O_POOLS + ((size_t)(l * 32 + s) * 15) * D; f32x4 pl[4];
#pragma unroll
        for (int j = 0; j < 4; ++j) { v[j] = v[j] * rs * A[j] + S[j]; const int w = 2 << j; f32x4 sum = v[j];
            for (int k = 1; k < w; ++k) sum += ((const f32x4*)(sp + (size_t)(15 - k) * D))[F.lane + 64 * j];
            pl[j] = sum * (1.f / (float)w) - v[j]; ((f32x4*)(po + (size_t)14 * D))[F.lane + 64 * j] = v[j]; }
        store_row_bf16(((bf16*)(F.ws + WS_XN2)) + (size_t)row * D, F.lane, pl);
        for (int i = 0; i < 14; ++i)
#pragma unroll
            for (int j = 0; j < 4; ++j) ((f32x4*)(po + (size_t)i * D))[F.lane + 64 * j] = ((const f32x4*)(sp + (size_t)(i + 1) * D))[F.lane + 64 * j];
    }
}
__device__ __forceinline__ void pass_pool(Ctx& F) {
    for (int ch = F.gw; ch < MP / 8; ch += F.NGW) {
        const int row0 = ch * 8, t0 = row0 & (SEQ - 1); f32x4 Sw[4];
#pragma unroll
        for (int j = 0; j < 4; ++j) { const int w = 2 << j; Sw[j] = (f32x4){0.f, 0.f, 0.f, 0.f};
            for (int k = 1; k < w; ++k) if (t0 - k >= 0) Sw[j] += ((const f32x4*)(((float*)(F.ws + WS_H0)) + (size_t)(row0 - k) * D))[F.lane + 64 * j]; }
        for (int r = 0; r < 8; ++r) { const int row = row0 + r, t = t0 + r; f32x4 h[4], pl[4]; load_row(((float*)(F.ws + WS_H0)) + (size_t)row * D, F.lane, h);
#pragma unroll
            for (int j = 0; j < 4; ++j) { const int w = 2 << j; Sw[j] += h[j]; const int cnt = (t + 1) < w ? (t + 1) : w; pl[j] = Sw[j] * (1.f / (float)cnt) - h[j];
                if (t - w + 1 >= 0) Sw[j] -= ((const f32x4*)(((float*)(F.ws + WS_H0)) + (size_t)(row - w + 1) * D))[F.lane + 64 * j]; }
            store_row_bf16(((bf16*)(F.ws + WS_XN2)) + (size_t)row * D, F.lane, pl); }
    }
}
__device__ __forceinline__ void pass_norm(Ctx& F, const float* xlo, const float* xhi, const float* gain1, int off1, bf16* out1, const float* gain2, int off2, bf16* out2) {
    const float* mods = (const float*)(F.ws + WS_MODS);
    for (int ch = F.gw; ch < (MR + 7) / 8; ch += F.NGW) {
        const int row0 = ch * 8; const bool uni = row0 < MP; f32x4 A1[4], S1[4], A2[4], S2[4];
        if (uni) { load_mod(mods, row0 >> 13, off1, gain1, F.lane, A1, S1); if (out2) load_mod(mods, row0 >> 13, off2, gain2, F.lane, A2, S2); }
        for (int rb = 0; rb < 8; rb += 4) {
            f32x4 v[4][4];
#pragma unroll
            for (int r = 0; r < 4; ++r) { const int row = (row0 + rb + r) < MR ? (row0 + rb + r) : MR - 1; load_row(xrow(xlo, xhi, row), F.lane, v[r]); }
#pragma unroll
            for (int r = 0; r < 4; ++r) { const int row = row0 + rb + r; if (row < MR) {
                if (!uni) { load_mod(mods, bidx_of(row), off1, gain1, F.lane, A1, S1); if (out2) load_mod(mods, bidx_of(row), off2, gain2, F.lane, A2, S2); }
                f32x4 o[4]; const float rs = row_rstd(v[r]);
#pragma unroll
                for (int j = 0; j < 4; ++j) o[j] = v[r][j] * rs * A1[j] + S1[j];
                store_row_bf16(out1 + (size_t)row * D, F.lane, o);
                if (out2) {
#pragma unroll
                    for (int j = 0; j < 4; ++j) o[j] = v[r][j] * rs * A2[j] + S2[j];
                    store_row_bf16(out2 + (size_t)row * D, F.lane, o); } } }
        }
    }
}
__device__ __forceinline__ f32x4 head_norm_rope(f32x4 v, const float* gain  , const float* ropep  , int lane) {
    const int q = lane & 15; float ss = (v.x * v.x + v.y * v.y) + (v.z * v.z + v.w * v.w);
    ss += __shfl_xor(ss, 1); ss += __shfl_xor(ss, 2); ss += __shfl_xor(ss, 4); ss += __shfl_xor(ss, 8);
    v = v * rsqrtf(ss * (1.f / 64.f) + EPS) * *(const f32x4*)(gain + 4 * q);
    f32x4 o; o.x = __shfl_xor(v.x, 2); o.y = __shfl_xor(v.y, 2); o.z = __shfl_xor(v.z, 2); o.w = __shfl_xor(v.w, 2);
    if (q < 4) { const f32x4 c0 = *(const f32x4*)(ropep + 8 * (q & 1)), c1 = *(const f32x4*)(ropep + 8 * (q & 1) + 4); const f32x4 cv = {c0.x, c0.z, c1.x, c1.z}, sv = {c0.y, c0.w, c1.y, c1.w};
        v = (q < 2) ? v * cv - o * sv : v * cv + o * sv; }
    return v;
}
__device__ __forceinline__ unsigned long long pk4(f32x4 v) { return (unsigned long long)pk2(v.x, v.y) | ((unsigned long long)pk2(v.z, v.w) << 32); }
__device__ __forceinline__ void skinny_res(Ctx& F, const bf16* As, int lda, int a_grp_off, const bf16* Bt, int ldb, int K, const float* in_hi, float* out_hi, const float* mods, int gate_off, const float* cscale) {
    if (F.vcu >= 64) return;
    const int lane = F.lane, w = F.wave, n = lane & 15, kq = lane >> 4, c0 = 16 * F.vcu;
    const bf16* ap = As + (size_t)n * lda + (c0 >> 8) * a_grp_off + 8 * kq; const bf16* bp = Bt + (size_t)(c0 + n) * ldb + 8 * kq;
    const int kper = K >> 3; f32x4 acc0 = {0.f, 0.f, 0.f, 0.f}, acc1 = {0.f, 0.f, 0.f, 0.f};
    for (int k = w * kper; k < (w + 1) * kper; k += 32) {
        const bf16x8 a0 = *(const bf16x8*)(ap + k), a1 = *(const bf16x8*)(ap + (size_t)16 * lda + k), bb = *(const bf16x8*)(bp + k);
        acc0 = __builtin_amdgcn_mfma_f32_16x16x32_bf16(a0, bb, acc0, 0, 0, 0); acc1 = __builtin_amdgcn_mfma_f32_16x16x32_bf16(a1, bb, acc1, 0, 0, 0); }
    LAS f32x4* red = (LAS f32x4*)F.lds;
    red[(w * 2 + 0) * 64 + lane] = acc0; red[(w * 2 + 1) * 64 + lane] = acc1;
    __syncthreads();
    if (w < 2) { f32x4 a = red[w * 64 + lane];
#pragma unroll
        for (int ww = 1; ww < 8; ++ww) a += red[(ww * 2 + w) * 64 + lane];
        const int col = c0 + n; const float cs = cscale ? cscale[col] : 1.f;
#pragma unroll
        for (int i = 0; i < 4; ++i) { const int srow = 16 * w + 4 * kq + i; const float gt = mods[(size_t)(2 + srow) * NADA + gate_off + col] * cs;
            out_hi[(size_t)srow * D + col] = in_hi[(size_t)srow * D + col] + gt * a[i]; } }
    __syncthreads();
}

__device__ __forceinline__ float gelu_tanh(float x) { const float u = 0.7978845608028654f * (x + 0.044715f * x * x * x); return x * __builtin_amdgcn_rcpf(1.f + __builtin_amdgcn_exp2f(-2.f * 1.4426950408889634f * u)); }
__device__ __forceinline__ bf16x8 pack8(const f32x4 a, const f32x4 b) { v4u w; w.x = pk2(a.x, a.y); w.y = pk2(a.z, a.w); w.z = pk2(b.x, b.y); w.w = pk2(b.z, b.w); return __builtin_bit_cast(bf16x8, w); }
__device__ __forceinline__ void compress_phase(Ctx& F) {
    const int lane = F.lane, wid = F.wave, tid = F.tid, n = lane & 15, kq = lane >> 4;
    const int nper = (NBLKT + F.G - 1) / F.G, c0 = F.vcu * nper; int n_cu = NBLKT - c0; n_cu = n_cu < 0 ? 0 : (n_cu > nper ? nper : n_cu);
    if (nper > 32) return;
    const int nbw = (nper + 7) / 8, bw0 = wid * nbw; int nb_w = n_cu - bw0; nb_w = nb_w < 0 ? 0 : (nb_w > nbw ? nbw : nb_w);
    const int bl = n >> 2, kvh = n & 3; const bool vcol = bl < nb_w;
    int gblk = c0 + bw0 + (vcol ? bl : 0); gblk = gblk < NBLKT ? gblk : NBLKT - 1;
    const int bb = gblk >> 7, blk = gblk & 127;
    const float* base = bb < 2 ? F.out + O_KV + ((size_t)(bb * SEQ + blk * 64)) * 1024 : ((const float*)kin(2)) + ((size_t)((const int*)kin(5))[(bb - 2) * 64 + (blk >> 1)] * 128 + (blk & 1) * 64) * 1024;
    const float* lp = base + kvh * 64 + 8 * kq;
    unsigned soff[2];
#pragma unroll
    for (int i = 0; i < 2; ++i) { int R, C; pg8::stage_rc(tid * 16 + i * 8192, R, C); soff[i] = (unsigned)(R * 4096 + C) * 2u; }
    const int foff = pg8::lds_byte(n, kq * 8);
    LAS unsigned char* lds = F.lds;
#define CSTAGE(buf, s) do { _Pragma("unroll") for (int sl = 0; sl < 2; ++sl) _Pragma("unroll") for (int _i = 0; _i < 2; ++_i) \
        __builtin_amdgcn_global_load_lds((const unsigned*)((const char*)(((bf16*)(F.ws + WS_W1T)) + (size_t)sl * 128 * 4096 + (size_t)(s) * 64) + soff[_i]), (LAS unsigned*)(lds + ((buf) * 2 + sl) * 16384 + wid * 1024 + _i * 8192), 16, 0, 0); } while (0)
    f32x4 acc[2][8];
#pragma unroll
    for (int sl = 0; sl < 2; ++sl)
#pragma unroll
        for (int mt = 0; mt < 8; ++mt) acc[sl][mt] = (f32x4){0.f, 0.f, 0.f, 0.f};
    f32x4 raw[2][2][2];
#define CLOAD(s) do { _Pragma("unroll") for (int sl = 0; sl < 2; ++sl) _Pragma("unroll") for (int e = 0; e < 2; ++e) { const float* p_ = lp + (size_t)(s) * 1024 + sl * 256 + 32 * e; raw[sl][e][0] = *(const f32x4*)p_; raw[sl][e][1] = *(const f32x4*)(p_ + 4); } } while (0)
    __syncthreads();
    CSTAGE(0, 0); CLOAD(0);
    VM_WAIT(); __syncthreads();
    for (int s = 0; s < 64; ++s) {
        const int buf = s & 1; bf16x8 bfr[2][2];
#pragma unroll
        for (int sl = 0; sl < 2; ++sl)
#pragma unroll
            for (int e = 0; e < 2; ++e) bfr[sl][e] = pack8(raw[sl][e][0], raw[sl][e][1]);
        if (s + 1 < 64) { CSTAGE(buf ^ 1, s + 1); CLOAD(s + 1); }
#pragma unroll
        for (int sl = 0; sl < 2; ++sl)
#pragma unroll
            for (int e = 0; e < 2; ++e) { bf16x8 af[8];
#pragma unroll
                for (int mt = 0; mt < 8; ++mt) af[mt] = *(const LAS bf16x8*)(lds + (buf * 2 + sl) * 16384 + foff + mt * 2048 + e * 1024);
#pragma unroll
                for (int mt = 0; mt < 8; ++mt) acc[sl][mt] = __builtin_amdgcn_mfma_f32_16x16x32_bf16(af[mt], bfr[sl][e], acc[sl][mt], 0, 0, 0);
                __builtin_amdgcn_sched_barrier(0); }
        VM_WAIT(); __syncthreads();
    }
#undef CSTAGE
#undef CLOAD
#pragma unroll
    for (int sl = 0; sl < 2; ++sl) {
        bf16x8 hb[4];
#pragma unroll
        for (int e2 = 0; e2 < 4; ++e2) { f32x4 a = acc[sl][2 * e2] + *(const f32x4*)(((float*)(F.ws + WS_BIASPE)) + sl * 128 + 32 * e2 + 4 * kq), b = acc[sl][2 * e2 + 1] + *(const f32x4*)(((float*)(F.ws + WS_BIASPE)) + sl * 128 + 32 * e2 + 16 + 4 * kq);
            a = (f32x4){gelu_tanh(a.x), gelu_tanh(a.y), gelu_tanh(a.z), gelu_tanh(a.w)}; b = (f32x4){gelu_tanh(b.x), gelu_tanh(b.y), gelu_tanh(b.z), gelu_tanh(b.w)}; hb[e2] = pack8(a, b); }
        f32x4 o[4];
        const float* w2b = ((const float*)kin(21)) + (size_t)sl * 128 * 64 + n;
#pragma unroll
        for (int mt2 = 0; mt2 < 4; ++mt2) { o[mt2] = (f32x4){0.f, 0.f, 0.f, 0.f};
#pragma unroll
            for (int e2 = 0; e2 < 4; ++e2) { const float* w2 = w2b + 16 * mt2; float wv[8];
#pragma unroll
                for (int jj = 0; jj < 8; ++jj) wv[jj] = w2[(size_t)(32 * e2 + 16 * (jj >> 2) + 4 * kq + (jj & 3)) * 64];
                const bf16x8 a = pack8((f32x4){wv[0], wv[1], wv[2], wv[3]}, (f32x4){wv[4], wv[5], wv[6], wv[7]});
                o[mt2] = __builtin_amdgcn_mfma_f32_16x16x32_bf16(a, hb[e2], o[mt2], 0, 0, 0); __builtin_amdgcn_sched_barrier(0); } }
        if (sl == 0) {
            float ss = 0.f;
#pragma unroll
            for (int mt2 = 0; mt2 < 4; ++mt2) ss += (o[mt2].x * o[mt2].x + o[mt2].y * o[mt2].y) + (o[mt2].z * o[mt2].z + o[mt2].w * o[mt2].w);
            ss += __shfl_xor(ss, 16); ss += __shfl_xor(ss, 32);
            const float rs = rsqrtf(ss * (1.f / 64.f) + EPS);
#pragma unroll
            for (int mt2 = 0; mt2 < 4; ++mt2) o[mt2] = o[mt2] * rs * *(const f32x4*)(((const float*)kin(18)) + 16 * mt2 + 4 * kq);
            const int pos = (blk + 1) * 64 - 1; const float* rp = ((float*)(F.ws + WS_ROPE)) + (size_t)pos * 16 + (4 * (kq & 1)) * 2;
            f32x4 other; other.x = __shfl_xor(o[0].x, 32); other.y = __shfl_xor(o[0].y, 32); other.z = __shfl_xor(o[0].z, 32); other.w = __shfl_xor(o[0].w, 32);
            const f32x4 cs0 = *(const f32x4*)rp, cs1 = *(const f32x4*)(rp + 4); const f32x4 cv = {cs0.x, cs0.z, cs1.x, cs1.z}, sv = {cs0.y, cs0.w, cs1.y, cs1.w};
            o[0] = (kq < 2) ? o[0] * cv - other * sv : o[0] * cv + other * sv;
        }
        if (vcol) { float* dst = (sl == 0 ? ((float*)(F.ws + WS_KC)) : ((float*)(F.ws + WS_VC))) + ((size_t)(bb * NBLK + blk) * 4 + kvh) * 64 + 4 * kq;
#pragma unroll
            for (int mt2 = 0; mt2 < 4; ++mt2) *(f32x4*)(dst + 16 * mt2) = o[mt2]; }
    }
    __syncthreads();
}

struct Soft { float m[4], l[4], o[4]; };
__device__ __forceinline__ void soft_init(Soft& s) {
#pragma unroll
    for (int g = 0; g < 4; ++g) { s.m[g] = -1e30f; s.l[g] = 0.f; s.o[g] = 0.f; } }
template <class KF, class VF>
__device__ __forceinline__ void attn_block64(LAS float* qs, LAS float* ps, bool valid, KF kf, VF vf, Soft& st, float (&sc)[4], int lane) {
#pragma unroll
    for (int g = 0; g < 4; ++g) sc[g] = 0.f;
#pragma unroll
    for (int d8 = 0; d8 < 8; ++d8) { float kv[8]; kf(d8, kv);
#pragma unroll
        for (int g = 0; g < 4; ++g) { const f32x4 q0 = *(const LAS f32x4*)(qs + g * 64 + d8 * 8), q1 = *(const LAS f32x4*)(qs + g * 64 + d8 * 8 + 4);
            sc[g] += (q0.x * kv[0] + q0.y * kv[1]) + (q0.z * kv[2] + q0.w * kv[3]) + (q1.x * kv[4] + q1.y * kv[5]) + (q1.z * kv[6] + q1.w * kv[7]); } }
    f32x4 pv;
#pragma unroll
    for (int g = 0; g < 4; ++g) { const float sg = valid ? sc[g] : -1e30f; const float mn = fmaxf(st.m[g], wave_max(sg));
        const float p = valid ? __builtin_amdgcn_exp2f(sg - mn) : 0.f; const float corr = __builtin_amdgcn_exp2f(st.m[g] - mn);
        st.l[g] = st.l[g] * corr + wave_sum(p); st.o[g] *= corr; st.m[g] = mn; pv[g] = p; }
    *(LAS f32x4*)(ps + lane * 4) = pv;
    LDS_WAIT(); asm volatile("" ::: "memory");
#pragma unroll 16
    for (int key = 0; key < 64; ++key) { const f32x4 pp = *(const LAS f32x4*)(ps + key * 4); const float v = vf(key);
        st.o[0] += pp.x * v; st.o[1] += pp.y * v; st.o[2] += pp.z * v; st.o[3] += pp.w * v; }
    LDS_WAIT(); asm volatile("" ::: "memory");
}
__device__ __forceinline__ void ld8_bf16(const bf16* p, float (&kv)[8]) { const v4u w = *(const v4u*)p;
    kv[0] = __builtin_bit_cast(float, w.x << 16); kv[1] = __builtin_bit_cast(float, w.x & 0xffff0000u); kv[2] = __builtin_bit_cast(float, w.y << 16); kv[3] = __builtin_bit_cast(float, w.y & 0xffff0000u);
    kv[4] = __builtin_bit_cast(float, w.z << 16); kv[5] = __builtin_bit_cast(float, w.z & 0xffff0000u); kv[6] = __builtin_bit_cast(float, w.w << 16); kv[7] = __builtin_bit_cast(float, w.w & 0xffff0000u); }
__device__ __forceinline__ void ld8_f32(const float* p, float (&kv)[8]) { const f32x4 a = *(const f32x4*)p, b = *(const f32x4*)(p + 4); kv[0] = a.x; kv[1] = a.y; kv[2] = a.z; kv[3] = a.w; kv[4] = b.x; kv[5] = b.y; kv[6] = b.z; kv[7] = b.w; }

__device__ __forceinline__ void cmp_and_select(Ctx& F, LAS float* qs, LAS float* ps, int bb, int kvh, int t, float (&oc)[4], unsigned long long& msk0, unsigned long long& msk1) {
    const int lane = F.lane, cur = t >> 6; Soft st; soft_init(st); float sc0[4], sc1[4];
    const float* kcb = ((float*)(F.ws + WS_KC)) + ((size_t)bb * NBLK * 4 + kvh) * 64; const float* vcb = ((float*)(F.ws + WS_VC)) + ((size_t)bb * NBLK * 4 + kvh) * 64;
    const bool v0 = (lane + 1) * 64 - 1 <= t, v1 = (lane + 65) * 64 - 1 <= t;
    attn_block64(qs, ps, v0, [&](int d8, float (&kv)[8]) { ld8_f32(kcb + (size_t)lane * 256 + d8 * 8, kv); }, [&](int key) { return vcb[(size_t)key * 256 + lane]; }, st, sc0, lane);
    attn_block64(qs, ps, v1, [&](int d8, float (&kv)[8]) { ld8_f32(kcb + (size_t)(64 + lane) * 256 + d8 * 8, kv); }, [&](int key) { return vcb[(size_t)(64 + key) * 256 + lane]; }, st, sc1, lane);
    float imp0 = 0.f, imp1 = 0.f;
#pragma unroll
    for (int g = 0; g < 4; ++g) { const float il = st.l[g] > 0.f ? 1.f / st.l[g] : 0.f; oc[g] = st.o[g] * il;
        imp0 += v0 ? __builtin_amdgcn_exp2f(sc0[g] - st.m[g]) * il : 0.f; imp1 += v1 ? __builtin_amdgcn_exp2f(sc1[g] - st.m[g]) * il : 0.f; }
    bool s0, s1;
    if (cur <= 15) { s0 = lane <= cur; s1 = false; }
    else {
        const int b0 = lane, b1 = lane + 64; const bool c0 = b0 >= 1 && b0 <= cur - 2, c1 = b1 >= 1 && b1 <= cur - 2;
        const float x0 = c0 ? imp0 : -1.f, x1 = c1 ? imp1 : -1.f; int r0 = 0, r1 = 0;
        for (int k = 0; k < 64; ++k) { const float y0 = __shfl(x0, k), y1 = __shfl(x1, k);
            r0 += (y0 > x0 || (y0 == x0 && k < b0)) ? 1 : 0; r0 += (y1 > x0 || (y1 == x0 && (k + 64) < b0)) ? 1 : 0;
            r1 += (y0 > x1 || (y0 == x1 && k < b1)) ? 1 : 0; r1 += (y1 > x1 || (y1 == x1 && (k + 64) < b1)) ? 1 : 0; }
        s0 = (b0 == 0) || (b0 == cur) || (b0 == cur - 1) || (c0 && r0 < 13); s1 = (b1 == cur) || (b1 == cur - 1) || (c1 && r1 < 13);
    }
    msk0 = __ballot(s0); msk1 = __ballot(s1);
}
__device__ __forceinline__ void attn_sample_wg(Ctx& F) {
    const int lane = F.lane, w = F.wave;
    LAS float* qs = (LAS float*)F.lds;
    LAS float* ps = (LAS float*)(F.lds + 1024 + w * 1024);
    LAS unsigned* msk = (LAS unsigned*)(F.lds + 16384);
    LAS float* ocs = (LAS float*)(F.lds + 16384 + 64);
    LAS float* part = (LAS float*)(F.lds + 20480);
    const float* cache = (const float*)kin(2); const int* ptab = (const int*)kin(5);
    for (int task = F.vcu; task < NBS * 4; task += F.G) {
        const int s = task >> 2, kvh = task & 3, row = MP + s, t = SEQ;
        if (w == 0) {
#pragma unroll
            for (int g = 0; g < 4; ++g) qs[g * 64 + lane] = bf2f(((const bf16*)(F.ws + WS_QB))[(size_t)row * D + (kvh * 4 + g) * 64 + lane]);
        }
        __syncthreads();
        if (w == 0) { float oc[4]; unsigned long long m0, m1; cmp_and_select(F, qs, ps, 2 + s, kvh, t, oc, m0, m1);
#pragma unroll
            for (int g = 0; g < 4; ++g) ocs[g * 64 + lane] = oc[g];
            if (lane == 0) { msk[0] = (unsigned)m0; msk[1] = (unsigned)(m0 >> 32); msk[2] = (unsigned)m1; msk[3] = (unsigned)(m1 >> 32); } }
        __syncthreads();
        Soft ss, sw; soft_init(ss); soft_init(sw); float scd[4];
        { int cnt = 0;
            for (int wd = 0; wd < 4; ++wd) { unsigned mm = (unsigned)__builtin_amdgcn_readfirstlane((int)msk[wd]);
                while (mm) { const int j = __builtin_ctz(mm) + 32 * wd; mm &= mm - 1; const bool mine = (cnt & 7) == w; ++cnt; if (!mine) continue;
                    const float* pg = cache + ((size_t)ptab[s * 64 + (j >> 1)] * 128 + (j & 1) * 64) * 1024;
                    const float* kb = pg + (size_t)lane * 1024 + 512 + kvh * 64; const float* vb = pg + 768 + kvh * 64 + lane;
                    attn_block64(qs, ps, true, [&](int d8, float (&kv)[8]) { ld8_f32(kb + d8 * 8, kv); }, [&](int key) { return vb[(size_t)key * 1024]; }, ss, scd, lane); } }
            if ((cnt & 7) == w) { const float* nr = F.out + O_KV + (size_t)row * 1024;
                attn_block64(qs, ps, lane == 0, [&](int d8, float (&kv)[8]) { ld8_f32(nr + 512 + kvh * 64 + d8 * 8, kv); }, [&](int) { return nr[768 + kvh * 64 + lane]; }, ss, scd, lane); }
            ++cnt;
            const float* wb = F.out + O_WINS + (size_t)s * 512 * 512;
            for (int c = 0; c < 8; ++c, ++cnt) if ((cnt & 7) == w) { const float* kb = wb + (size_t)(64 * c + lane) * 512 + kvh * 64; const float* vb = wb + (size_t)(64 * c) * 512 + 256 + kvh * 64 + lane;
                attn_block64(qs, ps, true, [&](int d8, float (&kv)[8]) { ld8_f32(kb + d8 * 8, kv); }, [&](int key) { return vb[(size_t)key * 512]; }, sw, scd, lane); } }
#pragma unroll
        for (int g = 0; g < 4; ++g) { LAS float* p0 = part + ((w * 2 + 0) * 4 + g) * 66; LAS float* p1 = part + ((w * 2 + 1) * 4 + g) * 66;
            if (lane == 0) { p0[0] = ss.m[g]; p0[1] = ss.l[g]; p1[0] = sw.m[g]; p1[1] = sw.l[g]; } p0[2 + lane] = ss.o[g]; p1[2 + lane] = sw.o[g]; }
        __syncthreads();
        if (w < 4) { const int g = w; float res[2];
#pragma unroll
            for (int kd = 0; kd < 2; ++kd) { float M = -1e30f;
#pragma unroll
                for (int ww = 0; ww < 8; ++ww) M = fmaxf(M, part[((ww * 2 + kd) * 4 + g) * 66]);
                float L = 0.f, O = 0.f;
#pragma unroll
                for (int ww = 0; ww < 8; ++ww) { const LAS float* pp = part + ((ww * 2 + kd) * 4 + g) * 66; const float f = __builtin_amdgcn_exp2f(pp[0] - M); L += pp[1] * f; O += pp[2 + lane] * f; }
                res[kd] = L > 0.f ? O / L : 0.f; }
            const float* gt = (const float*)(F.ws + WS_GATES) + (size_t)row * 48 + (kvh * 4 + g) * 3;
            ((bf16*)(F.ws + WS_OB))[(size_t)row * D + (kvh * 4 + g) * 64 + lane] = (bf16)f2bf(gt[0] * ocs[g * 64 + lane] + gt[1] * res[0] + gt[2] * res[1]); }
        __syncthreads();
    }
}

namespace attn_body {
using bf16=__hip_bfloat16;
using bf16x8=__attribute__((ext_vector_type(8)))short;
using s16x4=__attribute__((ext_vector_type(4)))short;
using f32x16=__attribute__((ext_vector_type(16)))float;
using u32x4=__attribute__((ext_vector_type(4)))unsigned;
constexpr int BATCH=2,NHEAD=16,SEQ=8192,D=64,DM=NHEAD*D;
constexpr int NW=8,QBLK=32,QB=QBLK*NW,KVBLK=64,NQB=SEQ/QB;
constexpr int ATTN_PITCH=DM, ATTN_UNIT_ROWS=QB;
__device__ __forceinline__ int crow(int r,int hi){return (r&3)+8*(r>>2)+4*hi;}
#define SBAR() __builtin_amdgcn_sched_barrier(0)
__device__ __forceinline__ void cmask(f32x16&p0,f32x16&p1,int jb,int qrel,int hi){
  const float NEG=-INFINITY; int kb=64*jb+4*hi;
  #pragma unroll
  for(int r=0;r<16;++r){int kv=kb+(r&3)+8*(r>>2); if(kv>qrel)p0[r]=NEG; if(kv+32>qrel)p1[r]=NEG;}
}

__device__ __forceinline__ void lmask(f32x16&p0,f32x16&p1,int k,int qrel,int hi){
  const float NEG=-INFINITY; int kb=64*k+4*hi;
  #pragma unroll
  for(int r=0;r<16;++r){int kv=kb+(r&3)+8*(r>>2); if(kv<=qrel)p0[r]=NEG; if(kv+32<=qrel)p1[r]=NEG;}
}
constexpr int NSLOT=3, SLOTB=8192;
constexpr int LDS_K=0, LDS_V=NSLOT*SLOTB, LDS_WS=2*NSLOT*SLOTB, LDS_OST=LDS_WS+NW*64*4, LDS_BYTES=LDS_OST+NW*4096;
constexpr float C2=0.125f*1.4426950408889634f;
__device__ __forceinline__ void glds16(const void*gsrc,unsigned lds_dst){unsigned keep;
  asm volatile("s_mov_b32 %0, m0\n\ts_mov_b32 m0, %2\n\ts_nop 0\n\tglobal_load_lds_dwordx4 %1, off\n\ts_mov_b32 m0, %0":"=&s"(keep):"v"(gsrc),"s"(lds_dst):"memory");}
__device__ __forceinline__ float max3f(float a,float b,float c){float r;asm("v_max3_f32 %0, %1, %2, %3":"=v"(r):"v"(a),"v"(b),"v"(c));return r;}
__device__ __forceinline__ float max2f(float a,float b){float r;asm("v_max_f32_e32 %0, %1, %2":"=v"(r):"v"(a),"v"(b));return r;}
__device__ __forceinline__ float fadd_s(float a,float b){float r;asm("v_add_f32_e32 %0, %1, %2":"=v"(r):"v"(a),"v"(b));return r;}
__device__ __forceinline__ float fsub_s(float a,float b){float r;asm("v_sub_f32_e32 %0, %1, %2":"=v"(r):"v"(a),"v"(b));return r;}
typedef float f32x2_t __attribute__((ext_vector_type(2))); typedef __bf16 bf16x2_t __attribute__((ext_vector_type(2)));
__device__ __forceinline__ unsigned cvtpk_s(float lo,float hi){f32x2_t v={lo,hi};bf16x2_t b=__builtin_convertvector(v,bf16x2_t);return __builtin_bit_cast(unsigned,b);}
#define WAIT_BAR(N) asm volatile("s_waitcnt vmcnt(" #N ") lgkmcnt(0)\n\ts_barrier":::"memory")

__device__ __forceinline__ void qkt(f32x16&p0,f32x16&p1,const char*Kslot,const bf16x8*qr,const f32x16&negm,int r32,int hi){
  const char*kb=Kslot+hi*1024+r32*16;
  #pragma unroll
  for(int d0=0;d0<4;++d0){
    const bf16x8 b0=*reinterpret_cast<const bf16x8*>(kb+d0*2048);
    const bf16x8 b1=*reinterpret_cast<const bf16x8*>(kb+d0*2048+512);
    if(d0==0){p0=__builtin_amdgcn_mfma_f32_32x32x16_bf16(b0,qr[0],negm,0,0,0);p1=__builtin_amdgcn_mfma_f32_32x32x16_bf16(b1,qr[0],negm,0,0,0);}
    else{p0=__builtin_amdgcn_mfma_f32_32x32x16_bf16(b0,qr[d0],p0,0,0,0);p1=__builtin_amdgcn_mfma_f32_32x32x16_bf16(b1,qr[d0],p1,0,0,0);}}
}
typedef __attribute__((address_space(3))) const char* lds_cptr;
typedef short v4i16_t __attribute__((ext_vector_type(4)));
__device__ __forceinline__ void kload8(bf16x8*kf,lds_cptr kp){
  kf[0]=*(const __attribute__((address_space(3))) bf16x8*)(kp);      kf[1]=*(const __attribute__((address_space(3))) bf16x8*)(kp+512);
  kf[2]=*(const __attribute__((address_space(3))) bf16x8*)(kp+2048); kf[3]=*(const __attribute__((address_space(3))) bf16x8*)(kp+2560);
  kf[4]=*(const __attribute__((address_space(3))) bf16x8*)(kp+4096); kf[5]=*(const __attribute__((address_space(3))) bf16x8*)(kp+4608);
  kf[6]=*(const __attribute__((address_space(3))) bf16x8*)(kp+6144); kf[7]=*(const __attribute__((address_space(3))) bf16x8*)(kp+6656);
}
__device__ __forceinline__ void kload2(bf16x8*kf,lds_cptr kp,int j){ kf[2*j]=*(const __attribute__((address_space(3))) bf16x8*)(kp+j*2048); kf[2*j+1]=*(const __attribute__((address_space(3))) bf16x8*)(kp+j*2048+512); }
__device__ __forceinline__ s16x4 vtr(lds_cptr p){ return __builtin_bit_cast(s16x4,__builtin_amdgcn_ds_read_tr16_b64_v4i16((__attribute__((address_space(3))) v4i16_t*)p)); }
__device__ __forceinline__ float rowmax(const f32x16&p0,const f32x16&p1){
  float a=max3f(p0[0],p0[1],p1[0]),b=max3f(p0[2],p0[3],p1[1]);a=max3f(a,p1[2],p1[3]);
  #pragma unroll
  for(int r=4;r<16;r+=4){a=max3f(a,p0[r],p0[r+1]);b=max3f(b,p0[r+2],p0[r+3]);a=max3f(a,p1[r],p1[r+1]);b=max3f(b,p1[r+2],p1[r+3]);}
  const float m=max2f(a,b);
  auto rr=__builtin_amdgcn_permlane32_swap(__float_as_uint(m),__float_as_uint(m),false,false);
  return max2f(__uint_as_float(rr[0]),__uint_as_float(rr[1]));
}
__device__ __forceinline__ void pv(f32x16*o,int vb,bf16x8 pa0,bf16x8 pa1,bf16x8 pa2,bf16x8 pa3){
  #pragma unroll
  for(int d0=0;d0<2;++d0){s16x4 lo[4],hi[4];
    #pragma unroll
    for(int ks=0;ks<4;++ks){
      asm volatile("ds_read_b64_tr_b16 %0,%1 offset:%c2":"=&v"(lo[ks]):"v"(vb),"i"(d0*4096+ks*1024):"memory");
      asm volatile("ds_read_b64_tr_b16 %0,%1 offset:%c2":"=&v"(hi[ks]):"v"(vb),"i"(d0*4096+ks*1024+512):"memory");}
    asm volatile("s_waitcnt lgkmcnt(0)":::"memory");SBAR();
    #define PK(k) (bf16x8){lo[k][0],lo[k][1],lo[k][2],lo[k][3],hi[k][0],hi[k][1],hi[k][2],hi[k][3]}
    o[d0]=__builtin_amdgcn_mfma_f32_32x32x16_bf16(pa0,PK(0),o[d0],0,0,0);
    o[d0]=__builtin_amdgcn_mfma_f32_32x32x16_bf16(pa1,PK(1),o[d0],0,0,0);
    o[d0]=__builtin_amdgcn_mfma_f32_32x32x16_bf16(pa2,PK(2),o[d0],0,0,0);
    o[d0]=__builtin_amdgcn_mfma_f32_32x32x16_bf16(pa3,PK(3),o[d0],0,0,0);
    #undef PK
  }
}

#ifndef ATTN_STORE16
#define ATTN_STORE16(p,v) (*(u32x4*)(p)=(v))
#endif
template<int THRL,int MODE,int KVP> __device__ __forceinline__ void attn_unit(int b,int h,int qb,const bf16*Q,const bf16*__restrict__ K,const bf16*__restrict__ V,bf16*O,char*shm,const u32x4*SELM,const float*GATES){
  int tid=threadIdx.x; asm volatile("":"+v"(tid));
  const int lane=tid&63,r32=lane&31,hi=lane>>5; const int wid=__builtin_amdgcn_readfirstlane(tid>>6);
  const long rowbase=(long)b*SEQ; const int q0=qb*QB;
  const bf16*Qw=Q+(rowbase+q0+wid*QBLK)*DM+h*D;
  const int kvh=h>>2; const bool LOWER=(MODE==1)&&(qb>=2); const int T0=LOWER?4*qb-8:0;
  const bf16*Kh=K+(rowbase+(long)T0*KVBLK)*KVP+kvh*D,*Vh=V+(rowbase+(long)T0*KVBLK)*KVP+kvh*D;
  const unsigned lds0=(unsigned)(uintptr_t)shm;
  float*wsf=(float*)(shm+LDS_WS)+wid*64;
  const bf16*ksrc=Kh+(long)lane*KVP+wid*8;
  const bf16*vsrc=Vh+(long)(16*(wid&3)+(lane>>2))*KVP+(wid>>2)*32+(lane&3)*8;
  const unsigned kdst=lds0+LDS_K+wid*1024, vdst=lds0+LDS_V+wid*1024;
  #define DMA_K(t,slot) glds16(ksrc+(long)(t)*KVBLK*KVP,(unsigned)__builtin_amdgcn_readfirstlane(kdst+(slot)))
  #define DMA_V(t,slot) glds16(vsrc+(long)(t)*KVBLK*KVP,(unsigned)__builtin_amdgcn_readfirstlane(vdst+(slot)))
  const int vb0=(int)(lds0+LDS_V)+((lane>>4)&1)*32+(lane&3)*8+(4*hi+((lane&15)>>2))*64;
  const char*Kbase=shm+LDS_K; bf16x8 kf[8];
  const lds_cptr shm3=(lds_cptr)shm; const lds_cptr kp0=shm3+LDS_K+hi*1024+r32*16; const lds_cptr vp0=shm3+LDS_V+((lane>>4)&1)*32+(lane&3)*8+(4*hi+((lane&15)>>2))*64;
  const int NT=(q0+QB)/KVBLK-T0;
  DMA_K(0,0);DMA_V(0,0);DMA_K(1,SLOTB);
  bf16x8 qr[4];
  #pragma unroll
  for(int d0=0;d0<4;++d0)qr[d0]=*reinterpret_cast<const bf16x8*>(&Qw[(long)r32*DM+d0*16+hi*8]);
  float zf_=0.f; asm volatile("":"+v"(zf_));
  float mhat=0.f,l_reg=0.f;f32x16 o[2],negm;
  #pragma unroll
  for(int r=0;r<16;++r){o[0][r]=zf_;o[1][r]=zf_;negm[r]=zf_;}
  asm volatile("":"+v"(negm));
  const int qrel=wid*QBLK+r32;
  u32x4 sm=(u32x4){0u,0u,0u,0u}; unsigned selw=0xffffffffu; if(MODE==0){ sm=SELM[(long)(b*4+kvh)*SEQ+q0+wid*QBLK+r32]; }
  #define SELSTEP() do{ if(MODE==0){ selw=0u-(sm.x&1u); sm.x=__builtin_amdgcn_alignbit(sm.y,sm.x,1); sm.y=__builtin_amdgcn_alignbit(sm.z,sm.y,1); sm.z=__builtin_amdgcn_alignbit(sm.w,sm.z,1); sm.w>>=1; } }while(0)
  #define CMASK(P0,P1,t) do{int jb_=(t)-(NT-4); if(jb_>=0)cmask(P0,P1,jb_,qrel,hi);}while(0)
  bool resc=false;
  #define START(P0,P1) do{ const float rm=max2f(rowmax(P0,P1),-64.f); resc=false; \
    { const float dl=rm; mhat=fadd_s(mhat,dl); \
      _Pragma("unroll") for(int r=0;r<16;++r){P0[r]=fsub_s(P0[r],dl);P1[r]=fsub_s(P1[r],dl);} \
      _Pragma("unroll") for(int r=0;r<16;++r)negm[r]=-mhat; asm volatile("":"+v"(negm)); } \
    _Pragma("unroll") for(int r=0;r<16;++r)P0[r]=__builtin_amdgcn_exp2f(P0[r]); }while(0)
  #define RESC() do{ if(resc){ asm volatile("s_waitcnt lgkmcnt(0)":::"memory"); \
      _Pragma("unroll") for(int d_=0;d_<2;++d_) _Pragma("unroll") for(int r=0;r<16;++r)o[d_][r]*=wsf[crow(r,hi)]; } }while(0)
  f32x16 pA0,pA1,pB0,pB1;
  int sl_prev=0,sl_cur=0,sl_next=SLOTB;
  #define ROT() do{sl_prev=sl_cur;sl_cur=sl_next;sl_next=(sl_next==(NSLOT-1)*SLOTB)?0:sl_next+SLOTB;}while(0)
  DMA_K(2,2*SLOTB);
  WAIT_BAR(3);
  qkt(pA0,pA1,Kbase,qr,negm,r32,hi);asm volatile("s_nop 15\n\ts_nop 7":"+v"(pA0),"+v"(pA1));CMASK(pA0,pA1,0); if(LOWER)lmask(pA0,pA1,0,qrel,hi);
  START(pA0,pA1);
  _Pragma("unroll") for(int r=0;r<16;++r)pA1[r]=__builtin_amdgcn_exp2f(pA1[r]);
  WAIT_BAR(0);
  DMA_K(3,0);DMA_V(1,SLOTB);
  ROT();
  kload8(kf,kp0+sl_cur);
  WAIT_BAR(2);
  s16x4 vlo[8],vhi[8]; u32x4 pw0,pw1,pw2,pw3;
  #define PKW(P,B) (cvtpk_s(P[B],P[B+1])&selw)
  #define PAF(k) __builtin_bit_cast(bf16x8,pw##k)
  #define VFR(i) (bf16x8){vlo[i][0],vlo[i][1],vlo[i][2],vlo[i][3],vhi[i][0],vhi[i][1],vhi[i][2],vhi[i][3]}
  #define PIN(x) asm volatile("":"+v"(x))
  #define MX3(a,b,c) __builtin_fmaxf(__builtin_fmaxf((a),(b)),(c))
  #define GAPA(MF,A0,A1,A2,A3,W0,W1,PW) do{ MF; sacc+=A0; sacc+=A1; sacc+=A2; sacc+=A3; PIN(sacc); W0; W1; PIN(PW); SBAR(); }while(0)
  #define EX(v) __builtin_amdgcn_exp2f(v)
  #define GAPB(MF,X,B) do{ MF; X[B]=EX(X[B]); X[B+1]=EX(X[B+1]); X[B+2]=EX(X[B+2]); X[B+3]=EX(X[B+3]); PIN(X); SBAR(); }while(0)
  #define VRD(i) do{ vlo[i]=vtr(vp_+(((i)>>2)*4096+((i)&3)*1024)); vhi[i]=vtr(vp_+(((i)>>2)*4096+((i)&3)*1024+512)); }while(0)
  #define KRD(G,j) do{ if(G){ kload2(kf,kp0+sl_next,j); SBAR(); } }while(0)
  #define STEP(C0,C1,P0,P1,t,GK,GV,GL) do{ SELSTEP(); SBAR(); \
    const lds_cptr vp_=vp0+sl_prev; \
    VRD(0); SBAR(); float sacc=(P0[0]+P0[1]); \
    GAPA(C0=__builtin_amdgcn_mfma_f32_32x32x16_bf16(kf[0],qr[0],negm,0,0,0), P0[2],P0[3],P0[4],P0[5],     pw0[0]=PKW(P0,0), pw0[1]=PKW(P0,2), pw0); \
    VRD(4); SBAR(); GAPA(C1=__builtin_amdgcn_mfma_f32_32x32x16_bf16(kf[1],qr[0],negm,0,0,0), P0[6],P0[7],P0[8],P0[9],     pw0[2]=PKW(P0,4), pw0[3]=PKW(P0,6), pw0); \
    VRD(1); SBAR(); GAPA(C0=__builtin_amdgcn_mfma_f32_32x32x16_bf16(kf[2],qr[1],C0,0,0,0),   P0[10],P0[11],P0[12],P0[13], pw1[0]=PKW(P0,8), pw1[1]=PKW(P0,10), pw1); \
    VRD(5); SBAR(); GAPA(C1=__builtin_amdgcn_mfma_f32_32x32x16_bf16(kf[3],qr[1],C1,0,0,0),   P0[14],P0[15],P1[0],P1[1],   pw1[2]=PKW(P0,12),pw1[3]=PKW(P0,14), pw1); \
    VRD(2); SBAR(); GAPA(C0=__builtin_amdgcn_mfma_f32_32x32x16_bf16(kf[4],qr[2],C0,0,0,0),   P1[2],P1[3],P1[4],P1[5],     pw2[0]=PKW(P1,0), pw2[1]=PKW(P1,2), pw2); \
    VRD(6); SBAR(); GAPA(C1=__builtin_amdgcn_mfma_f32_32x32x16_bf16(kf[5],qr[2],C1,0,0,0),   P1[6],P1[7],P1[8],P1[9],     pw2[2]=PKW(P1,4), pw2[3]=PKW(P1,6), pw2); \
    VRD(3); SBAR(); GAPA(C0=__builtin_amdgcn_mfma_f32_32x32x16_bf16(kf[6],qr[3],C0,0,0,0),   P1[10],P1[11],P1[12],P1[13], pw3[0]=PKW(P1,8), pw3[1]=PKW(P1,10), pw3); \
    VRD(7); SBAR(); GAPA(C1=__builtin_amdgcn_mfma_f32_32x32x16_bf16(kf[7],qr[3],C1,0,0,0),   P1[14],P1[15],0.f,0.f,       pw3[2]=PKW(P1,12),pw3[3]=PKW(P1,14), pw3); \
    l_reg+=__uint_as_float(__float_as_uint(sacc)&selw); \
    if(GK){DMA_K((t)+3,sl_cur);} if(GV){DMA_V((t)+1,sl_next);} \
    CMASK(C0,C1,t); \
    { float a=MX3(C0[0],C0[1],C1[0]),b=MX3(C0[2],C0[3],C1[1]); a=MX3(a,C1[2],C1[3]); \
      _Pragma("unroll") for(int r=4;r<16;r+=4){a=MX3(a,C0[r],C0[r+1]);b=MX3(b,C0[r+2],C0[r+3]);a=MX3(a,C1[r],C1[r+1]);b=MX3(b,C1[r+2],C1[r+3]);} \
      float rm=__builtin_fmaxf(a,b); { auto rr=__builtin_amdgcn_permlane32_swap(__float_as_uint(rm),__float_as_uint(rm),false,false); rm=__builtin_fmaxf(__uint_as_float(rr[0]),__uint_as_float(rr[1])); } \
      resc=false; \
      if(__builtin_expect(__any(rm>(float)THRL),0)){ const float dl=__builtin_fmaxf(rm,0.f); mhat+=dl; \
        _Pragma("unroll") for(int r=0;r<16;++r){C0[r]-=dl;C1[r]-=dl;} \
        _Pragma("unroll") for(int r=0;r<16;++r)negm[r]=-mhat; asm volatile("":"+v"(negm)); \
        const float f=__builtin_amdgcn_exp2f(-dl); l_reg*=f; if(hi==0)wsf[r32]=f; resc=true; } } \
    SBAR(); \
    GAPB(o[0]=__builtin_amdgcn_mfma_f32_32x32x16_bf16(PAF(0),VFR(0),o[0],0,0,0), C0,0); \
    GAPB(o[1]=__builtin_amdgcn_mfma_f32_32x32x16_bf16(PAF(0),VFR(4),o[1],0,0,0), C0,4); \
    KRD(GL,0); GAPB(o[0]=__builtin_amdgcn_mfma_f32_32x32x16_bf16(PAF(1),VFR(1),o[0],0,0,0), C0,8); \
    KRD(GL,1); GAPB(o[1]=__builtin_amdgcn_mfma_f32_32x32x16_bf16(PAF(1),VFR(5),o[1],0,0,0), C0,12); \
    KRD(GL,2); GAPB(o[0]=__builtin_amdgcn_mfma_f32_32x32x16_bf16(PAF(2),VFR(2),o[0],0,0,0), C1,0); \
    KRD(GL,3); GAPB(o[1]=__builtin_amdgcn_mfma_f32_32x32x16_bf16(PAF(2),VFR(6),o[1],0,0,0), C1,4); \
    GAPB(o[0]=__builtin_amdgcn_mfma_f32_32x32x16_bf16(PAF(3),VFR(3),o[0],0,0,0), C1,8); \
    GAPB(o[1]=__builtin_amdgcn_mfma_f32_32x32x16_bf16(PAF(3),VFR(7),o[1],0,0,0), C1,12); \
    }while(0)
  int t=1;
  #undef CMASK
  #define CMASK(P0,P1,t) lmask(P0,P1,(t),qrel,hi)
  if(LOWER){ for(;t<5;t+=2){
    STEP(pB0,pB1,pA0,pA1,t,true,true,true);     WAIT_BAR(2); RESC(); ROT();
    STEP(pA0,pA1,pB0,pB1,t+1,true,true,true);   WAIT_BAR(2); RESC(); ROT();
  } }
  #undef CMASK
  #define CMASK(P0,P1,t) do{}while(0)
  for(;t+5<NT;t+=2){
    STEP(pB0,pB1,pA0,pA1,t,true,true,true);     WAIT_BAR(2); RESC(); ROT();
    STEP(pA0,pA1,pB0,pB1,t+1,true,true,true);   WAIT_BAR(2); RESC(); ROT();
  }
  #undef CMASK
  #define CMASK(P0,P1,t) do{int jb_=(t)-(NT-4); if(jb_>=0)cmask(P0,P1,jb_,qrel,hi);}while(0)
  #define ENDW(tt) do{ if((tt)+3<NT){WAIT_BAR(2);} else if((tt)+2<NT){WAIT_BAR(1);} else {WAIT_BAR(0);} }while(0)
  for(;t+1<NT;t+=2){
    STEP(pB0,pB1,pA0,pA1,t,(t+3<NT),(t+1<NT),(t+1<NT));       ENDW(t);   RESC(); ROT();
    STEP(pA0,pA1,pB0,pB1,t+1,(t+4<NT),(t+2<NT),(t+2<NT));     ENDW(t+1); RESC(); ROT();
  }
  STEP(pB0,pB1,pA0,pA1,NT-1,false,false,false); RESC();
  { SELSTEP(); float sacc=pB0[0]+pB0[1]; _Pragma("unroll") for(int r=2;r<16;++r)sacc+=pB0[r]; _Pragma("unroll") for(int r=0;r<16;++r)sacc+=pB1[r]; l_reg+=__uint_as_float(__float_as_uint(sacc)&selw);
    pw0=(u32x4){PKW(pB0,0),PKW(pB0,2),PKW(pB0,4),PKW(pB0,6)};pw1=(u32x4){PKW(pB0,8),PKW(pB0,10),PKW(pB0,12),PKW(pB0,14)};pw2=(u32x4){PKW(pB1,0),PKW(pB1,2),PKW(pB1,4),PKW(pB1,6)};pw3=(u32x4){PKW(pB1,8),PKW(pB1,10),PKW(pB1,12),PKW(pB1,14)};
    SBAR(); pv(o,vb0+sl_cur,PAF(0),PAF(1),PAF(2),PAF(3)); }
  #undef PKW
  #undef PAF
  #undef VFR
  #undef PIN
  #undef MX3
  #undef GAPA
  #undef GAPB
  #undef EX
  #undef VRD
  #undef KRD
  #undef STEP
  #undef ENDW
  {auto rr=__builtin_amdgcn_permlane32_swap(__float_as_uint(l_reg),__float_as_uint(l_reg),false,false);l_reg=__uint_as_float(rr[0])+__uint_as_float(rr[1]);}
  if(hi==0){ const float gt=GATES[(rowbase+q0+wid*QBLK+r32)*48+h*3+1+MODE]; wsf[32+r32]=gt*__builtin_amdgcn_rcpf(l_reg); } asm volatile("s_waitcnt lgkmcnt(0)":::"memory");
  float rli[16];
  #pragma unroll
  for(int r=0;r<16;++r)rli[r]=wsf[32+crow(r,hi)];
  bf16*Ow=O+(rowbase+q0+wid*QBLK)*DM+h*D;
  { bf16*stg=(bf16*)(shm+LDS_OST)+wid*2048;
    #pragma unroll
    for(int r=0;r<16;++r){const int orow=crow(r,hi);
      #pragma unroll
      for(int d0=0;d0<2;++d0)stg[orow*64+d0*32+r32]=__float2bfloat16(o[d0][r]*rli[r]);}
    asm volatile("s_waitcnt lgkmcnt(0)":::"memory");
    #pragma unroll
    for(int i=0;i<4;++i){const int row=i*8+(lane>>3),ch=lane&7; const u32x4 v=*(const u32x4*)(stg+row*64+ch*8); const u32x4 pv=*(const u32x4*)(Ow+(long)row*DM+ch*8); u32x4 o4;
      #pragma unroll
      for(int e=0;e<4;++e){ const float lo=__uint_as_float(v[e]<<16)+__uint_as_float(pv[e]<<16), hi2=__uint_as_float(v[e]&0xffff0000u)+__uint_as_float(pv[e]&0xffff0000u); o4[e]=cvtpk_s(lo,hi2); }
      ATTN_STORE16(Ow+(long)row*DM+ch*8,o4);} }
  asm volatile("s_waitcnt lgkmcnt(0)\n\ts_barrier":::"memory");
  #undef DMA_K
  #undef DMA_V
  #undef CMASK
  #undef START
  #undef RESC
  #undef ROT
  #undef SELSTEP
}
constexpr int ATTN_LDS_BYTES=LDS_BYTES;
struct AttnUnit { int bh; int qb; };
template<int THRL=8> __device__ __forceinline__ void attn_phase(char*lds,unsigned char*ws_,int vcu,int G){
  for(int i=0;;++i){ const int L=i*G+vcu; if(L>=BATCH*NHEAD*8*4) break; const int v=L%(BATCH*NHEAD*8), rnd=L/(BATCH*NHEAD*8), s=v&7; AttnUnit u; u.bh=v>>3; u.qb=(rnd==0)?s:(rnd==1)?15-s:(rnd==2)?16+s:31-s;
    unsigned char* ws=uni_ptr(ws_);
    const bf16*Q=(const bf16*)(ws+WS_QB); const bf16*KV=(const bf16*)(ws+WS_KVB); const bf16*WN=(const bf16*)(ws+WS_WINB); bf16*O=(bf16*)(ws+WS_OB); const u32x4*SELM=(const u32x4*)(ws+WS_SELM); const float*GATES=(const float*)(ws+WS_GATES);
    attn_unit<THRL,0,1024>(u.bh/NHEAD,u.bh%NHEAD,u.qb,Q,KV+512,KV+768,O,lds,SELM,GATES);
    asm volatile("s_waitcnt vmcnt(0)":::"memory");
    attn_unit<THRL,1,512>(u.bh/NHEAD,u.bh%NHEAD,u.qb,Q,WN,WN+256,O,lds,nullptr,GATES);
    asm volatile("s_waitcnt vmcnt(0)":::"memory"); }
}
#undef SBAR
#undef WAIT_BAR
}

typedef float f32x16 __attribute__((ext_vector_type(16)));
__device__ __forceinline__ int crow16(int r, int hi) { return (r & 3) + 8 * (r >> 2) + 4 * hi; }
__device__ __forceinline__ void cmpsel_phase(Ctx& F) {
    const int w = F.wave;
    for (int u = F.vcu; u < NBP * 4 * NBLK; u += F.G) {
        unsigned char* ws = uni_ptr(F.ws);
        const bf16* QB = (const bf16*)(ws + WS_QB); const float* KC = (const float*)(ws + WS_KC); const float* VC = (const float*)(ws + WS_VC); const float* GATES = (const float*)(ws + WS_GATES);
        bf16* OB = (bf16*)(ws + WS_OB); v4u* SELM = (v4u*)(ws + WS_SELM);
        int lane = F.lane; asm volatile("" : "+v"(lane));
        const int r32 = lane & 31, hi = lane >> 5, g = r32 >> 3, ql = r32 & 7;
        const int i = u & 127, bk = u >> 7, b = bk >> 2, kvh = bk & 3;
        const int t = 64 * i + 8 * w + ql, row = b * SEQ + t, h = kvh * 4 + g;
        bf16x8 qf[4];
#pragma unroll
        for (int s = 0; s < 4; ++s) qf[s] = *(const bf16x8*)(QB + (size_t)row * D + h * 64 + 16 * s + 8 * hi);
        const float gatev = GATES[(size_t)row * 48 + h * 3];
        const int ntile = (i >> 5) + 1;
        f32x16 p[4];
#pragma unroll
        for (int kt = 0; kt < 4; ++kt) { p[kt] = (f32x16){};
            if (kt < ntile) {
#pragma unroll
                for (int s = 0; s < 4; ++s) { const float* kp = KC + ((size_t)((b * NBLK + 32 * kt + r32) * 4 + kvh)) * 64 + 16 * s + 8 * hi;
                    p[kt] = __builtin_amdgcn_mfma_f32_32x32x16_bf16(pack8(*(const f32x4*)kp, *(const f32x4*)(kp + 4)), qf[s], p[kt], 0, 0, 0); } } }
        const bool lastq = (t & 63) == 63;
        float m = -INFINITY;
#pragma unroll
        for (int kt = 0; kt < 4; ++kt)
#pragma unroll
            for (int r = 0; r < 16; ++r) { const int j = 32 * kt + crow16(r, hi); const bool valid = (j < i) || (j == i && lastq); if (!valid) p[kt][r] = -INFINITY; m = fmaxf(m, p[kt][r]); }
        m = fmaxf(m, __shfl_xor(m, 32)); m = fmaxf(m, -64.f);
        float l = 0.f;
#pragma unroll
        for (int kt = 0; kt < 4; ++kt)
#pragma unroll
            for (int r = 0; r < 16; ++r) { const float e = __builtin_amdgcn_exp2f(p[kt][r] - m); p[kt][r] = e; l += e; }
        l += __shfl_xor(l, 32);
        const float il = l > 0.f ? 1.f / l : 0.f;
#pragma unroll
        for (int kt = 0; kt < 4; ++kt) p[kt] = p[kt] * il;
        f32x16 o[2]; o[0] = (f32x16){}; o[1] = (f32x16){};
#pragma unroll
        for (int kt = 0; kt < 4; ++kt) if (kt < ntile) {
#pragma unroll
            for (int s = 0; s < 2; ++s) { v4u pw; pw.x = pg8::cvt_pk_bf16(p[kt][8 * s + 0], p[kt][8 * s + 1]); pw.y = pg8::cvt_pk_bf16(p[kt][8 * s + 2], p[kt][8 * s + 3]); pw.z = pg8::cvt_pk_bf16(p[kt][8 * s + 4], p[kt][8 * s + 5]); pw.w = pg8::cvt_pk_bf16(p[kt][8 * s + 6], p[kt][8 * s + 7]);
                const bf16x8 pa = __builtin_bit_cast(bf16x8, pw);
#pragma unroll
                for (int d0 = 0; d0 < 2; ++d0) { float vv[8];
#pragma unroll
                    for (int jj = 0; jj < 8; ++jj) vv[jj] = VC[((size_t)((b * NBLK + 32 * kt + 16 * s + 8 * (jj >> 2) + 4 * hi + (jj & 3)) * 4 + kvh)) * 64 + 32 * d0 + r32];
                    o[d0] = __builtin_amdgcn_mfma_f32_32x32x16_bf16(pa, pack8((f32x4){vv[0], vv[1], vv[2], vv[3]}, (f32x4){vv[4], vv[5], vv[6], vv[7]}), o[d0], 0, 0, 0); }
                __builtin_amdgcn_sched_barrier(0); } }
#pragma unroll
        for (int r = 0; r < 16; ++r) { const int rw = crow16(r, hi); const float gt = __shfl(gatev, rw); bf16* op = OB + (size_t)(b * SEQ + 64 * i + 8 * w + (rw & 7)) * D + (kvh * 4 + (rw >> 3)) * 64 + r32;
            op[0] = (bf16)f2bf(gt * o[0][r]); op[32] = (bf16)f2bf(gt * o[1][r]); }
#pragma unroll
        for (int kt = 0; kt < 4; ++kt)
#pragma unroll
            for (int r = 0; r < 16; ++r) { float x = p[kt][r]; x += __shfl_xor(x, 8); x += __shfl_xor(x, 16); p[kt][r] = x; }
        unsigned T = 0u;
        if (i >= 16) {
            unsigned xs[16];
#pragma unroll
            for (int kt = 0; kt < 4; ++kt)
#pragma unroll
                for (int k = 0; k < 4; ++k) { float v = p[kt][k]; v = (g == 1) ? p[kt][4 + k] : v; v = (g == 2) ? p[kt][8 + k] : v; v = (g == 3) ? p[kt][12 + k] : v;
                    const int j = 32 * kt + 8 * g + 4 * hi + k; xs[kt * 4 + k] = (j >= 1 && j <= i - 2) ? __float_as_uint(v) : 0u; }
            for (int bit = 30; bit >= 0; --bit) { const unsigned c = T | (1u << bit); int cnt = 0;
#pragma unroll
                for (int q = 0; q < 16; ++q) cnt += (xs[q] >= c) ? 1 : 0;
                cnt += __shfl_xor(cnt, 8); cnt += __shfl_xor(cnt, 16); cnt += __shfl_xor(cnt, 32);
                if (cnt >= 13) T = c; }
        }
        v4u wd;
#pragma unroll
        for (int kt = 0; kt < 4; ++kt) { unsigned wv = 0u;
#pragma unroll
            for (int r = 0; r < 16; ++r) { const int cr = crow16(r, hi), j = 32 * kt + cr; bool sel;
                if (i >= 16) sel = (j == 0) || (j == i) || (j == i - 1) || (j >= 1 && j <= i - 2 && __float_as_uint(p[kt][r]) >= T); else sel = j <= i;
                wv |= sel ? (1u << cr) : 0u; }
            wv |= (unsigned)__shfl_xor((int)wv, 32); wd[kt] = wv; }
        if (g == 0 && hi == 0) SELM[(size_t)(b * 4 + kvh) * SEQ + t] = wd;
    }
}

constexpr int NPHASES = 31;
__global__ void __launch_bounds__(512, 2) mk_fwd(Args args) {
    extern __shared__ __attribute__((aligned(16))) unsigned char lds_raw[];
    Ctx F;
    F.lds = (LAS unsigned char*)lds_raw; F.tid = threadIdx.x; F.lane = F.tid & 63; F.wave = __builtin_amdgcn_readfirstlane(F.tid >> 6);
    F.G = gridDim.x; { const int bx = blockIdx.x; F.vcu = (F.G % 8 == 0) ? (bx % 8) * (F.G / 8) + bx / 8 : bx; }
    F.gw = F.vcu * 8 + F.wave; F.NGW = F.G * 8;
    F.out = args.out; F.ws = args.ws; unsigned char* ws = args.ws;
    volatile LAS unsigned* MISC = (volatile LAS unsigned*)(F.lds + MISC_OFF);
    for (int u = F.tid; u < (LDS_BYTES - RING_BYTES) / 4; u += 512) ((LAS unsigned*)(F.lds + RING_BYTES))[u] = 0u;
    __syncthreads();
    unsigned* ctl = (unsigned*)(ws + WS_CTL);
    XcdBarrier bar; bar.bar = ctl + CW_BAR; bar.x = 0; bar.st = nullptr;
    const int lo = args.ph_lo, hi = args.ph_hi;
    if (hi - lo > 1) bar = xcd_barrier_post(ctl + CW_BAR, MISC + 8);
    int ph = 0;
    const Ctx& F0 = F;
#define PH_BEGIN if (ph >= lo && ph < hi) { Ctx F = fresh(F0); float* X = F.out + O_Y; (void)X;
#define PH_CLOSE } do { if (ph >= lo && ph + 1 < hi) { XcdBarrier b2_ = bar; asm volatile("" : "+s"(b2_.bar), "+s"(b2_.x)); xcd_barrier(b2_); } ++ph; } while (0)
#define XLO (l == 0 ? (const float*)kin(0) : (const float*)X)
#define XHI (l == 0 ? (const float*)kin(1) : (const float*)(X + (size_t)MP * D))
#define WSB(off) ((bf16*)(F.ws + (off)))
#define WSF(off) ((float*)(F.ws + (off)))
    const int bxi = (int)blockIdx.x;
    PH_BEGIN p0_prologue(F); PH_CLOSE;
    PH_BEGIN pg8::Gemm g{WSB(WS_CB), WSB(WS_ADAT), D, D, D, 0}; pg8::StaticOrder S; S.init(256, NADA, F.G, bxi); pg8::EpiF32 E{WSF(WS_MODS), NADA, 64, (const float*)kin(9), (const float*)kin(15), 8 * 3072};
        pg8::gemm_phase(F.lds, g, S, E); PH_CLOSE;
    for (int l = 0; l < 4; ++l) {
        if (l < 2) {
            PH_BEGIN pass_h(F, l, XLO, XHI); PH_CLOSE;
            PH_BEGIN pass_pool(F); PH_CLOSE;
            PH_BEGIN pg8::Gemm g{WSB(WS_XN2), WSB(WS_POOLW) + (size_t)l * 1024 * 256, D, 256, 256, 256}; pg8::StaticOrder S; S.init(MP, D, F.G, bxi);
                pg8::EpiRes E{XLO, XHI, X, WSF(WS_MODS), (l * 2 + 0) * 3072 + 2048, (const float*)kin(13) + l * D}; pg8::gemm_phase(F.lds, g, S, E);
                skinny_res(F, WSB(WS_XN2) + (size_t)MP * D, D, 256, WSB(WS_POOLW) + (size_t)l * 1024 * 256, 256, 256, XHI, X + (size_t)MP * D, WSF(WS_MODS), (l * 2 + 0) * 3072 + 2048, (const float*)kin(13) + l * D); PH_CLOSE;
        } else {
            const int j = l - 2;
            PH_BEGIN if (l == 2) pass_norm(F, X, X + (size_t)MP * D, (const float*)kin(10) + l * D, (l * 2 + 0) * 3072, WSB(WS_XN), (const float*)kin(16), 8 * 3072, WSB(WS_XN2));
                     else pass_norm(F, X, X + (size_t)MP * D, (const float*)kin(10) + l * D, (l * 2 + 0) * 3072, WSB(WS_XN), nullptr, 0, nullptr); PH_CLOSE;
            PH_BEGIN
                if (l == 2) { pg8::Gemm g{WSB(WS_XN2), WSB(WS_WKV), D, D, D, 0}; pg8::StaticOrder S; S.init(MPAD, NKV, F.G, bxi);
                    pg8::EpiKV E{F.out + O_KV, WSB(WS_KVB), WSB(WS_WINB), F.out + O_WINP, F.out + O_WINS, (const float*)kin(18), WSF(WS_ROPE)}; pg8::gemm_phase(F.lds, g, S, E); }
                { pg8::Gemm g{WSB(WS_XN), WSB(WS_WQG) + (size_t)j * NQGP * D, D, D, D, 0}; pg8::StaticOrder S; S.init(MPAD, NQGP, F.G, bxi);
                    pg8::EpiQG E{WSB(WS_QB), WSF(WS_GATES), (const float*)kin(23) + j * 64, WSF(WS_ROPE)}; pg8::gemm_phase(F.lds, g, S, E); }
            PH_CLOSE;
            if (l == 2) { PH_BEGIN compress_phase(F); PH_CLOSE; }
            PH_BEGIN attn_sample_wg(F); cmpsel_phase(F); PH_CLOSE;
            PH_BEGIN attn_body::attn_phase<8>((char*)lds_raw, F.ws, F.vcu, F.G); PH_CLOSE;
            PH_BEGIN pg8::Gemm g{WSB(WS_OB), WSB(WS_WO) + (size_t)j * D * D, D, D, D, 0}; pg8::StaticOrder S; S.init(MP, D, F.G, bxi);
                pg8::EpiRes E{X, X + (size_t)MP * D, X, WSF(WS_MODS), (l * 2 + 0) * 3072 + 2048, nullptr}; pg8::gemm_phase(F.lds, g, S, E);
                skinny_res(F, WSB(WS_OB) + (size_t)MP * D, D, 0, WSB(WS_WO) + (size_t)j * D * D, D, D, X + (size_t)MP * D, X + (size_t)MP * D, WSF(WS_MODS), (l * 2 + 0) * 3072 + 2048, nullptr); PH_CLOSE;
        }
        PH_BEGIN pass_norm(F, X, X + (size_t)MP * D, (const float*)kin(11) + l * D, (l * 2 + 1) * 3072, WSB(WS_XN), nullptr, 0, nullptr); PH_CLOSE;
        PH_BEGIN pg8::Gemm g{WSB(WS_XN), WSB(WS_WGU) + (size_t)l * NGU * D, D, D, D, 0}; pg8::StaticOrder S; S.init(MPAD, NGU, F.G, bxi); pg8::EpiSwiglu E{WSB(WS_H), DFF}; pg8::gemm_phase(F.lds, g, S, E); PH_CLOSE;
        PH_BEGIN pg8::Gemm g{WSB(WS_H), WSB(WS_WDN) + (size_t)l * D * DFF, DFF, DFF, DFF, 0}; pg8::StaticOrder S; S.init(MP, D, F.G, bxi);
            pg8::EpiRes E{X, X + (size_t)MP * D, X, WSF(WS_MODS), (l * 2 + 1) * 3072 + 2048, nullptr}; pg8::gemm_phase(F.lds, g, S, E);
            skinny_res(F, WSB(WS_H) + (size_t)MP * DFF, DFF, 0, WSB(WS_WDN) + (size_t)l * D * DFF, DFF, DFF, X + (size_t)MP * D, X + (size_t)MP * D, WSF(WS_MODS), (l * 2 + 1) * 3072 + 2048, nullptr); PH_CLOSE;
    }
}

extern "C" void kernel_launch(void* const* d_in, const int* in_sizes, int n_in, void* d_out, int out_size, void* d_ws, size_t ws_size, hipStream_t stream) {
    static int grid = 0;
    if (grid == 0) {
        if (n_in != 27 || (size_t)out_size != O_END || ws_size < WS_END) { fprintf(stderr, "kernel_launch: unexpected shapes (n_in %d out %d ws %zu)\n", n_in, out_size, ws_size); grid = -1; return; }
        int dev = 0, cus = 0, per_cu = 0;
        if (hipGetDevice(&dev) != hipSuccess || hipDeviceGetAttribute(&cus, hipDeviceAttributeMultiprocessorCount, dev) != hipSuccess) { grid = -1; return; }
        if (hipFuncSetAttribute((const void*)mk_fwd, hipFuncAttributeMaxDynamicSharedMemorySize, LDS_BYTES) != hipSuccess) { fprintf(stderr, "kernel_launch: hipFuncSetAttribute failed\n"); grid = -1; return; }
        if (hipOccupancyMaxActiveBlocksPerMultiprocessor(&per_cu, (const void*)mk_fwd, 512, LDS_BYTES) != hipSuccess || per_cu < 1) fprintf(stderr, "kernel_launch: occupancy query reports %d\n", per_cu);
        (void)hipGetLastError();
        grid = cus;
    }
    if (grid < 0) return;
    (void)hipMemsetAsync((char*)d_ws + WS_CTL, 0, CTL_ZERO_BYTES, stream);
    Args a{};
    for (int i = 0; i < 27; ++i) a.in[i] = d_in[i];
    a.out = (float*)d_out; a.ws = (unsigned char*)d_ws;
#if MK_PER_PHASE
    for (int p = 0; p < NPHASES; ++p) { a.ph_lo = p; a.ph_hi = p + 1; hipLaunchKernelGGL(mk_fwd, dim3(grid), dim3(512), LDS_BYTES, stream, a); }
#else
    a.ph_lo = 0; a.ph_hi = NPHASES; hipLaunchKernelGGL(mk_fwd, dim3(grid), dim3(512), LDS_BYTES, stream, a);
#endif
}
```

```cpp
#include <hip/hip_runtime.h>
#include <cstdio>
#include <cstdint>
#include <hip/hip_bf16.h>
#include <cmath>

#ifndef MK_PER_PHASE
#define MK_PER_PHASE 0
#endif

constexpr int D = 1024, SEQ = 8192, NBP = 2, NBS = 32, MP = NBP * SEQ  , MR = MP + NBS  , MPAD = 16640  ;
constexpr int DFF = 2816, NGU = 2 * DFF, NKV = 1536, NQG = 1072, NQGP = 1280, NADA = 8 * 3072 + 2048  ;
constexpr int NBLK = 128, NBATCH = NBP + NBS  , NBLKT = NBATCH * NBLK  ;
constexpr float EPS = 1e-6f;
constexpr float C2 = 0.125f * 1.4426950408889634f;

constexpr size_t O_Y = 0, O_KV = (size_t)MR * 1024, O_WINP = O_KV + (size_t)MR * 1024, O_WINS = O_WINP + (size_t)2 * 512 * 512, O_POOLP = O_WINS + (size_t)32 * 512 * 512,
                 O_POOLS = O_POOLP + (size_t)2 * 2 * 15 * 1024, O_END = O_POOLS + (size_t)2 * 32 * 15 * 1024;
static_assert(O_END == 43577344, "output size");

constexpr size_t MiB = 1u << 20;
constexpr size_t WS_CTL = 0, CTL_ZERO_BYTES = 1 * MiB;
constexpr size_t WS_MODS = 1 * MiB, WS_CB = 8 * MiB, WS_ROPE = 9 * MiB, WS_BIASPE = 10 * MiB;
constexpr size_t WS_ADAT = 16 * MiB, WS_WGU = 68 * MiB, WS_WDN = 112 * MiB, WS_WKV = 134 * MiB, WS_WQG = 137 * MiB, WS_WO = 142 * MiB, WS_POOLW = 146 * MiB, WS_W1T = 147 * MiB;
constexpr size_t WS_XN = 160 * MiB, WS_XN2 = 193 * MiB, WS_H0 = 226 * MiB, WS_H = 291 * MiB, WS_RAWKV = 381 * MiB, WS_RAWQ = 479 * MiB, WS_KVB = 561 * MiB, WS_WINB = 594 * MiB,
                 WS_QB = 611 * MiB, WS_OB = 644 * MiB, WS_GATES = 677 * MiB, WS_KC = 681 * MiB, WS_VC = 686 * MiB, WS_SELM = 691 * MiB, WS_KCB = 693 * MiB, WS_VCT = 696 * MiB, WS_END = 700 * MiB;
constexpr int CW_BAR = 4096;

#define GAS __attribute__((address_space(1)))
#define LAS __attribute__((address_space(3)))
typedef unsigned short bf16;
typedef float f32x4 __attribute__((ext_vector_type(4)));
typedef float f32x2 __attribute__((ext_vector_type(2)));
typedef unsigned v4u __attribute__((ext_vector_type(4)));
typedef unsigned v2u __attribute__((ext_vector_type(2)));
typedef short bf16x8 __attribute__((ext_vector_type(8)));
#define RLX_AGENT __ATOMIC_RELAXED, __HIP_MEMORY_SCOPE_AGENT
#define LDS_WAIT() asm volatile("s_waitcnt lgkmcnt(0)" ::: "memory")
#define VM_WAIT() asm volatile("s_waitcnt vmcnt(0)" ::: "memory")

__device__ __forceinline__ unsigned f2bf(float f) { unsigned u = __builtin_bit_cast(unsigned, f); return (u + 0x7fffu + ((u >> 16) & 1u)) >> 16; }
__device__ __forceinline__ unsigned pk2(float lo, float hi) { return f2bf(lo) | (f2bf(hi) << 16); }
__device__ __forceinline__ float bf2f(unsigned short u) { return __builtin_bit_cast(float, (unsigned)u << 16); }
__device__ __forceinline__ float wave_sum(float v) {
#pragma unroll
    for (int o = 1; o < 64; o <<= 1) v += __shfl_xor(v, o);
    return v;
}
__device__ __forceinline__ float wave_max(float v) {
#pragma unroll
    for (int o = 1; o < 64; o <<= 1) v = fmaxf(v, __shfl_xor(v, o));
    return v;
}
__device__ __forceinline__ int bidx_of(int row) { return row < MP ? (row >> 13) : ((row - MP + 2) < NBATCH ? (row - MP + 2) : NBATCH - 1); }

namespace pg8 {
#define PG8_LAS __attribute__((address_space(3)))
typedef unsigned short bf16_t;
typedef short bf16x8 __attribute__((ext_vector_type(8)));
typedef float f32x4 __attribute__((ext_vector_type(4)));
typedef unsigned u32x4 __attribute__((ext_vector_type(4)));
constexpr int BM = 256, BK = 64, HALF = 128, HTB = HALF * BK * 2, STAGE_BYTES = 8 * HTB, NXCD = 8, WGM = 8;
__host__ __device__ __forceinline__ int lds_byte(int r, int c) { const int st = (r >> 4) * 2 + (c >> 5), rr = r & 15, cc = c & 31, ob = rr * 64 + cc * 2; return st * 1024 + (ob ^ (((ob >> 9) & 1) << 5)); }
__host__ __device__ __forceinline__ void stage_rc(int b, int& R, int& C) { const int st = b / 1024, sb = b % 1024, swz = sb ^ (((sb >> 9) & 1) << 5); R = (st >> 1) * 16 + swz / 64; C = (st & 1) * 32 + (swz % 64) / 2; }
__host__ __device__ __forceinline__ int perm32(int rho) { const int n = rho >> 4, i = rho & 15; return 8 * (i >> 2) + 4 * n + (i & 3); }
struct Unit { int pm, pn; };
struct Gemm { const bf16_t* A; const bf16_t* Bt; int lda, ldb, K, a_pn_off; };
struct StaticOrder {
    int nM, nN, nwg, G, c;
    __host__ __device__ void init(int M, int N, int G_, int c_) { nM = M / BM; nN = N / BM; nwg = nM * nN; G = G_; c = c_; }
    __host__ __device__ bool next(int i, Unit& u) const {
        const long L = (long)i * G + c; if (L >= nwg) return false;
        int wgid = (int)L; { const int q = nwg / NXCD, r = nwg % NXCD, xcd = wgid % NXCD, off = wgid / NXCD; wgid = (xcd < r ? xcd * (q + 1) : r * (q + 1) + (xcd - r) * q) + off; }
        const int nig = WGM * nN, gid = wgid / nig, fm = gid * WGM, gsz = (nM - fm) < WGM ? (nM - fm) : WGM;
        u.pm = fm + ((wgid % nig) % gsz); u.pn = (wgid % nig) / gsz; return true;
    }
};
template <class Epi>
__device__ __forceinline__ void gemm_phase(PG8_LAS unsigned char* lds, const Gemm g, const StaticOrder& S, const Epi& E) {
    int tid = threadIdx.x; asm volatile("" : "+v"(tid));
    const int wid = __builtin_amdgcn_readfirstlane(tid >> 6), lane = tid & 63, wr = wid >> 2, wc = wid & 3, fr = lane & 15, fq = lane >> 4;
    const int K = g.K, nt = K / BK;
    unsigned voffA[2], voffB[2];
#pragma unroll
    for (int i = 0; i < 2; ++i) { int R, C; stage_rc(tid * 16 + i * 8192, R, C); const int Rb = Epi::PERM ? ((R & ~31) + perm32(R & 31)) : R;
        voffA[i] = (unsigned)(R * g.lda + C) * 2u; voffB[i] = (unsigned)(Rb * g.ldb + C) * 2u; }
    const size_t kstep = (size_t)(BK * 2);
    const size_t hstepA = (size_t)HALF * g.lda * 2, hstepB = (size_t)HALF * g.ldb * 2, tstepA = 2 * hstepA, tstepB = 2 * hstepB;
    const unsigned ldsw = (unsigned)wid * 1024u;
    const int aoff = lds_byte(wr * 64 + fr, fq * 8), boff = lds_byte(wc * 32 + fr, fq * 8);
#define PG8_SA(b, h) (((b) * 2 + (h)) * HTB)
#define PG8_SB(b, h) ((4 + (b) * 2 + (h)) * HTB)
#define PG8_STAGE(bufoff, gbase, voff) do { _Pragma("unroll") for (int _i = 0; _i < 2; ++_i) \
        __builtin_amdgcn_global_load_lds((const unsigned*)((const char*)(gbase) + (voff)[_i]), (PG8_LAS unsigned*)(lds + (bufoff) + ldsw + _i * 8192), 16, 0, 0); } while (0)
#define PG8_LDA(dst, b, h) do { _Pragma("unroll") for (int m = 0; m < 4; ++m) _Pragma("unroll") for (int k = 0; k < 2; ++k) dst[m][k] = *(const PG8_LAS bf16x8*)(lds + PG8_SA(b, h) + aoff + m * 2048 + k * 1024); } while (0)
#define PG8_LDB(dst, b, h) do { _Pragma("unroll") for (int n = 0; n < 2; ++n) _Pragma("unroll") for (int k = 0; k < 2; ++k) dst[n][k] = *(const PG8_LAS bf16x8*)(lds + PG8_SB(b, h) + boff + n * 2048 + k * 1024); } while (0)
#define PG8_MMA(ai, bj, At, Bt) do { __builtin_amdgcn_s_setprio(1); _Pragma("unroll") for (int m = 0; m < 4; ++m) _Pragma("unroll") for (int n = 0; n < 2; ++n) _Pragma("unroll") for (int k = 0; k < 2; ++k) \
        acc[ai][bj][m][n] = __builtin_amdgcn_mfma_f32_16x16x32_bf16(Bt[n][k], At[m][k], acc[ai][bj][m][n], 0, 0, 0); __builtin_amdgcn_s_setprio(0); } while (0)
#define PG8_WAIT_V(n) asm volatile("s_waitcnt vmcnt(" #n ")" ::: "memory")
#define PG8_WAIT_L(n) asm volatile("s_waitcnt lgkmcnt(" #n ")" ::: "memory")
#define PG8_BAR __builtin_amdgcn_s_barrier()
#define PG8_SCHED __builtin_amdgcn_sched_barrier(0)
    Unit cur, nxt; int ui = 0;
    if (!S.next(0, cur)) return;
    f32x4 acc[2][2][4][2];
#pragma unroll
    for (int a = 0; a < 2; ++a)
#pragma unroll
        for (int b = 0; b < 2; ++b)
#pragma unroll
            for (int m = 0; m < 4; ++m)
#pragma unroll
                for (int n = 0; n < 2; ++n) acc[a][b][m][n] = (f32x4){0.f, 0.f, 0.f, 0.f};
    bf16x8 At[4][2], B0[2][2], B1[2][2];
    const char* cA = (const char*)g.A + (size_t)cur.pm * tstepA + (size_t)cur.pn * g.a_pn_off * 2; const char* cB = (const char*)g.Bt + (size_t)cur.pn * tstepB;
    PG8_STAGE(PG8_SB(0, 0), cB, voffB); PG8_STAGE(PG8_SB(0, 1), cB + hstepB, voffB); PG8_STAGE(PG8_SA(0, 0), cA, voffA); PG8_STAGE(PG8_SA(0, 1), cA + hstepA, voffA);
    if (wr == 1) PG8_BAR;
    PG8_WAIT_V(2); PG8_BAR;
    PG8_STAGE(PG8_SB(1, 0), cB + kstep, voffB); PG8_STAGE(PG8_SA(1, 0), cA + kstep, voffA); PG8_STAGE(PG8_SB(1, 1), cB + hstepB + kstep, voffB);
    PG8_WAIT_V(6); PG8_BAR;
    for (;;) {
        const bool has_next = S.next(ui + 1, nxt);
        const char* nA = has_next ? (const char*)g.A + (size_t)nxt.pm * tstepA + (size_t)nxt.pn * g.a_pn_off * 2 : cA; const char* nB = has_next ? (const char*)g.Bt + (size_t)nxt.pn * tstepB : cB;
        for (int t = 0; t < nt; t += 2) {
            const bool last = (t == nt - 2);
            const char* a1 = cA + (size_t)(t + 1) * kstep;
            const char* a2 = last ? nA : cA + (size_t)(t + 2) * kstep; const char* b2 = last ? nB : cB + (size_t)(t + 2) * kstep;
            const char* a3 = a2 + kstep; const char* b3 = b2 + kstep;
            PG8_LDB(B0, 0, 0); PG8_LDB(B1, 0, 1); PG8_SCHED; PG8_LDA(At, 0, 0); PG8_STAGE(PG8_SA(1, 1), a1 + hstepA, voffA);
            PG8_WAIT_V(8); PG8_WAIT_L(0); PG8_BAR; PG8_MMA(0, 0, At, B0); PG8_MMA(0, 1, At, B1); PG8_BAR; PG8_SCHED;
            PG8_LDA(At, 0, 1); PG8_STAGE(PG8_SB(0, 0), b2, voffB); PG8_STAGE(PG8_SB(0, 1), b2 + hstepB, voffB); PG8_STAGE(PG8_SA(0, 0), a2, voffA);
            PG8_WAIT_V(8); PG8_WAIT_L(0); PG8_BAR; PG8_MMA(1, 0, At, B0); PG8_MMA(1, 1, At, B1); PG8_BAR; PG8_SCHED;
            PG8_LDB(B0, 1, 0); PG8_LDB(B1, 1, 1); PG8_SCHED; PG8_LDA(At, 1, 0); PG8_STAGE(PG8_SA(0, 1), a2 + hstepA, voffA);
            PG8_WAIT_V(8); PG8_WAIT_L(0); PG8_BAR; PG8_MMA(0, 0, At, B0); PG8_MMA(0, 1, At, B1); PG8_BAR; PG8_SCHED;
            PG8_LDA(At, 1, 1); PG8_STAGE(PG8_SB(1, 0), b3, voffB); PG8_STAGE(PG8_SB(1, 1), b3 + hstepB, voffB); PG8_STAGE(PG8_SA(1, 0), a3, voffA);
            PG8_WAIT_V(8); PG8_WAIT_L(0); PG8_BAR; PG8_MMA(1, 0, At, B0); PG8_MMA(1, 1, At, B1); PG8_BAR; PG8_SCHED;
        }
        if (wr == 0) PG8_BAR;
        E(acc, cur, wr, wc, fr, fq);
        if (!has_next) break;
#pragma unroll
        for (int a = 0; a < 2; ++a)
#pragma unroll
            for (int b = 0; b < 2; ++b)
#pragma unroll
                for (int m = 0; m < 4; ++m)
#pragma unroll
                    for (int n = 0; n < 2; ++n) acc[a][b][m][n] = (f32x4){0.f, 0.f, 0.f, 0.f};
        cur = nxt; cA = nA; cB = nB; ++ui;
        if (wr == 1) PG8_BAR;
    }
    PG8_WAIT_V(0);
    PG8_BAR;
#undef PG8_SA
#undef PG8_SB
#undef PG8_STAGE
#undef PG8_LDA
#undef PG8_LDB
#undef PG8_MMA
#undef PG8_WAIT_V
#undef PG8_WAIT_L
#undef PG8_BAR
#undef PG8_SCHED
}

__device__ __forceinline__ unsigned cvt_pk_bf16(float lo, float hi) { unsigned r; asm volatile("v_cvt_pk_bf16_f32 %0, %1, %2" : "=v"(r) : "v"(lo), "v"(hi)); return r; }
struct EpiF32 {
    static constexpr bool PERM = false;
    float* out; int ldc; int rows_valid; const float* bias_a; const float* bias_b; int bias_split;
    __device__ __forceinline__ void operator()(const f32x4 (&acc)[2][2][4][2], const Unit& u, int wr, int wc, int fr, int fq) const {
#pragma unroll
        for (int ai = 0; ai < 2; ++ai)
#pragma unroll
            for (int m = 0; m < 4; ++m) { const int row = u.pm * BM + ai * HALF + wr * 64 + m * 16 + fr;
                if (row < rows_valid) {
#pragma unroll
                    for (int bj = 0; bj < 2; ++bj)
#pragma unroll
                        for (int n = 0; n < 2; ++n) { const int col = u.pn * BM + bj * HALF + wc * 32 + n * 16 + 4 * fq; f32x4 v = acc[ai][bj][m][n];
                            if (bias_a) { const f32x4 b = (col < bias_split) ? *(const f32x4*)(bias_a + col) : *(const f32x4*)(bias_b + (col - bias_split)); v += b; }
                            *(f32x4*)(out + (size_t)row * ldc + col) = v; } } }
    }
};
struct EpiRes {
    static constexpr bool PERM = false;
    const float* in_lo; const float* in_hi; float* out; const float* mods; int gate_off; const float* cscale;
    __device__ __forceinline__ void operator()(const f32x4 (&acc)[2][2][4][2], const Unit& u, int wr, int wc, int fr, int fq) const {
#pragma unroll
        for (int ai = 0; ai < 2; ++ai)
#pragma unroll
            for (int m = 0; m < 4; ++m) { const int row = u.pm * BM + ai * HALF + wr * 64 + m * 16 + fr;
                if (row < MR) { const float* gp = mods + (size_t)bidx_of(row) * NADA + gate_off; const float* ip = row < MP ? in_lo + (size_t)row * D : in_hi + (size_t)(row - MP) * D; float* op = out + (size_t)row * D;
#pragma unroll
                    for (int bj = 0; bj < 2; ++bj)
#pragma unroll
                        for (int n = 0; n < 2; ++n) { const int col = u.pn * BM + bj * HALF + wc * 32 + n * 16 + 4 * fq; f32x4 gt = *(const f32x4*)(gp + col);
                            if (cscale) gt *= *(const f32x4*)(cscale + col);
                            const f32x4 x = *(const f32x4*)(ip + col); *(f32x4*)(op + col) = x + gt * acc[ai][bj][m][n]; } } }
    }
};
__device__ __forceinline__ float silu_f(float x) { return x * __builtin_amdgcn_rcpf(1.f + __builtin_amdgcn_exp2f(-1.4426950408889634f * x)); }
struct EpiSwiglu {
    static constexpr bool PERM = true;
    bf16_t* H; int ldh;
    __device__ __forceinline__ void operator()(const f32x4 (&acc)[2][2][4][2], const Unit& u, int wr, int wc, int fr, int fq) const {
        const int row0 = u.pm * BM + wr * 64 + fr, col0 = u.pn * HALF + wc * 32 + 8 * fq;
#pragma unroll
        for (int ai = 0; ai < 2; ++ai)
#pragma unroll
            for (int m = 0; m < 4; ++m) { bf16_t* rowp = H + (size_t)(row0 + ai * HALF + m * 16) * ldh + col0;
                const f32x4 g0 = acc[ai][0][m][0], g1 = acc[ai][0][m][1], u0 = acc[ai][1][m][0], u1 = acc[ai][1][m][1];
                u32x4 w; w.x = cvt_pk_bf16(silu_f(g0[0]) * u0[0], silu_f(g0[1]) * u0[1]); w.y = cvt_pk_bf16(silu_f(g0[2]) * u0[2], silu_f(g0[3]) * u0[3]);
                w.z = cvt_pk_bf16(silu_f(g1[0]) * u1[0], silu_f(g1[1]) * u1[1]); w.w = cvt_pk_bf16(silu_f(g1[2]) * u1[2], silu_f(g1[3]) * u1[3]);
                *(u32x4*)rowp = w; }
    }
};

__device__ __forceinline__ void head_post(f32x4 (&v)[2][2], const float* gain, const float* ropep, int fq) {
    float ss = 0.f;
#pragma unroll
    for (int bj = 0; bj < 2; ++bj)
#pragma unroll
        for (int n = 0; n < 2; ++n) ss += (v[bj][n].x * v[bj][n].x + v[bj][n].y * v[bj][n].y) + (v[bj][n].z * v[bj][n].z + v[bj][n].w * v[bj][n].w);
    ss += __shfl_xor(ss, 16); ss += __shfl_xor(ss, 32);
    const float rs = rsqrtf(ss * (1.f / 64.f) + EPS);
#pragma unroll
    for (int bj = 0; bj < 2; ++bj)
#pragma unroll
        for (int n = 0; n < 2; ++n) v[bj][n] = v[bj][n] * rs * *(const f32x4*)(gain + 32 * bj + 16 * n + 4 * fq);
    f32x4 o; o.x = __shfl_xor(v[0][0].x, 32); o.y = __shfl_xor(v[0][0].y, 32); o.z = __shfl_xor(v[0][0].z, 32); o.w = __shfl_xor(v[0][0].w, 32);
    const f32x4 c0 = *(const f32x4*)(ropep + 8 * (fq & 1)), c1 = *(const f32x4*)(ropep + 8 * (fq & 1) + 4); const f32x4 cv = {c0.x, c0.z, c1.x, c1.z}, sv = {c0.y, c0.w, c1.y, c1.w};
    v[0][0] = (fq < 2) ? v[0][0] * cv - o * sv : v[0][0] * cv + o * sv;
}
__device__ __forceinline__ unsigned long long pk4e(f32x4 v) { return (unsigned long long)cvt_pk_bf16(v.x, v.y) | ((unsigned long long)cvt_pk_bf16(v.z, v.w) << 32); }
struct EpiKV {
    static constexpr bool PERM = false;
    float* kvo; bf16_t* kvb; bf16_t* winb; float* winp; float* wins; const float* knorm; const float* rope;
    __device__ __forceinline__ void operator()(const f32x4 (&acc)[2][2][4][2], const Unit& u, int wr, int wc, int fr, int fq) const {
        const int slot = u.pn;
#pragma unroll
        for (int ai = 0; ai < 2; ++ai)
#pragma unroll
            for (int m = 0; m < 4; ++m) { const int row = u.pm * BM + ai * HALF + wr * 64 + m * 16 + fr;
                if (row < MR) { const int pos = row < MP ? (row & (SEQ - 1)) : SEQ; f32x4 v[2][2];
#pragma unroll
                    for (int bj = 0; bj < 2; ++bj)
#pragma unroll
                        for (int n = 0; n < 2; ++n) v[bj][n] = acc[ai][bj][m][n];
                    if (slot == 2 || slot == 4) head_post(v, knorm + (slot == 2 ? 64 : 128), rope + (size_t)pos * 16, fq);
                    if (slot < 4) { float* fo = kvo + (size_t)row * 1024 + slot * 256 + wc * 64 + 4 * fq; bf16_t* bo = kvb + (size_t)row * 1024 + slot * 256 + wc * 64 + 4 * fq;
#pragma unroll
                        for (int bj = 0; bj < 2; ++bj)
#pragma unroll
                            for (int n = 0; n < 2; ++n) { *(f32x4*)(fo + 32 * bj + 16 * n) = v[bj][n]; *(unsigned long long*)(bo + 32 * bj + 16 * n) = pk4e(v[bj][n]); } }
                    else { bf16_t* bo = winb + (size_t)row * 512 + (slot - 4) * 256 + wc * 64 + 4 * fq; float* fo = nullptr;
                        if (row < MP) { if (pos >= SEQ - 512) fo = winp + ((size_t)(row >> 13) * 512 + (pos - (SEQ - 512))) * 512; } else fo = wins + ((size_t)(row - MP) * 512 + 511) * 512;
                        if (fo) fo += (slot - 4) * 256 + wc * 64 + 4 * fq;
#pragma unroll
                        for (int bj = 0; bj < 2; ++bj)
#pragma unroll
                            for (int n = 0; n < 2; ++n) { *(unsigned long long*)(bo + 32 * bj + 16 * n) = pk4e(v[bj][n]); if (fo) *(f32x4*)(fo + 32 * bj + 16 * n) = v[bj][n]; } } } }
    }
};
struct EpiQG {
    static constexpr bool PERM = false;
    bf16_t* qb; float* gates; const float* qnorm; const float* rope;
    __device__ __forceinline__ void operator()(const f32x4 (&acc)[2][2][4][2], const Unit& u, int wr, int wc, int fr, int fq) const {
#pragma unroll
        for (int ai = 0; ai < 2; ++ai)
#pragma unroll
            for (int m = 0; m < 4; ++m) { const int row = u.pm * BM + ai * HALF + wr * 64 + m * 16 + fr;
                if (row < MR) {
                    if (u.pn < 4) { const int pos = row < MP ? (row & (SEQ - 1)) : SEQ; f32x4 v[2][2];
#pragma unroll
                        for (int bj = 0; bj < 2; ++bj)
#pragma unroll
                            for (int n = 0; n < 2; ++n) v[bj][n] = acc[ai][bj][m][n];
                        head_post(v, qnorm, rope + (size_t)pos * 16, fq);
                        bf16_t* bo = qb + (size_t)row * D + (4 * u.pn + wc) * 64 + 4 * fq;
#pragma unroll
                        for (int bj = 0; bj < 2; ++bj)
#pragma unroll
                            for (int n = 0; n < 2; ++n) *(unsigned long long*)(bo + 32 * bj + 16 * n) = pk4e(v[bj][n] * C2); }
                    else if (wc < 2) {
#pragma unroll
                        for (int n = 0; n < 2; ++n) if (wc == 0 || n == 0) { const f32x4 a = acc[ai][0][m][n]; f32x4 g;
                            g.x = __builtin_amdgcn_rcpf(1.f + __builtin_amdgcn_exp2f(-1.4426950408889634f * a.x)); g.y = __builtin_amdgcn_rcpf(1.f + __builtin_amdgcn_exp2f(-1.4426950408889634f * a.y));
                            g.z = __builtin_amdgcn_rcpf(1.f + __builtin_amdgcn_exp2f(-1.4426950408889634f * a.z)); g.w = __builtin_amdgcn_rcpf(1.f + __builtin_amdgcn_exp2f(-1.4426950408889634f * a.w));
                            *(f32x4*)(gates + (size_t)row * 48 + 32 * wc + 16 * n + 4 * fq) = g; } } } }
    }
};
}

#define XB_TMO      128
#define XB_XCNT(j)  (256  + 64 * (j))
#define XB_XSUB(j)  (1280 + 64 * (j))
#define XB_XGEN(j)  (2304 + 64 * (j))
#define XB_TOP      3328
#define XB_TOPGEN   3392
#define XCD_BAR_WORDS 3456
#define XB_SPIN_CAP (1u << 18)
__device__ __forceinline__ unsigned xb_ld(unsigned* p)              { return __hip_atomic_load(p, __ATOMIC_RELAXED, __HIP_MEMORY_SCOPE_AGENT); }
__device__ __forceinline__ unsigned xb_add(unsigned* p, unsigned v) { return __hip_atomic_fetch_add(p, v, __ATOMIC_RELAXED, __HIP_MEMORY_SCOPE_AGENT); }
__device__ __forceinline__ unsigned xb_xcc_id() { return (unsigned)__builtin_amdgcn_s_getreg((3 << 11) | 20) & 0xFu; }
#define XB_SPIN(cond, bar) do { unsigned _sp = 0; while (cond) { __builtin_amdgcn_s_sleep(1); \
    if ((++_sp & 255u) == 0u) { if (xb_ld(&(bar)[XB_TMO])) break; if (_sp > XB_SPIN_CAP) { atomicAdd(&(bar)[XB_TMO], 1u); break; } } } } while (0)
struct XcdBarrier { unsigned* bar; unsigned x; volatile LAS unsigned* st; };
__device__ __forceinline__ XcdBarrier xcd_barrier_post(unsigned* bar, volatile LAS unsigned* st) {
    XcdBarrier b; b.bar = bar; b.x = xb_xcc_id(); b.st = st;
    if (threadIdx.x == 0) (void)xb_add(&bar[XB_XCNT(b.x)], 1u);
    return b;
}
__device__ __forceinline__ void xcd_barrier_complete(unsigned* bar, unsigned x, unsigned& nloc, unsigned& nx) {
    const unsigned G = gridDim.x * gridDim.y * gridDim.z;
    unsigned sum, cnt, mine, sp = 0u;
    for (;;) {
        sum = 0u; cnt = 0u; mine = 0u;
#pragma unroll
        for (unsigned j = 0; j < 16; ++j) { const unsigned c = xb_ld(&bar[XB_XCNT(j)]); sum += c; cnt += (c > 0u) ? 1u : 0u; mine = (j == x) ? c : mine; }
        if (sum == G) break;
        __builtin_amdgcn_s_sleep(1);
        if ((++sp & 255u) == 0u) { if (xb_ld(&bar[XB_TMO])) break; if (sp > XB_SPIN_CAP) { atomicAdd(&bar[XB_TMO], 1u); break; } }
    }
    nloc = mine > 0u ? mine : 1u; nx = cnt > 0u ? cnt : 1u;
}
__device__ __forceinline__ void xcd_barrier(const XcdBarrier& b) {
    asm volatile("s_waitcnt vmcnt(0)" ::: "memory");
    __syncthreads();
    if (threadIdx.x == 0) {
        unsigned* bar = b.bar;
        __builtin_amdgcn_s_waitcnt(0);
        unsigned nloc = b.st[0], nx = b.st[1];
        if (nloc == 0u) { xcd_barrier_complete(bar, b.x, nloc, nx); b.st[0] = nloc; b.st[1] = nx; }
        const unsigned old = xb_add(&bar[XB_XSUB(b.x)], 1u);
        const unsigned gen = old / nloc;
        if (old + 1u == (gen + 1u) * nloc) {
            __builtin_amdgcn_fence(__ATOMIC_RELEASE, "agent");
            asm volatile("s_waitcnt vmcnt(0)" ::: "memory");
            const unsigned og = xb_add(&bar[XB_TOP], 1u);
            const unsigned tg = og / nx;
            if (og + 1u == (tg + 1u) * nx) xb_add(&bar[XB_TOPGEN], 1u);
            else XB_SPIN(xb_ld(&bar[XB_TOPGEN]) == tg, bar);
            __builtin_amdgcn_fence(__ATOMIC_ACQUIRE, "agent");
            xb_add(&bar[XB_XGEN(b.x)], 1u);
            asm volatile("s_waitcnt vmcnt(0)" ::: "memory");
        } else {
            XB_SPIN(xb_ld(&bar[XB_XGEN(b.x)]) == gen, bar);
            __builtin_amdgcn_fence(__ATOMIC_ACQUIRE, "agent");
            asm volatile("s_waitcnt vmcnt(0)" ::: "memory");
        }
    }
    __syncthreads();
}

constexpr int RING_BYTES = 131072, MISC_OFF = RING_BYTES + 320, LDS_BYTES = 147456;
struct Args { const void* in[27]; float* out; unsigned char* ws; int ph_lo, ph_hi; };
struct Ctx {
    LAS unsigned char* lds; int tid, lane, wave, vcu, G, gw, NGW;
    float* out; unsigned char* ws;
};

__device__ __forceinline__ Ctx fresh(const Ctx& F) { Ctx C = F; GAS float* go = (GAS float*)F.out; GAS unsigned char* gw_ = (GAS unsigned char*)F.ws;
    asm volatile("" : "+v"(C.tid), "+s"(C.wave), "+s"(C.vcu), "+s"(C.G), "+s"(go), "+s"(gw_)); C.lane = C.tid & 63; C.gw = C.vcu * 8 + C.wave; C.NGW = C.G * 8;
    C.out = (float*)go; C.ws = (unsigned char*)gw_;
    return C; }
__device__ __forceinline__ unsigned char* uni_ptr(const void* p) { const unsigned long long v = (unsigned long long)p; unsigned lo = __builtin_amdgcn_readfirstlane((unsigned)v), hi = __builtin_amdgcn_readfirstlane((unsigned)(v >> 32));
    asm volatile("" : "+s"(lo), "+s"(hi)); return (unsigned char*)(GAS unsigned char*)(((unsigned long long)hi << 32) | lo); }
__device__ __forceinline__ const void* kin(int i) { const char __attribute__((address_space(4)))* kp = (const char __attribute__((address_space(4)))*)__builtin_amdgcn_kernarg_segment_ptr(); asm volatile("" : "+s"(kp));
    const GAS void* p = *(const GAS void* const __attribute__((address_space(4)))*)(kp + 8 * i); return (const void*)p; }
__device__ __forceinline__ void tr_item(const float* W, int N, int K, bf16* WT, int kb, int n0, int drow0, LAS float* scr, int lane) {
    const int k0 = 64 * kb, nn = n0 + (lane & 31); const bool ok = nn < N;
    float tv[32];
#pragma unroll
    for (int i = 0; i < 32; ++i) tv[i] = ok ? W[(size_t)(k0 + 2 * i + (lane >> 5)) * N + nn] : 0.f;
#pragma unroll
    for (int i = 0; i < 32; ++i) scr[(2 * i + (lane >> 5)) * 33 + (lane & 31)] = tv[i];
    LDS_WAIT(); asm volatile("" ::: "memory");
    const int c = lane & 7;
#pragma unroll
    for (int j = 0; j < 4; ++j) { const int n = (lane >> 3) + 8 * j; const LAS float* s = scr + (8 * c) * 33 + n;
        v4u o; o.x = pk2(s[0 * 33], s[1 * 33]); o.y = pk2(s[2 * 33], s[3 * 33]); o.z = pk2(s[4 * 33], s[5 * 33]); o.w = pk2(s[6 * 33], s[7 * 33]);
        *(GAS v4u*)(WT + (size_t)(drow0 + n) * K + k0 + 8 * c) = o; }
    LDS_WAIT(); asm volatile("" ::: "memory");
}
__device__ __forceinline__ void tr_job(const float* W, int N, int K, bf16* WT, int it, int mode, LAS float* scr, int lane) {
    const int nblk = (N + 31) / 32, kb = it / nblk, n0 = 32 * (it % nblk);
    int drow0 = n0;
    if (mode == 1) drow0 = (n0 < DFF) ? 256 * (n0 / 128) + (n0 % 128) : 256 * ((n0 - DFF) / 128) + 128 + ((n0 - DFF) % 128);
    if (mode == 2 && n0 < 6144) drow0 = 256 * (n0 / 256) + 128 * ((n0 % 64) / 32) + 32 * ((n0 % 256) / 64);
    if (mode == 3 && n0 < 1024) drow0 = 256 * (n0 / 256) + 128 * ((n0 % 64) / 32) + 32 * ((n0 % 256) / 64);
    tr_item(W, N, K, WT, kb, n0, drow0, scr, lane);
}
__device__ __forceinline__ void p0_prologue(Ctx& F) {
    LAS float* scr = (LAS float*)(F.lds + F.wave * 16384);
    constexpr int I_ADA = 16 * 96, I_ADAKV = 16 * 64, I_GU = 16 * 176, I_DN = 44 * 32, I_KV = 16 * 48, I_QG = 16 * 34, I_WO = 16 * 32, I_PW = 4 * 8, I_W1 = 64 * 4;
    constexpr int NIT = 8 * I_ADA + I_ADAKV + 4 * I_GU + 4 * I_DN + I_KV + 2 * I_QG + 2 * I_WO + 8 * I_PW + 2 * I_W1;
    for (int it = F.gw; it < NIT; it += F.NGW) {
        int r = it;
        if (r < 8 * I_ADA) { const int s = r / I_ADA; tr_job(((const float*)kin(8)) + (size_t)s * 1024 * 3072, 3072, 1024, ((bf16*)(F.ws + WS_ADAT)) + (size_t)s * 3072 * 1024, r % I_ADA, 0, scr, F.lane); continue; } r -= 8 * I_ADA;
        if (r < I_ADAKV) { tr_job(((const float*)kin(14)), 2048, 1024, ((bf16*)(F.ws + WS_ADAT)) + (size_t)24576 * 1024, r, 0, scr, F.lane); continue; } r -= I_ADAKV;
        if (r < 4 * I_GU) { const int s = r / I_GU; tr_job(((const float*)kin(25)) + (size_t)s * 1024 * NGU, NGU, 1024, ((bf16*)(F.ws + WS_WGU)) + (size_t)s * NGU * 1024, r % I_GU, 1, scr, F.lane); continue; } r -= 4 * I_GU;
        if (r < 4 * I_DN) { const int s = r / I_DN; tr_job(((const float*)kin(26)) + (size_t)s * DFF * 1024, 1024, DFF, ((bf16*)(F.ws + WS_WDN)) + (size_t)s * 1024 * DFF, r % I_DN, 0, scr, F.lane); continue; } r -= 4 * I_DN;
        if (r < I_KV) { tr_job(((const float*)kin(17)), NKV, 1024, ((bf16*)(F.ws + WS_WKV)), r, 2, scr, F.lane); continue; } r -= I_KV;
        if (r < 2 * I_QG) { const int s = r / I_QG; tr_job(((const float*)kin(22)) + (size_t)s * 1024 * NQG, NQG, 1024, ((bf16*)(F.ws + WS_WQG)) + (size_t)s * NQGP * 1024, r % I_QG, 3, scr, F.lane); continue; } r -= 2 * I_QG;
        if (r < 2 * I_WO) { const int s = r / I_WO; tr_job(((const float*)kin(24)) + (size_t)s * 1024 * 1024, 1024, 1024, ((bf16*)(F.ws + WS_WO)) + (size_t)s * 1024 * 1024, r % I_WO, 0, scr, F.lane); continue; } r -= 2 * I_WO;
        if (r < 8 * I_PW) { const int s = r / I_PW; tr_job(((const float*)kin(12)) + (size_t)s * 256 * 256, 256, 256, ((bf16*)(F.ws + WS_POOLW)) + (size_t)s * 256 * 256, r % I_PW, 0, scr, F.lane); continue; } r -= 8 * I_PW;
        { const int s = r / I_W1; tr_job(((const float*)kin(20)) + (size_t)s * 4096 * 128, 128, 4096, ((bf16*)(F.ws + WS_W1T)) + (size_t)s * 128 * 4096, r % I_W1, 0, scr, F.lane); }
    }
    for (int r = F.gw; r < 256; r += F.NGW) {
        const float* src = r < 2 ? ((const float*)kin(6)) + (size_t)r * D : (r < NBATCH ? ((const float*)kin(7)) + (size_t)(r - 2) * D : nullptr);
        unsigned long long* o8 = (unsigned long long*)(((bf16*)(F.ws + WS_CB)) + (size_t)r * D) + F.lane;
#pragma unroll
        for (int j = 0; j < 4; ++j) { f32x4 v = src ? ((const f32x4*)src)[F.lane + 64 * j] : (f32x4){0.f, 0.f, 0.f, 0.f}; o8[64 * j] = (unsigned long long)pk2(v.x, v.y) | ((unsigned long long)pk2(v.z, v.w) << 32); }
    }
    for (int r = F.gw; r < 2 * (NQGP - 1088); r += F.NGW) { const int s = r / (NQGP - 1088), rr = 1088 + r % (NQGP - 1088);
        unsigned long long* o8 = (unsigned long long*)(((bf16*)(F.ws + WS_WQG)) + ((size_t)s * NQGP + rr) * D) + F.lane;
#pragma unroll
        for (int j = 0; j < 4; ++j) o8[64 * j] = 0ull; }
    const int gt = F.gw * 64 + F.lane, NGT = F.NGW * 64;
    for (int e = gt; e < 8193 * 8; e += NGT) { const int pos = e >> 3, i = e & 7;
        const float invs[8] = {1.0f, 0.1939227432012558f, 0.03760603070259094f, 0.007292664609849453f, 0.0014142135623842478f, 0.00027424818836152554f, 5.318296098266728e-05f, 1.0313386155758053e-05f};
        float inv = invs[0];
#pragma unroll
        for (int q = 1; q < 8; ++q) inv = (i == q) ? invs[q] : inv;
        const float ang = (float)pos * inv; const double rev = (double)ang * 0.15915494309189535; const float fr = (float)(rev - floor(rev));
        ((f32x2*)((float*)(F.ws + WS_ROPE)))[e] = (f32x2){__builtin_amdgcn_cosf(fr), __builtin_amdgcn_sinf(fr)}; }
    for (int o = F.gw; o < 256; o += F.NGW) { const int slot = o >> 7, hid = o & 127; float s = 0.f;
        for (int k = F.lane; k < 4096; k += 64) s += ((const float*)kin(19))[slot * 4096 + k] * ((const float*)kin(20))[((size_t)slot * 4096 + k) * 128 + hid];
        s = wave_sum(s); if (F.lane == 0) ((float*)(F.ws + WS_BIASPE))[o] = s; }
    for (int e = gt; e < 32 * 511 * 128; e += NGT) { const int s = e / (511 * 128), r = e % (511 * 128), i = r >> 7, c = r & 127;
        ((f32x4*)(F.out + O_WINS))[((size_t)s * 512 + i) * 128 + c] = ((const f32x4*)((const float*)kin(3)))[((size_t)s * 512 + i + 1) * 128 + c]; }
}

__device__ __forceinline__ const float* xrow(const float* lo, const float* hi, int row) { return row < MP ? lo + (size_t)row * D : hi + (size_t)(row - MP) * D; }
__device__ __forceinline__ void load_row(const float* p, int lane, f32x4 (&v)[4]) {
#pragma unroll
    for (int j = 0; j < 4; ++j) v[j] = ((const f32x4*)p)[lane + 64 * j];
}
__device__ __forceinline__ float row_rstd(const f32x4 (&v)[4]) { float s = 0.f;
#pragma unroll
    for (int j = 0; j < 4; ++j) s += (v[j].x * v[j].x + v[j].y * v[j].y) + (v[j].z * v[j].z + v[j].w * v[j].w);
    return rsqrtf(wave_sum(s) * (1.f / D) + EPS); }
__device__ __forceinline__ void load_mod(const float* mods, int bi, int off, const float* gain, int lane, f32x4 (&A)[4], f32x4 (&S)[4]) {
    const float* mp = mods + (size_t)bi * NADA + off;
#pragma unroll
    for (int j = 0; j < 4; ++j) { const f32x4 g = ((const f32x4*)gain)[lane + 64 * j], sc = ((const f32x4*)(mp + 1024))[lane + 64 * j]; A[j] = g * (sc + 1.f); S[j] = ((const f32x4*)mp)[lane + 64 * j]; }
}
__device__ __forceinline__ void store_row_bf16(bf16* p, int lane, const f32x4 (&v)[4]) {
    unsigned long long* o8 = (unsigned long long*)p + lane;
#pragma unroll
    for (int j = 0; j < 4; ++j) o8[64 * j] = (unsigned long long)pk2(v[j].x, v[j].y) | ((unsigned long long)pk2(v[j].z, v[j].w) << 32);
}
__device__ __forceinline__ void pass_h(Ctx& F, int l, const float* xlo, const float* xhi) {
    const int off = (l * 2 + 0) * 3072; const float* gain = ((const float*)kin(10)) + l * D;
    for (int ch = F.gw; ch < MP / 8; ch += F.NGW) {
        const int b = ch >> 10; f32x4 A[4], S[4]; load_mod(((float*)(F.ws + WS_MODS)), b, off, gain, F.lane, A, S);
        for (int rb = 0; rb < 8; rb += 4) {
            f32x4 v[4][4];
#pragma unroll
            for (int r = 0; r < 4; ++r) load_row(xrow(xlo, xhi, ch * 8 + rb + r), F.lane, v[r]);
#pragma unroll
            for (int r = 0; r < 4; ++r) { const int row = ch * 8 + rb + r, t = row & (SEQ - 1); const float rs = row_rstd(v[r]);
#pragma unroll
                for (int j = 0; j < 4; ++j) { v[r][j] = v[r][j] * rs * A[j] + S[j]; ((f32x4*)(((float*)(F.ws + WS_H0)) + (size_t)row * D))[F.lane + 64 * j] = v[r][j]; }
                if (t >= SEQ - 15) { float* po = F.out + O_POOLP + ((size_t)(l * 2 + b) * 15 + (t - (SEQ - 15))) * D;
#pragma unroll
                    for (int j = 0; j < 4; ++j) ((f32x4*)po)[F.lane + 64 * j] = v[r][j]; } } }
    }
    for (int s = F.gw; s < NBS; s += F.NGW) {
        const int row = MP + s; f32x4 A[4], S[4], v[4]; load_mod(((float*)(F.ws + WS_MODS)), 2 + s, off, gain, F.lane, A, S); load_row(xrow(xlo, xhi, row), F.lane, v); const float rs = row_rstd(v);
        const float* sp = ((const float*)kin(4)) + ((size_t)(l * 32 + s) * 15) * D; float* po = F.out + O_POOLS + ((size_t)(l * 32 + s) * 15) * D; f32x4 pl[4];
#pragma unroll
        for (int j = 0; j < 4; ++j) { v[j] = v[j] * rs * A[j] + S[j]; const int w = 2 << j; f32x4 sum = v[j];
            for (int k = 1; k < w; ++k) sum += ((const f32x4*)(sp + (size_t)(15 - k) * D))[F.lane + 64 * j];
            pl[j] = sum * (1.f / (float)w) - v[j]; ((f32x4*)(po + (size_t)14 * D))[F.lane + 64 * j] = v[j]; }
        store_row_bf16(((bf16*)(F.ws + WS_XN2)) + (size_t)row * D, F.lane, pl);
        for (int i = 0; i < 14; ++i)
#pragma unroll
            for (int j = 0; j < 4; ++j) ((f32x4*)(po + (size_t)i * D))[F.lane + 64 * j] = ((const f32x4*)(sp + (size_t)(i + 1) * D))[F.lane + 64 * j];
    }
}
__device__ __forceinline__ void pass_pool(Ctx& F) {
    for (int ch = F.gw; ch < MP / 8; ch += F.NGW) {
        const int row0 = ch * 8, t0 = row0 & (SEQ - 1); f32x4 Sw[4];
#pragma unroll
        for (int j = 0; j < 4; ++j) { const int w = 2 << j; Sw[j] = (f32x4){0.f, 0.f, 0.f, 0.f};
            for (int k = 1; k < w; ++k) if (t0 - k >= 0) Sw[j] += ((const f32x4*)(((float*)(F.ws + WS_H0)) + (size_t)(row0 - k) * D))[F.lane + 64 * j]; }
        for (int r = 0; r < 8; ++r) { const int row = row0 + r, t = t0 + r; f32x4 h[4], pl[4]; load_row(((float*)(F.ws + WS_H0)) + (size_t)row * D, F.lane, h);
#pragma unroll
            for (int j = 0; j < 4; ++j) { const int w = 2 << j; Sw[j] += h[j]; const int cnt = (t + 1) < w ? (t + 1) : w; pl[j] = Sw[j] * (1.f / (float)cnt) - h[j];
                if (t - w + 1 >= 0) Sw[j] -= ((const f32x4*)(((float*)(F.ws + WS_H0)) + (size_t)(row - w + 1) * D))[F.lane + 64 * j]; }
            store_row_bf16(((bf16*)(F.ws + WS_XN2)) + (size_t)row * D, F.lane, pl); }
    }
}
__device__ __forceinline__ void pass_norm(Ctx& F, const float* xlo, const float* xhi, const float* gain1, int off1, bf16* out1, const float* gain2, int off2, bf16* out2) {
    const float* mods = (const float*)(F.ws + WS_MODS);
    for (int ch = F.gw; ch < (MR + 7) / 8; ch += F.NGW) {
        const int row0 = ch * 8; const bool uni = row0 < MP; f32x4 A1[4], S1[4], A2[4], S2[4];
        if (uni) { load_mod(mods, row0 >> 13, off1, gain1, F.lane, A1, S1); if (out2) load_mod(mods, row0 >> 13, off2, gain2, F.lane, A2, S2); }
        for (int rb = 0; rb < 8; rb += 4) {
            f32x4 v[4][4];
#pragma unroll
            for (int r = 0; r < 4; ++r) { const int row = (row0 + rb + r) < MR ? (row0 + rb + r) : MR - 1; load_row(xrow(xlo, xhi, row), F.lane, v[r]); }
#pragma unroll
            for (int r = 0; r < 4; ++r) { const int row = row0 + rb + r; if (row < MR) {
                if (!uni) { load_mod(mods, bidx_of(row), off1, gain1, F.lane, A1, S1); if (out2) load_mod(mods, bidx_of(row), off2, gain2, F.lane, A2, S2); }
                f32x4 o[4]; const float rs = row_rstd(v[r]);
#pragma unroll
                for (int j = 0; j < 4; ++j) o[j] = v[r][j] * rs * A1[j] + S1[j];
                store_row_bf16(out1 + (size_t)row * D, F.lane, o);
                if (out2) {
#pragma unroll
                    for (int j = 0; j < 4; ++j) o[j] = v[r][j] * rs * A2[j] + S2[j];
                    store_row_bf16(out2 + (size_t)row * D, F.lane, o); } } }
        }
    }
}
__device__ __forceinline__ f32x4 head_norm_rope(f32x4 v, const float* gain  , const float* ropep  , int lane) {
    const int q = lane & 15; float ss = (v.x * v.x + v.y * v.y) + (v.z * v.z + v.w * v.w);
    ss += __shfl_xor(ss, 1); ss += __shfl_xor(ss, 2); ss += __shfl_xor(ss, 4); ss += __shfl_xor(ss, 8);
    v = v * rsqrtf(ss * (1.f / 64.f) + EPS) * *(const f32x4*)(gain + 4 * q);
    f32x4 o; o.x = __shfl_xor(v.x, 2); o.y = __shfl_xor(v.y, 2); o.z = __shfl_xor(v.z, 2); o.w = __shfl_xor(v.w, 2);
    if (q < 4) { const f32x4 c0 = *(const f32x4*)(ropep + 8 * (q & 1)), c1 = *(const f32x4*)(ropep + 8 * (q & 1) + 4); const f32x4 cv = {c0.x, c0.z, c1.x, c1.z}, sv = {c0.y, c0.w, c1.y, c1.w};
        v = (q < 2) ? v * cv - o * sv : v * cv + o * sv; }
    return v;
}
__device__ __forceinline__ unsigned long long pk4(f32x4 v) { return (unsigned long long)pk2(v.x, v.y) | ((unsigned long long)pk2(v.z, v.w) << 32); }
__device__ __forceinline__ void skinny_res(Ctx& F, const bf16* As, int lda, int a_grp_off, const bf16* Bt, int ldb, int K, const float* in_hi, float* out_hi, const float* mods, int gate_off, const float* cscale) {
    if (F.vcu >= 64) return;
    const int lane = F.lane, w = F.wave, n = lane & 15, kq = lane >> 4, c0 = 16 * F.vcu;
    const bf16* ap = As + (size_t)n * lda + (c0 >> 8) * a_grp_off + 8 * kq; const bf16* bp = Bt + (size_t)(c0 + n) * ldb + 8 * kq;
    const int kper = K >> 3; f32x4 acc0 = {0.f, 0.f, 0.f, 0.f}, acc1 = {0.f, 0.f, 0.f, 0.f};
    for (int k = w * kper; k < (w + 1) * kper; k += 32) {
        const bf16x8 a0 = *(const bf16x8*)(ap + k), a1 = *(const bf16x8*)(ap + (size_t)16 * lda + k), bb = *(const bf16x8*)(bp + k);
        acc0 = __builtin_amdgcn_mfma_f32_16x16x32_bf16(a0, bb, acc0, 0, 0, 0); acc1 = __builtin_amdgcn_mfma_f32_16x16x32_bf16(a1, bb, acc1, 0, 0, 0); }
    LAS f32x4* red = (LAS f32x4*)F.lds;
    red[(w * 2 + 0) * 64 + lane] = acc0; red[(w * 2 + 1) * 64 + lane] = acc1;
    __syncthreads();
    if (w < 2) { f32x4 a = red[w * 64 + lane];
#pragma unroll
        for (int ww = 1; ww < 8; ++ww) a += red[(ww * 2 + w) * 64 + lane];
        const int col = c0 + n; const float cs = cscale ? cscale[col] : 1.f;
#pragma unroll
        for (int i = 0; i < 4; ++i) { const int srow = 16 * w + 4 * kq + i; const float gt = mods[(size_t)(2 + srow) * NADA + gate_off + col] * cs;
            out_hi[(size_t)srow * D + col] = in_hi[(size_t)srow * D + col] + gt * a[i]; } }
    __syncthreads();
}

__device__ __forceinline__ float gelu_tanh(float x) { const float u = 0.7978845608028654f * (x + 0.044715f * x * x * x); return x * __builtin_amdgcn_rcpf(1.f + __builtin_amdgcn_exp2f(-2.f * 1.4426950408889634f * u)); }
__device__ __forceinline__ bf16x8 pack8(const f32x4 a, const f32x4 b) { v4u w; w.x = pk2(a.x, a.y); w.y = pk2(a.z, a.w); w.z = pk2(b.x, b.y); w.w = pk2(b.z, b.w); return __builtin_bit_cast(bf16x8, w); }
__device__ __forceinline__ void compress_phase(Ctx& F) {
    const int lane = F.lane, wid = F.wave, tid = F.tid, n = lane & 15, kq = lane >> 4;
    const int nper = (NBLKT + F.G - 1) / F.G, c0 = F.vcu * nper; int n_cu = NBLKT - c0; n_cu = n_cu < 0 ? 0 : (n_cu > nper ? nper : n_cu);
    if (nper > 32) return;
    const int nbw = (nper + 7) / 8, bw0 = wid * nbw; int nb_w = n_cu - bw0; nb_w = nb_w < 0 ? 0 : (nb_w > nbw ? nbw : nb_w);
    const int bl = n >> 2, kvh = n & 3; const bool vcol = bl < nb_w;
    int gblk = c0 + bw0 + (vcol ? bl : 0); gblk = gblk < NBLKT ? gblk : NBLKT - 1;
    const int bb = gblk >> 7, blk = gblk & 127;
    const float* base = bb < 2 ? F.out + O_KV + ((size_t)(bb * SEQ + blk * 64)) * 1024 : ((const float*)kin(2)) + ((size_t)((const int*)kin(5))[(bb - 2) * 64 + (blk >> 1)] * 128 + (blk & 1) * 64) * 1024;
    const float* lp = base + kvh * 64 + 8 * kq;
    unsigned soff[2];
#pragma unroll
    for (int i = 0; i < 2; ++i) { int R, C; pg8::stage_rc(tid * 16 + i * 8192, R, C); soff[i] = (unsigned)(R * 4096 + C) * 2u; }
    const int foff = pg8::lds_byte(n, kq * 8);
    LAS unsigned char* lds = F.lds;
#define CSTAGE(buf, s) do { _Pragma("unroll") for (int sl = 0; sl < 2; ++sl) _Pragma("unroll") for (int _i = 0; _i < 2; ++_i) \
        __builtin_amdgcn_global_load_lds((const unsigned*)((const char*)(((bf16*)(F.ws + WS_W1T)) + (size_t)sl * 128 * 4096 + (size_t)(s) * 64) + soff[_i]), (LAS unsigned*)(lds + ((buf) * 2 + sl) * 16384 + wid * 1024 + _i * 8192), 16, 0, 0); } while (0)
    f32x4 acc[2][8];
#pragma unroll
    for (int sl = 0; sl < 2; ++sl)
#pragma unroll
        for (int mt = 0; mt < 8; ++mt) acc[sl][mt] = (f32x4){0.f, 0.f, 0.f, 0.f};
    f32x4 raw[3][2][2][2];
#define CLOAD(s, r) do { _Pragma("unroll") for (int sl = 0; sl < 2; ++sl) _Pragma("unroll") for (int e = 0; e < 2; ++e) { const float* p_ = lp + (size_t)(s) * 1024 + sl * 256 + 32 * e; raw[r][sl][e][0] = *(const f32x4*)p_; raw[r][sl][e][1] = *(const f32x4*)(p_ + 4); } } while (0)
#define CITER(s, r) do { \
        if ((s) + 1 < 64) asm volatile("s_waitcnt vmcnt(12)" ::: "memory"); else asm volatile("s_waitcnt vmcnt(0)" ::: "memory"); \
        __builtin_amdgcn_s_barrier(); asm volatile("" ::: "memory"); \
        if ((s) + 2 < 64) { CSTAGE(((r) + 2) % 3, (s) + 2); CLOAD((s) + 2, ((r) + 2) % 3); } \
        bf16x8 bfr[2][2]; \
        _Pragma("unroll") for (int sl = 0; sl < 2; ++sl) _Pragma("unroll") for (int e = 0; e < 2; ++e) bfr[sl][e] = pack8(raw[r][sl][e][0], raw[r][sl][e][1]); \
        _Pragma("unroll") for (int sl = 0; sl < 2; ++sl) _Pragma("unroll") for (int e = 0; e < 2; ++e) { bf16x8 af[8]; \
            _Pragma("unroll") for (int mt = 0; mt < 8; ++mt) af[mt] = *(const LAS bf16x8*)(lds + ((r) * 2 + sl) * 16384 + foff + mt * 2048 + e * 1024); \
            _Pragma("unroll") for (int mt = 0; mt < 8; ++mt) acc[sl][mt] = __builtin_amdgcn_mfma_f32_16x16x32_bf16(af[mt], bfr[sl][e], acc[sl][mt], 0, 0, 0); \
            __builtin_amdgcn_sched_barrier(0); } \
    } while (0)
    __syncthreads();
    CSTAGE(0, 0); CLOAD(0, 0); CSTAGE(1, 1); CLOAD(1, 1);
    for (int s0 = 0; s0 < 60; s0 += 12) { CITER(s0, 0); CITER(s0 + 1, 1); CITER(s0 + 2, 2); CITER(s0 + 3, 0); CITER(s0 + 4, 1); CITER(s0 + 5, 2); CITER(s0 + 6, 0); CITER(s0 + 7, 1); CITER(s0 + 8, 2); CITER(s0 + 9, 0); CITER(s0 + 10, 1); CITER(s0 + 11, 2); }
    CITER(60, 0); CITER(61, 1); CITER(62, 2); CITER(63, 0);
#undef CITER
#undef CSTAGE
#undef CLOAD
#pragma unroll
    for (int sl = 0; sl < 2; ++sl) {
        bf16x8 hb[4];
#pragma unroll
        for (int e2 = 0; e2 < 4; ++e2) { f32x4 a = acc[sl][2 * e2] + *(const f32x4*)(((float*)(F.ws + WS_BIASPE)) + sl * 128 + 32 * e2 + 4 * kq), b = acc[sl][2 * e2 + 1] + *(const f32x4*)(((float*)(F.ws + WS_BIASPE)) + sl * 128 + 32 * e2 + 16 + 4 * kq);
            a = (f32x4){gelu_tanh(a.x), gelu_tanh(a.y), gelu_tanh(a.z), gelu_tanh(a.w)}; b = (f32x4){gelu_tanh(b.x), gelu_tanh(b.y), gelu_tanh(b.z), gelu_tanh(b.w)}; hb[e2] = pack8(a, b); }
        f32x4 o[4];
        const float* w2b = ((const float*)kin(21)) + (size_t)sl * 128 * 64 + n;
#pragma unroll
        for (int mt2 = 0; mt2 < 4; ++mt2) { o[mt2] = (f32x4){0.f, 0.f, 0.f, 0.f};
#pragma unroll
            for (int e2 = 0; e2 < 4; ++e2) { const float* w2 = w2b + 16 * mt2; float wv[8];
#pragma unroll
                for (int jj = 0; jj < 8; ++jj) wv[jj] = w2[(size_t)(32 * e2 + 16 * (jj >> 2) + 4 * kq + (jj & 3)) * 64];
                const bf16x8 a = pack8((f32x4){wv[0], wv[1], wv[2], wv[3]}, (f32x4){wv[4], wv[5], wv[6], wv[7]});
                o[mt2] = __builtin_amdgcn_mfma_f32_16x16x32_bf16(a, hb[e2], o[mt2], 0, 0, 0); __builtin_amdgcn_sched_barrier(0); } }
        if (sl == 0) {
            float ss = 0.f;
#pragma unroll
            for (int mt2 = 0; mt2 < 4; ++mt2) ss += (o[mt2].x * o[mt2].x + o[mt2].y * o[mt2].y) + (o[mt2].z * o[mt2].z + o[mt2].w * o[mt2].w);
            ss += __shfl_xor(ss, 16); ss += __shfl_xor(ss, 32);
            const float rs = rsqrtf(ss * (1.f / 64.f) + EPS);
#pragma unroll
            for (int mt2 = 0; mt2 < 4; ++mt2) o[mt2] = o[mt2] * rs * *(const f32x4*)(((const float*)kin(18)) + 16 * mt2 + 4 * kq);
            const int pos = (blk + 1) * 64 - 1; const float* rp = ((float*)(F.ws + WS_ROPE)) + (size_t)pos * 16 + (4 * (kq & 1)) * 2;
            f32x4 other; other.x = __shfl_xor(o[0].x, 32); other.y = __shfl_xor(o[0].y, 32); other.z = __shfl_xor(o[0].z, 32); other.w = __shfl_xor(o[0].w, 32);
            const f32x4 cs0 = *(const f32x4*)rp, cs1 = *(const f32x4*)(rp + 4); const f32x4 cv = {cs0.x, cs0.z, cs1.x, cs1.z}, sv = {cs0.y, cs0.w, cs1.y, cs1.w};
            o[0] = (kq < 2) ? o[0] * cv - other * sv : o[0] * cv + other * sv;
        }
        if (vcol) { float* dst = (sl == 0 ? ((float*)(F.ws + WS_KC)) : ((float*)(F.ws + WS_VC))) + ((size_t)(bb * NBLK + blk) * 4 + kvh) * 64 + 4 * kq;
#pragma unroll
            for (int mt2 = 0; mt2 < 4; ++mt2) *(f32x4*)(dst + 16 * mt2) = o[mt2];
            if (sl == 0) { bf16* kb = ((bf16*)(F.ws + WS_KCB)) + ((size_t)((bb * 4 + kvh) * NBLK + blk)) * 64 + 4 * kq;
#pragma unroll
                for (int mt2 = 0; mt2 < 4; ++mt2) *(unsigned long long*)(kb + 16 * mt2) = pk4(o[mt2]); }
            else { bf16* vt = ((bf16*)(F.ws + WS_VCT)) + ((size_t)((bb * 4 + kvh) * 64 + 4 * kq)) * NBLK + blk;
#pragma unroll
                for (int mt2 = 0; mt2 < 4; ++mt2) { vt[(size_t)(16 * mt2 + 0) * NBLK] = (bf16)f2bf(o[mt2].x); vt[(size_t)(16 * mt2 + 1) * NBLK] = (bf16)f2bf(o[mt2].y); vt[(size_t)(16 * mt2 + 2) * NBLK] = (bf16)f2bf(o[mt2].z); vt[(size_t)(16 * mt2 + 3) * NBLK] = (bf16)f2bf(o[mt2].w); } } }
    }
    __syncthreads();
}

struct Soft { float m[4], l[4], o[4]; };
__device__ __forceinline__ void soft_init(Soft& s) {
#pragma unroll
    for (int g = 0; g < 4; ++g) { s.m[g] = -1e30f; s.l[g] = 0.f; s.o[g] = 0.f; } }
template <class KF, class VF>
__device__ __forceinline__ void attn_block64(LAS float* qs, LAS float* ps, bool valid, KF kf, VF vf, Soft& st, float (&sc)[4], int lane) {
#pragma unroll
    for (int g = 0; g < 4; ++g) sc[g] = 0.f;
#pragma unroll
    for (int d8 = 0; d8 < 8; ++d8) { float kv[8]; kf(d8, kv);
#pragma unroll
        for (int g = 0; g < 4; ++g) { const f32x4 q0 = *(const LAS f32x4*)(qs + g * 64 + d8 * 8), q1 = *(const LAS f32x4*)(qs + g * 64 + d8 * 8 + 4);
            sc[g] += (q0.x * kv[0] + q0.y * kv[1]) + (q0.z * kv[2] + q0.w * kv[3]) + (q1.x * kv[4] + q1.y * kv[5]) + (q1.z * kv[6] + q1.w * kv[7]); } }
    f32x4 pv;
#pragma unroll
    for (int g = 0; g < 4; ++g) { const float sg = valid ? sc[g] : -1e30f; const float mn = fmaxf(st.m[g], wave_max(sg));
        const float p = valid ? __builtin_amdgcn_exp2f(sg - mn) : 0.f; const float corr = __builtin_amdgcn_exp2f(st.m[g] - mn);
        st.l[g] = st.l[g] * corr + wave_sum(p); st.o[g] *= corr; st.m[g] = mn; pv[g] = p; }
    *(LAS f32x4*)(ps + lane * 4) = pv;
    LDS_WAIT(); asm volatile("" ::: "memory");
#pragma unroll 32
    for (int key = 0; key < 64; ++key) { const f32x4 pp = *(const LAS f32x4*)(ps + key * 4); const float v = vf(key);
        st.o[0] += pp.x * v; st.o[1] += pp.y * v; st.o[2] += pp.z * v; st.o[3] += pp.w * v; }
    LDS_WAIT(); asm volatile("" ::: "memory");
}
__device__ __forceinline__ void ld8_bf16(const bf16* p, float (&kv)[8]) { const v4u w = *(const v4u*)p;
    kv[0] = __builtin_bit_cast(float, w.x << 16); kv[1] = __builtin_bit_cast(float, w.x & 0xffff0000u); kv[2] = __builtin_bit_cast(float, w.y << 16); kv[3] = __builtin_bit_cast(float, w.y & 0xffff0000u);
    kv[4] = __builtin_bit_cast(float, w.z << 16); kv[5] = __builtin_bit_cast(float, w.z & 0xffff0000u); kv[6] = __builtin_bit_cast(float, w.w << 16); kv[7] = __builtin_bit_cast(float, w.w & 0xffff0000u); }
__device__ __forceinline__ void ld8_f32(const float* p, float (&kv)[8]) { const f32x4 a = *(const f32x4*)p, b = *(const f32x4*)(p + 4); kv[0] = a.x; kv[1] = a.y; kv[2] = a.z; kv[3] = a.w; kv[4] = b.x; kv[5] = b.y; kv[6] = b.z; kv[7] = b.w; }

__device__ __forceinline__ void cmp_and_select(Ctx& F, LAS float* qs, LAS float* ps, int bb, int kvh, int t, float (&oc)[4], unsigned long long& msk0, unsigned long long& msk1) {
    const int lane = F.lane, cur = t >> 6; Soft st; soft_init(st); float sc0[4], sc1[4];
    const float* kcb = ((float*)(F.ws + WS_KC)) + ((size_t)bb * NBLK * 4 + kvh) * 64; const float* vcb = ((float*)(F.ws + WS_VC)) + ((size_t)bb * NBLK * 4 + kvh) * 64;
    const bool v0 = (lane + 1) * 64 - 1 <= t, v1 = (lane + 65) * 64 - 1 <= t;
    attn_block64(qs, ps, v0, [&](int d8, float (&kv)[8]) { ld8_f32(kcb + (size_t)lane * 256 + d8 * 8, kv); }, [&](int key) { return vcb[(size_t)key * 256 + lane]; }, st, sc0, lane);
    attn_block64(qs, ps, v1, [&](int d8, float (&kv)[8]) { ld8_f32(kcb + (size_t)(64 + lane) * 256 + d8 * 8, kv); }, [&](int key) { return vcb[(size_t)(64 + key) * 256 + lane]; }, st, sc1, lane);
    float imp0 = 0.f, imp1 = 0.f;
#pragma unroll
    for (int g = 0; g < 4; ++g) { const float il = st.l[g] > 0.f ? 1.f / st.l[g] : 0.f; oc[g] = st.o[g] * il;
        imp0 += v0 ? __builtin_amdgcn_exp2f(sc0[g] - st.m[g]) * il : 0.f; imp1 += v1 ? __builtin_amdgcn_exp2f(sc1[g] - st.m[g]) * il : 0.f; }
    bool s0, s1;
    if (cur <= 15) { s0 = lane <= cur; s1 = false; }
    else {
        const int b0 = lane, b1 = lane + 64; const bool c0 = b0 >= 1 && b0 <= cur - 2, c1 = b1 >= 1 && b1 <= cur - 2;
        const float x0 = c0 ? imp0 : -1.f, x1 = c1 ? imp1 : -1.f; int r0 = 0, r1 = 0;
        for (int k = 0; k < 64; ++k) { const float y0 = __shfl(x0, k), y1 = __shfl(x1, k);
            r0 += (y0 > x0 || (y0 == x0 && k < b0)) ? 1 : 0; r0 += (y1 > x0 || (y1 == x0 && (k + 64) < b0)) ? 1 : 0;
            r1 += (y0 > x1 || (y0 == x1 && k < b1)) ? 1 : 0; r1 += (y1 > x1 || (y1 == x1 && (k + 64) < b1)) ? 1 : 0; }
        s0 = (b0 == 0) || (b0 == cur) || (b0 == cur - 1) || (c0 && r0 < 13); s1 = (b1 == cur) || (b1 == cur - 1) || (c1 && r1 < 13);
    }
    msk0 = __ballot(s0); msk1 = __ballot(s1);
}
__device__ __forceinline__ void attn_sample_wg(Ctx& F) {
    const int lane = F.lane, w = F.wave;
    LAS float* qs = (LAS float*)F.lds;
    LAS float* ps = (LAS float*)(F.lds + 1024 + w * 1024);
    LAS unsigned* msk = (LAS unsigned*)(F.lds + 16384);
    LAS float* ocs = (LAS float*)(F.lds + 16384 + 64);
    LAS float* part = (LAS float*)(F.lds + 20480);
    const float* cache = (const float*)kin(2); const int* ptab = (const int*)kin(5);
    for (int task = F.vcu; task < NBS * 4; task += F.G) {
        const int s = task >> 2, kvh = task & 3, row = MP + s, t = SEQ;
        if (w == 0) {
#pragma unroll
            for (int g = 0; g < 4; ++g) qs[g * 64 + lane] = bf2f(((const bf16*)(F.ws + WS_QB))[(size_t)row * D + (kvh * 4 + g) * 64 + lane]);
        }
        __syncthreads();
        if (w == 0) { float oc[4]; unsigned long long m0, m1; cmp_and_select(F, qs, ps, 2 + s, kvh, t, oc, m0, m1);
#pragma unroll
            for (int g = 0; g < 4; ++g) ocs[g * 64 + lane] = oc[g];
            if (lane == 0) { msk[0] = (unsigned)m0; msk[1] = (unsigned)(m0 >> 32); msk[2] = (unsigned)m1; msk[3] = (unsigned)(m1 >> 32); } }
        __syncthreads();
        Soft ss, sw; soft_init(ss); soft_init(sw); float scd[4];
        { int cnt = 0;
            for (int wd = 0; wd < 4; ++wd) { unsigned mm = (unsigned)__builtin_amdgcn_readfirstlane((int)msk[wd]);
                while (mm) { const int j = __builtin_ctz(mm) + 32 * wd; mm &= mm - 1; const bool mine = (cnt & 7) == w; ++cnt; if (!mine) continue;
                    const float* pg = cache + ((size_t)ptab[s * 64 + (j >> 1)] * 128 + (j & 1) * 64) * 1024;
                    const float* kb = pg + (size_t)lane * 1024 + 512 + kvh * 64; const float* vb = pg + 768 + kvh * 64 + lane;
                    attn_block64(qs, ps, true, [&](int d8, float (&kv)[8]) { ld8_f32(kb + d8 * 8, kv); }, [&](int key) { return vb[(size_t)key * 1024]; }, ss, scd, lane); } }
            if ((cnt & 7) == w) { const float* nr = F.out + O_KV + (size_t)row * 1024;
                attn_block64(qs, ps, lane == 0, [&](int d8, float (&kv)[8]) { ld8_f32(nr + 512 + kvh * 64 + d8 * 8, kv); }, [&](int) { return nr[768 + kvh * 64 + lane]; }, ss, scd, lane); }
            ++cnt;
            const float* wb = F.out + O_WINS + (size_t)s * 512 * 512;
            for (int c = 0; c < 8; ++c, ++cnt) if ((cnt & 7) == w) { const float* kb = wb + (size_t)(64 * c + lane) * 512 + kvh * 64; const float* vb = wb + (size_t)(64 * c) * 512 + 256 + kvh * 64 + lane;
                attn_block64(qs, ps, true, [&](int d8, float (&kv)[8]) { ld8_f32(kb + d8 * 8, kv); }, [&](int key) { return vb[(size_t)key * 512]; }, sw, scd, lane); } }
#pragma unroll
        for (int g = 0; g < 4; ++g) { LAS float* p0 = part + ((w * 2 + 0) * 4 + g) * 66; LAS float* p1 = part + ((w * 2 + 1) * 4 + g) * 66;
            if (lane == 0) { p0[0] = ss.m[g]; p0[1] = ss.l[g]; p1[0] = sw.m[g]; p1[1] = sw.l[g]; } p0[2 + lane] = ss.o[g]; p1[2 + lane] = sw.o[g]; }
        __syncthreads();
        if (w < 4) { const int g = w; float res[2];
#pragma unroll
            for (int kd = 0; kd < 2; ++kd) { float M = -1e30f;
#pragma unroll
                for (int ww = 0; ww < 8; ++ww) M = fmaxf(M, part[((ww * 2 + kd) * 4 + g) * 66]);
                float L = 0.f, O = 0.f;
#pragma unroll
                for (int ww = 0; ww < 8; ++ww) { const LAS float* pp = part + ((ww * 2 + kd) * 4 + g) * 66; const float f = __builtin_amdgcn_exp2f(pp[0] - M); L += pp[1] * f; O += pp[2 + lane] * f; }
                res[kd] = L > 0.f ? O / L : 0.f; }
            const float* gt = (const float*)(F.ws + WS_GATES) + (size_t)row * 48 + (kvh * 4 + g) * 3;
            ((bf16*)(F.ws + WS_OB))[(size_t)row * D + (kvh * 4 + g) * 64 + lane] = (bf16)f2bf(gt[0] * ocs[g * 64 + lane] + gt[1] * res[0] + gt[2] * res[1]); }
        __syncthreads();
    }
}

namespace attn_body {
using bf16=__hip_bfloat16;
using bf16x8=__attribute__((ext_vector_type(8)))short;
using s16x4=__attribute__((ext_vector_type(4)))short;
using f32x16=__attribute__((ext_vector_type(16)))float;
using u32x4=__attribute__((ext_vector_type(4)))unsigned;
constexpr int BATCH=2,NHEAD=16,SEQ=8192,D=64,DM=NHEAD*D;
constexpr int NW=8,QBLK=32,QB=QBLK*NW,KVBLK=64,NQB=SEQ/QB;
constexpr int ATTN_PITCH=DM, ATTN_UNIT_ROWS=QB;
__device__ __forceinline__ int crow(int r,int hi){return (r&3)+8*(r>>2)+4*hi;}
#define SBAR() __builtin_amdgcn_sched_barrier(0)
__device__ __forceinline__ void cmask(f32x16&p0,f32x16&p1,int jb,int qrel,int hi){
  const float NEG=-INFINITY; int kb=64*jb+4*hi;
  #pragma unroll
  for(int r=0;r<16;++r){int kv=kb+(r&3)+8*(r>>2); if(kv>qrel)p0[r]=NEG; if(kv+32>qrel)p1[r]=NEG;}
}

__device__ __forceinline__ void lmask(f32x16&p0,f32x16&p1,int k,int qrel,int hi){
  const float NEG=-INFINITY; int kb=64*k+4*hi;
  #pragma unroll
  for(int r=0;r<16;++r){int kv=kb+(r&3)+8*(r>>2); if(kv<=qrel)p0[r]=NEG; if(kv+32<=qrel)p1[r]=NEG;}
}
constexpr int NSLOT=3, SLOTB=8192;
constexpr int LDS_K=0, LDS_V=NSLOT*SLOTB, LDS_WS=2*NSLOT*SLOTB, LDS_OST=LDS_WS+NW*64*4, LDS_BYTES=LDS_OST+NW*4096;
constexpr float C2=0.125f*1.4426950408889634f;
__device__ __forceinline__ void glds16(const void*gsrc,unsigned lds_dst){unsigned keep;
  asm volatile("s_mov_b32 %0, m0\n\ts_mov_b32 m0, %2\n\ts_nop 0\n\tglobal_load_lds_dwordx4 %1, off\n\ts_mov_b32 m0, %0":"=&s"(keep):"v"(gsrc),"s"(lds_dst):"memory");}
__device__ __forceinline__ float max3f(float a,float b,float c){float r;asm("v_max3_f32 %0, %1, %2, %3":"=v"(r):"v"(a),"v"(b),"v"(c));return r;}
__device__ __forceinline__ float max2f(float a,float b){float r;asm("v_max_f32_e32 %0, %1, %2":"=v"(r):"v"(a),"v"(b));return r;}
__device__ __forceinline__ float fadd_s(float a,float b){float r;asm("v_add_f32_e32 %0, %1, %2":"=v"(r):"v"(a),"v"(b));return r;}
__device__ __forceinline__ float fsub_s(float a,float b){float r;asm("v_sub_f32_e32 %0, %1, %2":"=v"(r):"v"(a),"v"(b));return r;}
typedef float f32x2_t __attribute__((ext_vector_type(2))); typedef __bf16 bf16x2_t __attribute__((ext_vector_type(2)));
__device__ __forceinline__ unsigned cvtpk_s(float lo,float hi){f32x2_t v={lo,hi};bf16x2_t b=__builtin_convertvector(v,bf16x2_t);return __builtin_bit_cast(unsigned,b);}
#define WAIT_BAR(N) asm volatile("s_waitcnt vmcnt(" #N ") lgkmcnt(0)\n\ts_barrier":::"memory")

__device__ __forceinline__ void qkt(f32x16&p0,f32x16&p1,const char*Kslot,const bf16x8*qr,const f32x16&negm,int r32,int hi){
  const char*kb=Kslot+hi*1024+r32*16;
  #pragma unroll
  for(int d0=0;d0<4;++d0){
    const bf16x8 b0=*reinterpret_cast<const bf16x8*>(kb+d0*2048);
    const bf16x8 b1=*reinterpret_cast<const bf16x8*>(kb+d0*2048+512);
    if(d0==0){p0=__builtin_amdgcn_mfma_f32_32x32x16_bf16(b0,qr[0],negm,0,0,0);p1=__builtin_amdgcn_mfma_f32_32x32x16_bf16(b1,qr[0],negm,0,0,0);}
    else{p0=__builtin_amdgcn_mfma_f32_32x32x16_bf16(b0,qr[d0],p0,0,0,0);p1=__builtin_amdgcn_mfma_f32_32x32x16_bf16(b1,qr[d0],p1,0,0,0);}}
}
typedef __attribute__((address_space(3))) const char* lds_cptr;
typedef short v4i16_t __attribute__((ext_vector_type(4)));
__device__ __forceinline__ void kload8(bf16x8*kf,lds_cptr kp){
  kf[0]=*(const __attribute__((address_space(3))) bf16x8*)(kp);      kf[1]=*(const __attribute__((address_space(3))) bf16x8*)(kp+512);
  kf[2]=*(const __attribute__((address_space(3))) bf16x8*)(kp+2048); kf[3]=*(const __attribute__((address_space(3))) bf16x8*)(kp+2560);
  kf[4]=*(const __attribute__((address_space(3))) bf16x8*)(kp+4096); kf[5]=*(const __attribute__((address_space(3))) bf16x8*)(kp+4608);
  kf[6]=*(const __attribute__((address_space(3))) bf16x8*)(kp+6144); kf[7]=*(const __attribute__((address_space(3))) bf16x8*)(kp+6656);
}
__device__ __forceinline__ void kload2(bf16x8*kf,lds_cptr kp,int j){ kf[2*j]=*(const __attribute__((address_space(3))) bf16x8*)(kp+j*2048); kf[2*j+1]=*(const __attribute__((address_space(3))) bf16x8*)(kp+j*2048+512); }
__device__ __forceinline__ s16x4 vtr(lds_cptr p){ return __builtin_bit_cast(s16x4,__builtin_amdgcn_ds_read_tr16_b64_v4i16((__attribute__((address_space(3))) v4i16_t*)p)); }
__device__ __forceinline__ float rowmax(const f32x16&p0,const f32x16&p1){
  float a=max3f(p0[0],p0[1],p1[0]),b=max3f(p0[2],p0[3],p1[1]);a=max3f(a,p1[2],p1[3]);
  #pragma unroll
  for(int r=4;r<16;r+=4){a=max3f(a,p0[r],p0[r+1]);b=max3f(b,p0[r+2],p0[r+3]);a=max3f(a,p1[r],p1[r+1]);b=max3f(b,p1[r+2],p1[r+3]);}
  const float m=max2f(a,b);
  auto rr=__builtin_amdgcn_permlane32_swap(__float_as_uint(m),__float_as_uint(m),false,false);
  return max2f(__uint_as_float(rr[0]),__uint_as_float(rr[1]));
}
__device__ __forceinline__ void pv(f32x16*o,int vb,bf16x8 pa0,bf16x8 pa1,bf16x8 pa2,bf16x8 pa3){
  #pragma unroll
  for(int d0=0;d0<2;++d0){s16x4 lo[4],hi[4];
    #pragma unroll
    for(int ks=0;ks<4;++ks){
      asm volatile("ds_read_b64_tr_b16 %0,%1 offset:%c2":"=&v"(lo[ks]):"v"(vb),"i"(d0*4096+ks*1024):"memory");
      asm volatile("ds_read_b64_tr_b16 %0,%1 offset:%c2":"=&v"(hi[ks]):"v"(vb),"i"(d0*4096+ks*1024+512):"memory");}
    asm volatile("s_waitcnt lgkmcnt(0)":::"memory");SBAR();
    #define PK(k) (bf16x8){lo[k][0],lo[k][1],lo[k][2],lo[k][3],hi[k][0],hi[k][1],hi[k][2],hi[k][3]}
    o[d0]=__builtin_amdgcn_mfma_f32_32x32x16_bf16(pa0,PK(0),o[d0],0,0,0);
    o[d0]=__builtin_amdgcn_mfma_f32_32x32x16_bf16(pa1,PK(1),o[d0],0,0,0);
    o[d0]=__builtin_amdgcn_mfma_f32_32x32x16_bf16(pa2,PK(2),o[d0],0,0,0);
    o[d0]=__builtin_amdgcn_mfma_f32_32x32x16_bf16(pa3,PK(3),o[d0],0,0,0);
    #undef PK
  }
}

#ifndef ATTN_STORE16
#define ATTN_STORE16(p,v) (*(u32x4*)(p)=(v))
#endif
template<int THRL,int MODE,int KVP> __device__ __forceinline__ void attn_unit(int b,int h,int qb,const bf16*Q,const bf16*__restrict__ K,const bf16*__restrict__ V,bf16*O,char*shm,const u32x4*SELM,const float*GATES){
  int tid=threadIdx.x; asm volatile("":"+v"(tid));
  const int lane=tid&63,r32=lane&31,hi=lane>>5; const int wid=__builtin_amdgcn_readfirstlane(tid>>6);
  const long rowbase=(long)b*SEQ; const int q0=qb*QB;
  const bf16*Qw=Q+(rowbase+q0+wid*QBLK)*DM+h*D;
  const int kvh=h>>2; const bool LOWER=(MODE==1)&&(qb>=2); const int T0=LOWER?4*qb-8:0;
  const bf16*Kh=K+(rowbase+(long)T0*KVBLK)*KVP+kvh*D,*Vh=V+(rowbase+(long)T0*KVBLK)*KVP+kvh*D;
  const unsigned lds0=(unsigned)(uintptr_t)shm;
  float*wsf=(float*)(shm+LDS_WS)+wid*64;
  const bf16*ksrc=Kh+(long)lane*KVP+wid*8;
  const bf16*vsrc=Vh+(long)(16*(wid&3)+(lane>>2))*KVP+(wid>>2)*32+(lane&3)*8;
  const unsigned kdst=lds0+LDS_K+wid*1024, vdst=lds0+LDS_V+wid*1024;
  #define DMA_K(t,slot) glds16(ksrc+(long)(t)*KVBLK*KVP,(unsigned)__builtin_amdgcn_readfirstlane(kdst+(slot)))
  #define DMA_V(t,slot) glds16(vsrc+(long)(t)*KVBLK*KVP,(unsigned)__builtin_amdgcn_readfirstlane(vdst+(slot)))
  const int vb0=(int)(lds0+LDS_V)+((lane>>4)&1)*32+(lane&3)*8+(4*hi+((lane&15)>>2))*64;
  const char*Kbase=shm+LDS_K; bf16x8 kf[8];
  const lds_cptr shm3=(lds_cptr)shm; const lds_cptr kp0=shm3+LDS_K+hi*1024+r32*16; const lds_cptr vp0=shm3+LDS_V+((lane>>4)&1)*32+(lane&3)*8+(4*hi+((lane&15)>>2))*64;
  const int NT=(q0+QB)/KVBLK-T0;
  DMA_K(0,0);DMA_V(0,0);DMA_K(1,SLOTB);
  bf16x8 qr[4];
  #pragma unroll
  for(int d0=0;d0<4;++d0)qr[d0]=*reinterpret_cast<const bf16x8*>(&Qw[(long)r32*DM+d0*16+hi*8]);
  float zf_=0.f; asm volatile("":"+v"(zf_));
  float mhat=0.f,l_reg=0.f;f32x16 o[2],negm;
  #pragma unroll
  for(int r=0;r<16;++r){o[0][r]=zf_;o[1][r]=zf_;negm[r]=zf_;}
  asm volatile("":"+v"(negm));
  const int qrel=wid*QBLK+r32;
  u32x4 sm=(u32x4){0u,0u,0u,0u}; unsigned selw=0xffffffffu; if(MODE==0){ sm=SELM[(long)(b*4+kvh)*SEQ+q0+wid*QBLK+r32]; }
  #define SELSTEP() do{ if(MODE==0){ selw=0u-(sm.x&1u); sm.x=__builtin_amdgcn_alignbit(sm.y,sm.x,1); sm.y=__builtin_amdgcn_alignbit(sm.z,sm.y,1); sm.z=__builtin_amdgcn_alignbit(sm.w,sm.z,1); sm.w>>=1; } }while(0)
  #define CMASK(P0,P1,t) do{int jb_=(t)-(NT-4); if(jb_>=0)cmask(P0,P1,jb_,qrel,hi);}while(0)
  bool resc=false;
  #define START(P0,P1) do{ const float rm=max2f(rowmax(P0,P1),-64.f); resc=false; \
    { const float dl=rm; mhat=fadd_s(mhat,dl); \
      _Pragma("unroll") for(int r=0;r<16;++r){P0[r]=fsub_s(P0[r],dl);P1[r]=fsub_s(P1[r],dl);} \
      _Pragma("unroll") for(int r=0;r<16;++r)negm[r]=-mhat; asm volatile("":"+v"(negm)); } \
    _Pragma("unroll") for(int r=0;r<16;++r)P0[r]=__builtin_amdgcn_exp2f(P0[r]); }while(0)
  #define RESC() do{ if(resc){ asm volatile("s_waitcnt lgkmcnt(0)":::"memory"); \
      _Pragma("unroll") for(int d_=0;d_<2;++d_) _Pragma("unroll") for(int r=0;r<16;++r)o[d_][r]*=wsf[crow(r,hi)]; } }while(0)
  f32x16 pA0,pA1,pB0,pB1;
  int sl_prev=0,sl_cur=0,sl_next=SLOTB;
  #define ROT() do{sl_prev=sl_cur;sl_cur=sl_next;sl_next=(sl_next==(NSLOT-1)*SLOTB)?0:sl_next+SLOTB;}while(0)
  DMA_K(2,2*SLOTB);
  WAIT_BAR(3);
  qkt(pA0,pA1,Kbase,qr,negm,r32,hi);asm volatile("s_nop 15\n\ts_nop 7":"+v"(pA0),"+v"(pA1));CMASK(pA0,pA1,0); if(LOWER)lmask(pA0,pA1,0,qrel,hi);
  START(pA0,pA1);
  _Pragma("unroll") for(int r=0;r<16;++r)pA1[r]=__builtin_amdgcn_exp2f(pA1[r]);
  WAIT_BAR(0);
  DMA_K(3,0);DMA_V(1,SLOTB);
  ROT();
  kload8(kf,kp0+sl_cur);
  WAIT_BAR(2);
  s16x4 vlo[8],vhi[8]; u32x4 pw0,pw1,pw2,pw3;
  #define PKW(P,B) (cvtpk_s(P[B],P[B+1])&selw)
  #define PAF(k) __builtin_bit_cast(bf16x8,pw##k)
  #define VFR(i) (bf16x8){vlo[i][0],vlo[i][1],vlo[i][2],vlo[i][3],vhi[i][0],vhi[i][1],vhi[i][2],vhi[i][3]}
  #define PIN(x) asm volatile("":"+v"(x))
  #define MX3(a,b,c) __builtin_fmaxf(__builtin_fmaxf((a),(b)),(c))
  #define GAPA(MF,A0,A1,A2,A3,W0,W1,PW) do{ MF; sacc+=A0; sacc+=A1; sacc+=A2; sacc+=A3; PIN(sacc); W0; W1; PIN(PW); SBAR(); }while(0)
  #define EX(v) __builtin_amdgcn_exp2f(v)
  #define GAPB(MF,X,B) do{ MF; X[B]=EX(X[B]); X[B+1]=EX(X[B+1]); X[B+2]=EX(X[B+2]); X[B+3]=EX(X[B+3]); PIN(X); SBAR(); }while(0)
  #define VRD(i) do{ vlo[i]=vtr(vp_+(((i)>>2)*4096+((i)&3)*1024)); vhi[i]=vtr(vp_+(((i)>>2)*4096+((i)&3)*1024+512)); }while(0)
  #define KRD(G,j) do{ if(G){ kload2(kf,kp0+sl_next,j); SBAR(); } }while(0)
  #define STEP(C0,C1,P0,P1,t,GK,GV,GL) do{ SELSTEP(); SBAR(); \
    const lds_cptr vp_=vp0+sl_prev; \
    VRD(0); SBAR(); float sacc=(P0[0]+P0[1]); \
    GAPA(C0=__builtin_amdgcn_mfma_f32_32x32x16_bf16(kf[0],qr[0],negm,0,0,0), P0[2],P0[3],P0[4],P0[5],     pw0[0]=PKW(P0,0), pw0[1]=PKW(P0,2), pw0); \
    VRD(4); SBAR(); GAPA(C1=__builtin_amdgcn_mfma_f32_32x32x16_bf16(kf[1],qr[0],negm,0,0,0), P0[6],P0[7],P0[8],P0[9],     pw0[2]=PKW(P0,4), pw0[3]=PKW(P0,6), pw0); \
    VRD(1); SBAR(); GAPA(C0=__builtin_amdgcn_mfma_f32_32x32x16_bf16(kf[2],qr[1],C0,0,0,0),   P0[10],P0[11],P0[12],P0[13], pw1[0]=PKW(P0,8), pw1[1]=PKW(P0,10), pw1); \
    VRD(5); SBAR(); GAPA(C1=__builtin_amdgcn_mfma_f32_32x32x16_bf16(kf[3],qr[1],C1,0,0,0),   P0[14],P0[15],P1[0],P1[1],   pw1[2]=PKW(P0,12),pw1[3]=PKW(P0,14), pw1); \
    VRD(2); SBAR(); GAPA(C0=__builtin_amdgcn_mfma_f32_32x32x16_bf16(kf[4],qr[2],C0,0,0,0),   P1[2],P1[3],P1[4],P1[5],     pw2[0]=PKW(P1,0), pw2[1]=PKW(P1,2), pw2); \
    VRD(6); SBAR(); GAPA(C1=__builtin_amdgcn_mfma_f32_32x32x16_bf16(kf[5],qr[2],C1,0,0,0),   P1[6],P1[7],P1[8],P1[9],     pw2[2]=PKW(P1,4), pw2[3]=PKW(P1,6), pw2); \
    VRD(3); SBAR(); GAPA(C0=__builtin_amdgcn_mfma_f32_32x32x16_bf16(kf[6],qr[3],C0,0,0,0),   P1[10],P1[11],P1[12],P1[13], pw3[0]=PKW(P1,8), pw3[1]=PKW(P1,10), pw3); \
    VRD(7); SBAR(); GAPA(C1=__builtin_amdgcn_mfma_f32_32x32x16_bf16(kf[7],qr[3],C1,0,0,0),   P1[14],P1[15],0.f,0.f,       pw3[2]=PKW(P1,12),pw3[3]=PKW(P1,14), pw3); \
    l_reg+=__uint_as_float(__float_as_uint(sacc)&selw); \
    if(GK){DMA_K((t)+3,sl_cur);} if(GV){DMA_V((t)+1,sl_next);} \
    CMASK(C0,C1,t); \
    { float a=MX3(C0[0],C0[1],C1[0]),b=MX3(C0[2],C0[3],C1[1]); a=MX3(a,C1[2],C1[3]); \
      _Pragma("unroll") for(int r=4;r<16;r+=4){a=MX3(a,C0[r],C0[r+1]);b=MX3(b,C0[r+2],C0[r+3]);a=MX3(a,C1[r],C1[r+1]);b=MX3(b,C1[r+2],C1[r+3]);} \
      float rm=__builtin_fmaxf(a,b); { auto rr=__builtin_amdgcn_permlane32_swap(__float_as_uint(rm),__float_as_uint(rm),false,false); rm=__builtin_fmaxf(__uint_as_float(rr[0]),__uint_as_float(rr[1])); } \
      resc=false; \
      if(__builtin_expect(__any(rm>(float)THRL),0)){ const float dl=__builtin_fmaxf(rm,0.f); mhat+=dl; \
        _Pragma("unroll") for(int r=0;r<16;++r){C0[r]-=dl;C1[r]-=dl;} \
        _Pragma("unroll") for(int r=0;r<16;++r)negm[r]=-mhat; asm volatile("":"+v"(negm)); \
        const float f=__builtin_amdgcn_exp2f(-dl); l_reg*=f; if(hi==0)wsf[r32]=f; resc=true; } } \
    SBAR(); \
    GAPB(o[0]=__builtin_amdgcn_mfma_f32_32x32x16_bf16(PAF(0),VFR(0),o[0],0,0,0), C0,0); \
    GAPB(o[1]=__builtin_amdgcn_mfma_f32_32x32x16_bf16(PAF(0),VFR(4),o[1],0,0,0), C0,4); \
    KRD(GL,0); GAPB(o[0]=__builtin_amdgcn_mfma_f32_32x32x16_bf16(PAF(1),VFR(1),o[0],0,0,0), C0,8); \
    KRD(GL,1); GAPB(o[1]=__builtin_amdgcn_mfma_f32_32x32x16_bf16(PAF(1),VFR(5),o[1],0,0,0), C0,12); \
    KRD(GL,2); GAPB(o[0]=__builtin_amdgcn_mfma_f32_32x32x16_bf16(PAF(2),VFR(2),o[0],0,0,0), C1,0); \
    KRD(GL,3); GAPB(o[1]=__builtin_amdgcn_mfma_f32_32x32x16_bf16(PAF(2),VFR(6),o[1],0,0,0), C1,4); \
    GAPB(o[0]=__builtin_amdgcn_mfma_f32_32x32x16_bf16(PAF(3),VFR(3),o[0],0,0,0), C1,8); \
    GAPB(o[1]=__builtin_amdgcn_mfma_f32_32x32x16_bf16(PAF(3),VFR(7),o[1],0,0,0), C1,12); \
    }while(0)
  int t=1;
  #undef CMASK
  #define CMASK(P0,P1,t) lmask(P0,P1,(t),qrel,hi)
  if(LOWER){ for(;t<5;t+=2){
    STEP(pB0,pB1,pA0,pA1,t,true,true,true);     WAIT_BAR(2); RESC(); ROT();
    STEP(pA0,pA1,pB0,pB1,t+1,true,true,true);   WAIT_BAR(2); RESC(); ROT();
  } }
  #undef CMASK
  #define CMASK(P0,P1,t) do{}while(0)
  for(;t+5<NT;t+=2){
    STEP(pB0,pB1,pA0,pA1,t,true,true,true);     WAIT_BAR(2); RESC(); ROT();
    STEP(pA0,pA1,pB0,pB1,t+1,true,true,true);   WAIT_BAR(2); RESC(); ROT();
  }
  #undef CMASK
  #define CMASK(P0,P1,t) do{int jb_=(t)-(NT-4); if(jb_>=0)cmask(P0,P1,jb_,qrel,hi);}while(0)
  #define ENDW(tt) do{ if((tt)+3<NT){WAIT_BAR(2);} else if((tt)+2<NT){WAIT_BAR(1);} else {WAIT_BAR(0);} }while(0)
  for(;t+1<NT;t+=2){
    STEP(pB0,pB1,pA0,pA1,t,(t+3<NT),(t+1<NT),(t+1<NT));       ENDW(t);   RESC(); ROT();
    STEP(pA0,pA1,pB0,pB1,t+1,(t+4<NT),(t+2<NT),(t+2<NT));     ENDW(t+1); RESC(); ROT();
  }
  STEP(pB0,pB1,pA0,pA1,NT-1,false,false,false); RESC();
  { SELSTEP(); float sacc=pB0[0]+pB0[1]; _Pragma("unroll") for(int r=2;r<16;++r)sacc+=pB0[r]; _Pragma("unroll") for(int r=0;r<16;++r)sacc+=pB1[r]; l_reg+=__uint_as_float(__float_as_uint(sacc)&selw);
    pw0=(u32x4){PKW(pB0,0),PKW(pB0,2),PKW(pB0,4),PKW(pB0,6)};pw1=(u32x4){PKW(pB0,8),PKW(pB0,10),PKW(pB0,12),PKW(pB0,14)};pw2=(u32x4){PKW(pB1,0),PKW(pB1,2),PKW(pB1,4),PKW(pB1,6)};pw3=(u32x4){PKW(pB1,8),PKW(pB1,10),PKW(pB1,12),PKW(pB1,14)};
    SBAR(); pv(o,vb0+sl_cur,PAF(0),PAF(1),PAF(2),PAF(3)); }
  #undef PKW
  #undef PAF
  #undef VFR
  #undef PIN
  #undef MX3
  #undef GAPA
  #undef GAPB
  #undef EX
  #undef VRD
  #undef KRD
  #undef STEP
  #undef ENDW
  {auto rr=__builtin_amdgcn_permlane32_swap(__float_as_uint(l_reg),__float_as_uint(l_reg),false,false);l_reg=__uint_as_float(rr[0])+__uint_as_float(rr[1]);}
  if(hi==0){ const float gt=GATES[(rowbase+q0+wid*QBLK+r32)*48+h*3+1+MODE]; wsf[32+r32]=gt*__builtin_amdgcn_rcpf(l_reg); } asm volatile("s_waitcnt lgkmcnt(0)":::"memory");
  float rli[16];
  #pragma unroll
  for(int r=0;r<16;++r)rli[r]=wsf[32+crow(r,hi)];
  bf16*Ow=O+(rowbase+q0+wid*QBLK)*DM+h*D;
  { bf16*stg=(bf16*)(shm+LDS_OST)+wid*2048;
    #pragma unroll
    for(int r=0;r<16;++r){const int orow=crow(r,hi);
      #pragma unroll
      for(int d0=0;d0<2;++d0)stg[orow*64+d0*32+r32]=__float2bfloat16(o[d0][r]*rli[r]);}
    asm volatile("s_waitcnt lgkmcnt(0)":::"memory");
    #pragma unroll
    for(int i=0;i<4;++i){const int row=i*8+(lane>>3),ch=lane&7; const u32x4 v=*(const u32x4*)(stg+row*64+ch*8); const u32x4 pv=*(const u32x4*)(Ow+(long)row*DM+ch*8); u32x4 o4;
      #pragma unroll
      for(int e=0;e<4;++e){ const float lo=__uint_as_float(v[e]<<16)+__uint_as_float(pv[e]<<16), hi2=__uint_as_float(v[e]&0xffff0000u)+__uint_as_float(pv[e]&0xffff0000u); o4[e]=cvtpk_s(lo,hi2); }
      ATTN_STORE16(Ow+(long)row*DM+ch*8,o4);} }
  asm volatile("s_waitcnt lgkmcnt(0)\n\ts_barrier":::"memory");
  #undef DMA_K
  #undef DMA_V
  #undef CMASK
  #undef START
  #undef RESC
  #undef ROT
  #undef SELSTEP
}
constexpr int ATTN_LDS_BYTES=LDS_BYTES;
struct AttnUnit { int bh; int qb; };
template<int THRL=8> __device__ __forceinline__ void attn_phase(char*lds,unsigned char*ws_,int vcu,int G){
  for(int i=0;;++i){ const int L=i*G+vcu; if(L>=BATCH*NHEAD*8*4) break; const int v=L%(BATCH*NHEAD*8), rnd=L/(BATCH*NHEAD*8), s=v&7; AttnUnit u; u.bh=v>>3; u.qb=(rnd==0)?s:(rnd==1)?15-s:(rnd==2)?16+s:31-s;
    unsigned char* ws=uni_ptr(ws_);
    const bf16*Q=(const bf16*)(ws+WS_QB); const bf16*KV=(const bf16*)(ws+WS_KVB); const bf16*WN=(const bf16*)(ws+WS_WINB); bf16*O=(bf16*)(ws+WS_OB); const u32x4*SELM=(const u32x4*)(ws+WS_SELM); const float*GATES=(const float*)(ws+WS_GATES);
    attn_unit<THRL,0,1024>(u.bh/NHEAD,u.bh%NHEAD,u.qb,Q,KV+512,KV+768,O,lds,SELM,GATES);
    asm volatile("s_waitcnt vmcnt(0)":::"memory");
    attn_unit<THRL,1,512>(u.bh/NHEAD,u.bh%NHEAD,u.qb,Q,WN,WN+256,O,lds,nullptr,GATES);
    asm volatile("s_waitcnt vmcnt(0)":::"memory"); }
}
#undef SBAR
#undef WAIT_BAR
}

typedef float f32x16 __attribute__((ext_vector_type(16)));
__device__ __forceinline__ int crow16(int r, int hi) { return (r & 3) + 8 * (r >> 2) + 4 * hi; }
__device__ __forceinline__ float dpp_xor1(float v) { return __builtin_bit_cast(float, __builtin_amdgcn_update_dpp(0, __builtin_bit_cast(int, v), 0xB1, 0xf, 0xf, true)); }
__device__ __forceinline__ float dpp_xor2(float v) { return __builtin_bit_cast(float, __builtin_amdgcn_update_dpp(0, __builtin_bit_cast(int, v), 0x4E, 0xf, 0xf, true)); }
__device__ __forceinline__ int dpp_xor1i(int v) { return __builtin_amdgcn_update_dpp(0, v, 0xB1, 0xf, 0xf, true); }
__device__ __forceinline__ int dpp_xor2i(int v) { return __builtin_amdgcn_update_dpp(0, v, 0x4E, 0xf, 0xf, true); }
__device__ __forceinline__ void cmpsel_phase(Ctx& F) {
    const int w = F.wave;
    const bool bal = (F.G == 256); const int nmine = bal ? (F.vcu < 128 ? 2 : 6) : (NBP * 4 * NBLK - F.vcu + F.G - 1) / F.G, ubase = bal ? (F.vcu < 128 ? 768 + 2 * F.vcu : 6 * (F.vcu - 128)) : F.vcu, ustep = bal ? 1 : F.G;
    for (int ui = 0; ui < nmine; ++ui) { const int u = ubase + ui * ustep;
        unsigned char* ws = uni_ptr(F.ws);
        const bf16* QB = (const bf16*)(ws + WS_QB); const bf16* KCB = (const bf16*)(ws + WS_KCB); const bf16* VCT = (const bf16*)(ws + WS_VCT); const float* GATES = (const float*)(ws + WS_GATES);
        bf16* OB = (bf16*)(ws + WS_OB); v4u* SELM = (v4u*)(ws + WS_SELM);
        int lane = F.lane; asm volatile("" : "+v"(lane));
        const int r32 = lane & 31, hi = lane >> 5, g = r32 & 3, ql = r32 >> 2;
        const int i = u & 127, bk = u >> 7, b = bk >> 2, kvh = bk & 3;
        const int t = 64 * i + 8 * w + ql, row = b * SEQ + t, h = kvh * 4 + g;
        bf16x8 qf[4];
#pragma unroll
        for (int s = 0; s < 4; ++s) qf[s] = *(const bf16x8*)(QB + (size_t)row * D + h * 64 + 16 * s + 8 * hi);
        const float gatev = GATES[(size_t)row * 48 + h * 3];
        const int ntile = (i >> 5) + 1;
        f32x16 p[4];
#pragma unroll
        for (int kt = 0; kt < 4; ++kt) { p[kt] = (f32x16){};
            if (kt < ntile) {
#pragma unroll
                for (int s = 0; s < 4; ++s) { const bf16x8 ka = *(const bf16x8*)(KCB + ((size_t)((b * 4 + kvh) * NBLK + 32 * kt + r32)) * 64 + 16 * s + 8 * hi);
                    p[kt] = __builtin_amdgcn_mfma_f32_32x32x16_bf16(ka, qf[s], p[kt], 0, 0, 0); } } }
        const bool lastq = (t & 63) == 63;
        float m = -INFINITY;
#pragma unroll
        for (int kt = 0; kt < 4; ++kt)
#pragma unroll
            for (int r = 0; r < 16; ++r) { const int j = 32 * kt + crow16(r, hi); const bool valid = (j < i) || (j == i && lastq); if (!valid) p[kt][r] = -INFINITY; m = fmaxf(m, p[kt][r]); }
        m = fmaxf(m, __shfl_xor(m, 32)); m = fmaxf(m, -64.f);
        float l = 0.f;
#pragma unroll
        for (int kt = 0; kt < 4; ++kt)
#pragma unroll
            for (int r = 0; r < 16; ++r) { const float e = __builtin_amdgcn_exp2f(p[kt][r] - m); p[kt][r] = e; l += e; }
        l += __shfl_xor(l, 32);
        const float il = l > 0.f ? 1.f / l : 0.f;
#pragma unroll
        for (int kt = 0; kt < 4; ++kt) p[kt] = p[kt] * il;
        f32x16 o[2]; o[0] = (f32x16){}; o[1] = (f32x16){};
#pragma unroll
        for (int kt = 0; kt < 4; ++kt) if (kt < ntile) {
#pragma unroll
            for (int s = 0; s < 2; ++s) { v4u pw; pw.x = pg8::cvt_pk_bf16(p[kt][8 * s + 0], p[kt][8 * s + 1]); pw.y = pg8::cvt_pk_bf16(p[kt][8 * s + 2], p[kt][8 * s + 3]); pw.z = pg8::cvt_pk_bf16(p[kt][8 * s + 4], p[kt][8 * s + 5]); pw.w = pg8::cvt_pk_bf16(p[kt][8 * s + 6], p[kt][8 * s + 7]);
                const bf16x8 pa = __builtin_bit_cast(bf16x8, pw);
#pragma unroll
                for (int d0 = 0; d0 < 2; ++d0) { const bf16* vp = VCT + ((size_t)((b * 4 + kvh) * 64 + 32 * d0 + r32)) * NBLK + 32 * kt + 16 * s + 4 * hi;
                    const v2u lo = *(const v2u*)vp, hi8 = *(const v2u*)(vp + 8); const v4u vb = {lo.x, lo.y, hi8.x, hi8.y};
                    o[d0] = __builtin_amdgcn_mfma_f32_32x32x16_bf16(pa, __builtin_bit_cast(bf16x8, vb), o[d0], 0, 0, 0); } } }
#pragma unroll
        for (int r = 0; r < 16; ++r) { const int rw = crow16(r, hi); const float gt = __shfl(gatev, rw); bf16* op = OB + (size_t)(b * SEQ + 64 * i + 8 * w + (rw >> 2)) * D + (kvh * 4 + (rw & 3)) * 64 + r32;
            op[0] = (bf16)f2bf(gt * o[0][r]); op[32] = (bf16)f2bf(gt * o[1][r]); }
#pragma unroll
        for (int kt = 0; kt < 4; ++kt)
#pragma unroll
            for (int r = 0; r < 16; ++r) { float x = p[kt][r]; x += dpp_xor1(x); x += dpp_xor2(x); p[kt][r] = x; }
        unsigned T = 0u;
        if (i >= 16) {
            unsigned xs[16];
#pragma unroll
            for (int kt = 0; kt < 4; ++kt)
#pragma unroll
                for (int k = 0; k < 4; ++k) { float v = p[kt][k]; v = (g == 1) ? p[kt][4 + k] : v; v = (g == 2) ? p[kt][8 + k] : v; v = (g == 3) ? p[kt][12 + k] : v;
                    const int j = 32 * kt + 8 * g + 4 * hi + k; xs[kt * 4 + k] = (j >= 1 && j <= i - 2) ? __float_as_uint(v) : 0u; }
            unsigned mx = 0u;
#pragma unroll
            for (int q = 0; q < 16; ++q) mx = xs[q] > mx ? xs[q] : mx;
            { int t_ = (int)mx; int o1 = dpp_xor1i(t_); t_ = t_ > o1 ? t_ : o1; int o2 = dpp_xor2i(t_); t_ = t_ > o2 ? t_ : o2; int o3 = __shfl_xor(t_, 32); t_ = t_ > o3 ? t_ : o3; mx = (unsigned)t_; }
            mx = (unsigned)wave_max(__uint_as_float(mx) > 0.f ? (float)(31 - __builtin_clz(mx | 1u)) : 0.f);
            bool done = false;
            for (int bit = (int)mx; bit >= 0; --bit) { const unsigned c = T | (1u << bit); int cnt = 0;
#pragma unroll
                for (int q = 0; q < 16; ++q) cnt += (xs[q] >= c) ? 1 : 0;
                cnt += dpp_xor1i(cnt); cnt += dpp_xor2i(cnt); cnt += __shfl_xor(cnt, 32);
                if (!done && cnt >= 13) T = c;
                done = done || (cnt == 13);
                if (__all(done)) break; }
        }
        v4u wd;
#pragma unroll
        for (int kt = 0; kt < 4; ++kt) { unsigned wv = 0u;
#pragma unroll
            for (int r = 0; r < 16; ++r) { const int cr = crow16(r, hi), j = 32 * kt + cr; bool sel;
                if (i >= 16) sel = (j == 0) || (j == i) || (j == i - 1) || (j >= 1 && j <= i - 2 && __float_as_uint(p[kt][r]) >= T); else sel = j <= i;
                wv |= sel ? (1u << cr) : 0u; }
            wv |= (unsigned)__shfl_xor((int)wv, 32); wd[kt] = wv; }
        if (g == 0 && hi == 0) SELM[(size_t)(b * 4 + kvh) * SEQ + t] = wd;
    }
}

constexpr int NPHASES = 31;
__global__ void __launch_bounds__(512, 2) mk_fwd(Args args) {
    extern __shared__ __attribute__((aligned(16))) unsigned char lds_raw[];
    Ctx F;
    F.lds = (LAS unsigned char*)lds_raw; F.tid = threadIdx.x; F.lane = F.tid & 63; F.wave = __builtin_amdgcn_readfirstlane(F.tid >> 6);
    F.G = gridDim.x; { const int bx = blockIdx.x; F.vcu = (F.G % 8 == 0) ? (bx % 8) * (F.G / 8) + bx / 8 : bx; }
    F.gw = F.vcu * 8 + F.wave; F.NGW = F.G * 8;
    F.out = args.out; F.ws = args.ws; unsigned char* ws = args.ws;
    volatile LAS unsigned* MISC = (volatile LAS unsigned*)(F.lds + MISC_OFF);
    for (int u = F.tid; u < (LDS_BYTES - RING_BYTES) / 4; u += 512) ((LAS unsigned*)(F.lds + RING_BYTES))[u] = 0u;
    __syncthreads();
    unsigned* ctl = (unsigned*)(ws + WS_CTL);
    XcdBarrier bar; bar.bar = ctl + CW_BAR; bar.x = 0; bar.st = nullptr;
    const int lo = args.ph_lo, hi = args.ph_hi;
    if (hi - lo > 1) bar = xcd_barrier_post(ctl + CW_BAR, MISC + 8);
    int ph = 0;
    const Ctx& F0 = F;
#define PH_BEGIN if (ph >= lo && ph < hi) { Ctx F = fresh(F0); float* X = F.out + O_Y; (void)X;
#define PH_CLOSE } do { if (ph >= lo && ph + 1 < hi) { XcdBarrier b2_ = bar; asm volatile("" : "+s"(b2_.bar), "+s"(b2_.x)); xcd_barrier(b2_); } ++ph; } while (0)
#define XLO (l == 0 ? (const float*)kin(0) : (const float*)X)
#define XHI (l == 0 ? (const float*)kin(1) : (const float*)(X + (size_t)MP * D))
#define WSB(off) ((bf16*)(F.ws + (off)))
#define WSF(off) ((float*)(F.ws + (off)))
    const int bxi = (int)blockIdx.x;
    PH_BEGIN p0_prologue(F); PH_CLOSE;
    PH_BEGIN pg8::Gemm g{WSB(WS_CB), WSB(WS_ADAT), D, D, D, 0}; pg8::StaticOrder S; S.init(256, NADA, F.G, bxi); pg8::EpiF32 E{WSF(WS_MODS), NADA, 64, (const float*)kin(9), (const float*)kin(15), 8 * 3072};
        pg8::gemm_phase(F.lds, g, S, E); PH_CLOSE;
    for (int l = 0; l < 4; ++l) {
        if (l < 2) {
            PH_BEGIN pass_h(F, l, XLO, XHI); PH_CLOSE;
            PH_BEGIN pass_pool(F); PH_CLOSE;
            PH_BEGIN pg8::Gemm g{WSB(WS_XN2), WSB(WS_POOLW) + (size_t)l * 1024 * 256, D, 256, 256, 256}; pg8::StaticOrder S; S.init(MP, D, F.G, bxi);
                pg8::EpiRes E{XLO, XHI, X, WSF(WS_MODS), (l * 2 + 0) * 3072 + 2048, (const float*)kin(13) + l * D}; pg8::gemm_phase(F.lds, g, S, E);
                skinny_res(F, WSB(WS_XN2) + (size_t)MP * D, D, 256, WSB(WS_POOLW) + (size_t)l * 1024 * 256, 256, 256, XHI, X + (size_t)MP * D, WSF(WS_MODS), (l * 2 + 0) * 3072 + 2048, (const float*)kin(13) + l * D); PH_CLOSE;
        } else {
            const int j = l - 2;
            PH_BEGIN if (l == 2) pass_norm(F, X, X + (size_t)MP * D, (const float*)kin(10) + l * D, (l * 2 + 0) * 3072, WSB(WS_XN), (const float*)kin(16), 8 * 3072, WSB(WS_XN2));
                     else pass_norm(F, X, X + (size_t)MP * D, (const float*)kin(10) + l * D, (l * 2 + 0) * 3072, WSB(WS_XN), nullptr, 0, nullptr); PH_CLOSE;
            PH_BEGIN
                if (l == 2) { pg8::Gemm g{WSB(WS_XN2), WSB(WS_WKV), D, D, D, 0}; pg8::StaticOrder S; S.init(MPAD, NKV, F.G, bxi);
                    pg8::EpiKV E{F.out + O_KV, WSB(WS_KVB), WSB(WS_WINB), F.out + O_WINP, F.out + O_WINS, (const float*)kin(18), WSF(WS_ROPE)}; pg8::gemm_phase(F.lds, g, S, E); }
                { pg8::Gemm g{WSB(WS_XN), WSB(WS_WQG) + (size_t)j * NQGP * D, D, D, D, 0}; pg8::StaticOrder S; S.init(MPAD, NQGP, F.G, bxi);
                    pg8::EpiQG E{WSB(WS_QB), WSF(WS_GATES), (const float*)kin(23) + j * 64, WSF(WS_ROPE)}; pg8::gemm_phase(F.lds, g, S, E); }
            PH_CLOSE;
            if (l == 2) { PH_BEGIN compress_phase(F); PH_CLOSE; }
            PH_BEGIN attn_sample_wg(F); cmpsel_phase(F); PH_CLOSE;
            PH_BEGIN attn_body::attn_phase<8>((char*)lds_raw, F.ws, F.vcu, F.G); PH_CLOSE;
            PH_BEGIN pg8::Gemm g{WSB(WS_OB), WSB(WS_WO) + (size_t)j * D * D, D, D, D, 0}; pg8::StaticOrder S; S.init(MP, D, F.G, bxi);
                pg8::EpiRes E{X, X + (size_t)MP * D, X, WSF(WS_MODS), (l * 2 + 0) * 3072 + 2048, nullptr}; pg8::gemm_phase(F.lds, g, S, E);
                skinny_res(F, WSB(WS_OB) + (size_t)MP * D, D, 0, WSB(WS_WO) + (size_t)j * D * D, D, D, X + (size_t)MP * D, X + (size_t)MP * D, WSF(WS_MODS), (l * 2 + 0) * 3072 + 2048, nullptr); PH_CLOSE;
        }
        PH_BEGIN pass_norm(F, X, X + (size_t)MP * D, (const float*)kin(11) + l * D, (l * 2 + 1) * 3072, WSB(WS_XN), nullptr, 0, nullptr); PH_CLOSE;
        PH_BEGIN pg8::Gemm g{WSB(WS_XN), WSB(WS_WGU) + (size_t)l * NGU * D, D, D, D, 0}; pg8::StaticOrder S; S.init(MPAD, NGU, F.G, bxi); pg8::EpiSwiglu E{WSB(WS_H), DFF}; pg8::gemm_phase(F.lds, g, S, E); PH_CLOSE;
        PH_BEGIN pg8::Gemm g{WSB(WS_H), WSB(WS_WDN) + (size_t)l * D * DFF, DFF, DFF, DFF, 0}; pg8::StaticOrder S; S.init(MP, D, F.G, bxi);
            pg8::EpiRes E{X, X + (size_t)MP * D, X, WSF(WS_MODS), (l * 2 + 1) * 3072 + 2048, nullptr}; pg8::gemm_phase(F.lds, g, S, E);
            skinny_res(F, WSB(WS_H) + (size_t)MP * DFF, DFF, 0, WSB(WS_WDN) + (size_t)l * D * DFF, DFF, DFF, X + (size_t)MP * D, X + (size_t)MP * D, WSF(WS_MODS), (l * 2 + 1) * 3072 + 2048, nullptr); PH_CLOSE;
    }
}

extern "C" void kernel_launch(void* const* d_in, const int* in_sizes, int n_in, void* d_out, int out_size, void* d_ws, size_t ws_size, hipStream_t stream) {
    static int grid = 0;
    if (grid == 0) {
        if (n_in != 27 || (size_t)out_size != O_END || ws_size < WS_END) { fprintf(stderr, "kernel_launch: unexpected shapes (n_in %d out %d ws %zu)\n", n_in, out_size, ws_size); grid = -1; return; }
        int dev = 0, cus = 0, per_cu = 0;
        if (hipGetDevice(&dev) != hipSuccess || hipDeviceGetAttribute(&cus, hipDeviceAttributeMultiprocessorCount, dev) != hipSuccess) { grid = -1; return; }
        if (hipFuncSetAttribute((const void*)mk_fwd, hipFuncAttributeMaxDynamicSharedMemorySize, LDS_BYTES) != hipSuccess) { fprintf(stderr, "kernel_launch: hipFuncSetAttribute failed\n"); grid = -1; return; }
        if (hipOccupancyMaxActiveBlocksPerMultiprocessor(&per_cu, (const void*)mk_fwd, 512, LDS_BYTES) != hipSuccess || per_cu < 1) fprintf(stderr, "kernel_launch: occupancy query reports %d\n", per_cu);
        (void)hipGetLastError();
        grid = cus;
    }
    if (grid < 0) return;
    (void)hipMemsetAsync((char*)d_ws + WS_CTL, 0, CTL_ZERO_BYTES, stream);
    Args a{};
    for (int i = 0; i < 27; ++i) a.in[i] = d_in[i];
    a.out = (float*)d_out; a.ws = (unsigned char*)d_ws;
#if MK_PER_PHASE
    for (int p = 0; p < NPHASES; ++p) { a.ph_lo = p; a.ph_hi = p + 1; hipLaunchKernelGGL(mk_fwd, dim3(grid), dim3(512), LDS_BYTES, stream, a); }
#else
    a.ph_lo = 0; a.ph_hi = NPHASES; hipLaunchKernelGGL(mk_fwd, dim3(grid), dim3(512), LDS_BYTES, stream, a);
#endif
}
```
